# Optimizing an MI355X kernel written in HIP

```python
import jax, jax.numpy as jnp
from jax import lax
import numpy as np

D_MODEL = 2048
BATCH = 16
SEQ = 2048
DEPTH = 2

PLE_DIM = 256
FOX_HEADS = 16
FOX_HEAD_DIM = 64
FOX_W = FOX_HEADS * FOX_HEAD_DIM
Q_BLOCK = 128
RWKV_HEADS = 16
RWKV_HEAD_SIZE = 64
RWKV_W = RWKV_HEADS * RWKV_HEAD_SIZE
RWKV_DECAY_LORA = 64
RWKV_ICLR_LORA = 64
RWKV_SHIFT_COLS = 3 * RWKV_W + RWKV_DECAY_LORA + RWKV_ICLR_LORA
AB_COLS = 4 * FOX_W + FOX_HEADS + RWKV_SHIFT_COLS + RWKV_W
AB_OUT = FOX_W + RWKV_W
GMLP_W = D_MODEL
GMLP_GROUPS = 16
GMLP_GROUP_CH = GMLP_W // GMLP_GROUPS
GMLP_CHUNK = 128
C_COLS = 3 * GMLP_W
N_AB_LAYERS = (DEPTH + 1) // 2
N_C_LAYERS = DEPTH // 2
RMS_EPS = 1e-6
LN_EPS = 1e-5
RWKV_GN_EPS = 64e-5

kernel_name = 'hybrid_fox_rwkv7_gmlp_sandwich_ple'


def _split(x, sizes):
    offs = []
    o = 0
    for s in sizes[:-1]:
        o += s
        offs.append(o)
    return jnp.split(x, offs, axis=-1)


def rms_norm(x, g):
    xf = x.astype(jnp.float32)
    y = xf * lax.rsqrt(jnp.mean(xf * xf, axis=-1, keepdims=True) + RMS_EPS)
    return (y * g.astype(jnp.float32)).astype(x.dtype)


def layer_norm(x, g, b):
    xf = x.astype(jnp.float32)
    mu = jnp.mean(xf, axis=-1, keepdims=True)
    var = jnp.mean(jnp.square(xf - mu), axis=-1, keepdims=True)
    y = (xf - mu) * lax.rsqrt(var + LN_EPS) * g.astype(jnp.float32) + b.astype(jnp.float32)
    return y.astype(x.dtype)


def forgetting_attention(q, k, v, log_f):
    T = q.shape[1]
    c = jnp.cumsum(log_f, axis=1).transpose(0, 2, 1)
    scale = FOX_HEAD_DIM ** -0.5
    outs = []
    for blk in range(T // Q_BLOCK):
        q0 = blk * Q_BLOCK
        q1 = q0 + Q_BLOCK
        s = jnp.einsum('bqhd,bkhd->bhqk', q[:, q0:q1], k[:, :q1]).astype(jnp.float32) * scale
        bias = c[:, :, q0:q1, None] - c[:, :, None, :q1]
        causal = (q0 + jnp.arange(Q_BLOCK))[:, None] >= jnp.arange(q1)[None, :]
        s = jnp.where(causal, s + bias, -jnp.inf)
        pr = jax.nn.softmax(s, axis=-1)
        outs.append(jnp.einsum('bhqk,bkhd->bqhd', pr.astype(v.dtype), v[:, :q1]))
    return jnp.concatenate(outs, axis=1)


def rwkv7_time_mix(sh, mu, w0, w2, a0, a2, k_k, k_a, r_k, ln_g, ln_b):
    dt = sh.dtype
    B, T, _ = sh.shape
    H, N = RWKV_HEADS, RWKV_HEAD_SIZE
    prev = jnp.pad(sh, ((0, 0), (1, 0), (0, 0)))[:, :-1]
    sh = (sh + (prev - sh) * mu).astype(jnp.float32)
    r, k, v, w_lo, a_lo = _split(sh, (RWKV_W, RWKV_W, RWKV_W, RWKV_DECAY_LORA, RWKV_ICLR_LORA))
    w_raw = -jax.nn.softplus(-(w0.astype(jnp.float32) + jnp.tanh(w_lo) @ w2.astype(jnp.float32))) - 0.5
    decay = jnp.exp(-jnp.exp(w_raw))
    a = jax.nn.sigmoid(a0.astype(jnp.float32) + a_lo @ a2.astype(jnp.float32))
    kk = (k * k_k.astype(jnp.float32)).reshape(B, T, H, N)
    kk = kk / jnp.maximum(jnp.sqrt(jnp.sum(kk * kk, axis=-1, keepdims=True)), 1e-12)
    k = k * (1.0 + (a - 1.0) * k_a.astype(jnp.float32))
    heads = lambda z: z.reshape(B, T, H, N)
    r_h, k_h, v_h, a_h, w_h = heads(r), heads(k), heads(v), heads(a), heads(decay)
    xs = tuple(z.transpose(1, 0, 2, 3) for z in (r_h, w_h, k_h, v_h, kk, a_h))

    def step(S, inp):
        r_t, w_t, k_t, v_t, kk_t, a_t = inp
        sa = jnp.einsum('bhij,bhj->bhi', S, kk_t)
        S = S * w_t[:, :, None, :] - sa[..., None] * (kk_t * a_t)[:, :, None, :] + v_t[..., None] * k_t[:, :, None, :]
        y = jnp.einsum('bhij,bhj->bhi', S, r_t)
        return S, y

    S0 = jnp.zeros((B, H, N, N), jnp.float32)
    _, y = lax.scan(step, S0, xs)
    y = y.transpose(1, 0, 2, 3)
    mean = jnp.mean(y, axis=-1, keepdims=True)
    var = jnp.mean(jnp.square(y - mean), axis=-1, keepdims=True)
    y = ((y - mean) * lax.rsqrt(var + RWKV_GN_EPS)).reshape(B, T, RWKV_W)
    y = y * ln_g.astype(jnp.float32) + ln_b.astype(jnp.float32)
    bonus = jnp.sum(r_h * k_h * r_k.astype(jnp.float32), axis=-1, keepdims=True) * v_h
    y = y + bonus.reshape(B, T, RWKV_W)
    return y.astype(dt)


def chunked_spatial_gating(u, v, ln_g, ln_b, w_s, b_s):
    B, T, _ = v.shape
    u = jax.nn.gelu(u, approximate=False)
    v = layer_norm(jax.nn.gelu(v, approximate=False), ln_g, ln_b)
    vc = v.reshape(B, T // GMLP_CHUNK, GMLP_CHUNK, GMLP_GROUPS, GMLP_GROUP_CH)
    causal = jnp.tril(jnp.ones((GMLP_CHUNK, GMLP_CHUNK), w_s.dtype))
    mixed = jnp.einsum('gts,bnsgc->bntgc', w_s * causal, vc) + b_s.T[:, :, None]
    return u * mixed.reshape(B, T, GMLP_W)


def setup_inputs(seed: int = 0) -> dict:
    key = jax.random.key(seed)
    ks = iter(jax.random.split(key, 40))
    nrm = lambda shape, scale: scale * jax.random.normal(next(ks), shape, jnp.float32)
    uni = lambda shape, lo, hi: jax.random.uniform(next(ks), shape, jnp.float32, lo, hi)
    E, C = N_AB_LAYERS, N_C_LAYERS
    return {
        'x': nrm((BATCH, SEQ, D_MODEL), 1.0),
        'p': nrm((DEPTH, BATCH, SEQ, PLE_DIM), 1.0),
        'norm_pre': 1.0 + nrm((DEPTH, D_MODEL), 0.02),
        'norm_post': 1.0 + nrm((DEPTH, D_MODEL), 0.02),
        'ab_w_in': nrm((E, D_MODEL, AB_COLS), D_MODEL ** -0.5),
        'fox_f_bias': uni((E, FOX_HEADS), 1.0, 5.0),
        'rwkv_mu': uni((E, RWKV_SHIFT_COLS), 0.0, 1.0),
        'rwkv_w0': uni((E, RWKV_W), -6.0, 1.0),
        'rwkv_w2': nrm((E, RWKV_DECAY_LORA, RWKV_W), 0.1),
        'rwkv_a0': nrm((E, RWKV_W), 0.1),
        'rwkv_a2': nrm((E, RWKV_ICLR_LORA, RWKV_W), 0.1),
        'rwkv_k_k': 0.85 + nrm((E, RWKV_W), 0.05),
        'rwkv_k_a': 1.0 + nrm((E, RWKV_W), 0.05),
        'rwkv_r_k': nrm((E, RWKV_HEADS, RWKV_HEAD_SIZE), 0.1),
        'rwkv_ln_g': 1.0 + nrm((E, RWKV_W), 0.02),
        'rwkv_ln_b': nrm((E, RWKV_W), 0.02),
        'ab_w_out': nrm((E, AB_OUT, D_MODEL), AB_OUT ** -0.5),
        'c_w_in': nrm((C, D_MODEL, C_COLS), D_MODEL ** -0.5),
        'c_ln_g': 1.0 + nrm((C, GMLP_W), 0.02),
        'c_ln_b': nrm((C, GMLP_W), 0.02),
        'c_w_s': nrm((C, GMLP_GROUPS, GMLP_CHUNK, GMLP_CHUNK), GMLP_CHUNK ** -0.5),
        'c_b_s': 1.0 + nrm((C, GMLP_GROUPS, GMLP_CHUNK), 0.01),
        'c_w_out': nrm((C, GMLP_W, D_MODEL), GMLP_W ** -0.5),
        'ple_w_proj': nrm((DEPTH, PLE_DIM, D_MODEL), PLE_DIM ** -0.5),
        'ple_w_gate': nrm((DEPTH, D_MODEL, D_MODEL), D_MODEL ** -0.5),
    }


def reference(x, p, norm_pre, norm_post, ab_w_in, fox_f_bias, rwkv_mu, rwkv_w0, rwkv_w2, rwkv_a0, rwkv_a2,
              rwkv_k_k, rwkv_k_a, rwkv_r_k, rwkv_ln_g, rwkv_ln_b, ab_w_out, c_w_in, c_ln_g, c_ln_b, c_w_s,
              c_b_s, c_w_out, ple_w_proj, ple_w_gate):
    B, T, _ = x.shape
    h = x
    for i in range(DEPTH):
        j = i // 2
        xn = rms_norm(h, norm_pre[i])
        if i % 2 == 0:
            proj = xn @ ab_w_in[j]
            qa, ka, va, fa, ga, shb, gb = _split(
                proj, (FOX_W, FOX_W, FOX_W, FOX_HEADS, FOX_W, RWKV_SHIFT_COLS, RWKV_W))
            log_f = jax.nn.log_sigmoid((fa + fox_f_bias[j]).astype(jnp.float32))
            hd = lambda z: z.reshape(B, T, FOX_HEADS, FOX_HEAD_DIM)
            oa = forgetting_attention(hd(qa), hd(ka), hd(va), log_f).reshape(B, T, FOX_W)
            ob = rwkv7_time_mix(shb, rwkv_mu[j], rwkv_w0[j], rwkv_w2[j], rwkv_a0[j], rwkv_a2[j],
                                rwkv_k_k[j], rwkv_k_a[j], rwkv_r_k[j], rwkv_ln_g[j], rwkv_ln_b[j])
            y = jnp.concatenate([oa * jax.nn.silu(ga), ob * jax.nn.silu(gb)], axis=-1) @ ab_w_out[j]
        else:
            proj = xn @ c_w_in[j]
            u, v, g = _split(proj, (GMLP_W, GMLP_W, GMLP_W))
            oc = chunked_spatial_gating(u, v, c_ln_g[j], c_ln_b[j], c_w_s[j], c_b_s[j])
            y = (oc * jax.nn.silu(g)) @ c_w_out[j]
        h = h + rms_norm(y, norm_post[i])
        h = h + (p[i] @ ple_w_proj[i]) * jax.nn.sigmoid(h @ ple_w_gate[i])
    return h
```

```cpp
#include <hip/hip_runtime.h>
#include <hip/hip_cooperative_groups.h>
#include <cstdio>
#include <cstdint>
namespace cg = cooperative_groups;
namespace pg8 {
#define PG8_LAS __attribute__((address_space(3)))
typedef unsigned short bf16_t;
typedef short bf16x8 __attribute__((ext_vector_type(8)));
typedef float f32x4 __attribute__((ext_vector_type(4)));
typedef unsigned u32x4 __attribute__((ext_vector_type(4)));
constexpr int BM = 256, BK = 64, HALF = 128, HTB = HALF * BK * 2  , STAGE_BYTES = 8 * HTB, NXCD = 8, WGM = 8;

__host__ __device__ __forceinline__ int lds_byte(int r, int c) { const int st = (r >> 4) * 2 + (c >> 5), rr = r & 15, cc = c & 31, ob = rr * 64 + cc * 2; return st * 1024 + (ob ^ (((ob >> 9) & 1) << 5)); }
__host__ __device__ __forceinline__ void stage_rc(int b, int& R, int& C) { const int st = b / 1024, sb = b % 1024, swz = sb ^ (((sb >> 9) & 1) << 5); R = (st >> 1) * 16 + swz / 64; C = (st & 1) * 32 + (swz % 64) / 2; }
__host__ __device__ __forceinline__ int perm32(int rho) { const int n = rho >> 4, i = rho & 15; return 8 * (i >> 2) + 4 * n + (i & 3); }

struct Unit { int pm, pn; };
struct Gemm { const bf16_t* A; const bf16_t* Bt; int M, N, K; };

struct StaticOrder {
    int nM, nN, nwg, G, c;
    __host__ __device__ void init(int M, int N, int G_, int c_) { nM = M / BM; nN = N / BM; nwg = nM * nN; G = G_; c = c_; }
    __host__ __device__ bool next(int i, Unit& u) const {
        const long L = (long)i * G + c; if (L >= nwg) return false;
        int wgid = (int)L; { const int q = nwg / NXCD, r = nwg % NXCD, xcd = wgid % NXCD, off = wgid / NXCD; wgid = (xcd < r ? xcd * (q + 1) : r * (q + 1) + (xcd - r) * q) + off; }
        const int nig = WGM * nN, gid = wgid / nig, fm = gid * WGM, gsz = (nM - fm) < WGM ? (nM - fm) : WGM;
        u.pm = fm + ((wgid % nig) % gsz); u.pn = (wgid % nig) / gsz; return true;
    }
    __device__ __forceinline__ void a_ready(const Unit&) const {}
    __device__ __forceinline__ void done(const Unit&) const {}
};

__device__ __forceinline__ unsigned cvt_pk_bf16(float lo, float hi) { unsigned r; asm volatile("v_cvt_pk_bf16_f32 %0, %1, %2" : "=v"(r) : "v"(lo), "v"(hi)); return r; }
typedef float f32x2 __attribute__((ext_vector_type(2)));
__device__ __forceinline__ f32x2 gelu_pk(f32x2 v) {
    const f32x2 av = __builtin_elementwise_abs(v), d = av * 0.2316418882f + 1.0f;
    f32x2 t; t.x = __builtin_amdgcn_rcpf(d.x); t.y = __builtin_amdgcn_rcpf(d.y);
    f32x2 q = t * 0.5307027145f + (-0.7265760135f); q = q * t + 0.7107068705f; q = q * t + (-0.142248368f); q = q * t + 0.127414796f; q = q * t;
    const f32x2 s = (v * v) * (-0.72134752044f);
    f32x2 e; e.x = __builtin_amdgcn_exp2f(s.x); e.y = __builtin_amdgcn_exp2f(s.y);
    const f32x2 m = v * (q * e), r = v - m;
    f32x2 o; o.x = v.x < 0.f ? m.x : r.x; o.y = v.y < 0.f ? m.y : r.y; return o;
}
template <int ACT  > struct EpiBf16 {
    static constexpr bool PERM = true, AFTER_DRAIN = false; static_assert(ACT == 0 || ACT == 1, "EpiBf16: ACT is 0 (none) or 1 (gelu_pk)");
    bf16_t* O; int ldc; const float* bias; int split_cols; size_t split_stride; float scale0;
    __device__ __forceinline__ void operator()(const f32x4 (&acc)[2][2][4][2], const Unit& u, int wr, int wc, int fr, int fq) const {
        const int row0 = u.pm * BM + wr * 64 + fr; int colt = u.pn * BM; bf16_t* base = O;
        float sc = 1.f; if (split_cols) { const int t = colt / split_cols; base += (size_t)t * split_stride; colt -= t * split_cols; if (t == 0) sc = scale0; }
        const int col0 = colt + wc * 32 + 8 * fq, bcol0 = u.pn * BM + wc * 32 + 8 * fq;
        f32x4 bv[2][2];
#pragma unroll
        for (int bj = 0; bj < 2; ++bj)
#pragma unroll
            for (int n = 0; n < 2; ++n) bv[bj][n] = bias ? *(const f32x4*)(bias + bcol0 + bj * HALF + 4 * n) : (f32x4){0.f, 0.f, 0.f, 0.f};
#pragma unroll
        for (int ai = 0; ai < 2; ++ai)
#pragma unroll
            for (int m = 0; m < 4; ++m) { bf16_t* rowp = base + (size_t)(row0 + ai * HALF + m * 16) * ldc + col0;
#pragma unroll
                for (int bj = 0; bj < 2; ++bj) { f32x4 v0 = acc[ai][bj][m][0] + bv[bj][0], v1 = acc[ai][bj][m][1] + bv[bj][1];
                    if (ACT == 1) { f32x2 a = gelu_pk((f32x2){v0[0], v0[1]}), b = gelu_pk((f32x2){v0[2], v0[3]}), c = gelu_pk((f32x2){v1[0], v1[1]}), d = gelu_pk((f32x2){v1[2], v1[3]});
                        v0 = (f32x4){a.x, a.y, b.x, b.y}; v1 = (f32x4){c.x, c.y, d.x, d.y}; }
                    v0 = v0 * sc; v1 = v1 * sc; u32x4 w; w.x = cvt_pk_bf16(v0[0], v0[1]); w.y = cvt_pk_bf16(v0[2], v0[3]); w.z = cvt_pk_bf16(v1[0], v1[1]); w.w = cvt_pk_bf16(v1[2], v1[3]);
                    *(u32x4*)(rowp + bj * HALF) = w; } }
    }
};
__device__ __forceinline__ u32x4 pack8(const f32x4 v0, const f32x4 v1) { u32x4 w; w.x = cvt_pk_bf16(v0[0], v0[1]); w.y = cvt_pk_bf16(v0[2], v0[3]); w.z = cvt_pk_bf16(v1[0], v1[1]); w.w = cvt_pk_bf16(v1[2], v1[3]); return w; }
__device__ __forceinline__ float bflo(unsigned u) { return __uint_as_float(u << 16); }
__device__ __forceinline__ float bfhi(unsigned u) { return __uint_as_float(u & 0xffff0000u); }
__device__ __forceinline__ float sigm(float x) { return __builtin_amdgcn_rcpf(1.0f + __builtin_amdgcn_exp2f(-1.4426950408889634f * x)); }
#define PG8_FOR_AI_M _Pragma("unroll") for (int ai = 0; ai < 2; ++ai) _Pragma("unroll") for (int m = 0; m < 4; ++m)
struct EpiIn0 {
    static constexpr bool PERM = true, AFTER_DRAIN = false;
    bf16_t* G; float* small; const float* ssq; float qscale;
    __device__ __forceinline__ void operator()(const f32x4 (&acc)[2][2][4][2], const Unit& u, int wr, int wc, int fr_, int fq_) const {
        int fr = fr_, fq = fq_; asm volatile("" : "+v"(fr), "+v"(fq));
        const int row0 = u.pm * BM + wr * 64 + fr, ct = wc * 32 + 8 * fq;
        float rsv[2][4];
        PG8_FOR_AI_M rsv[ai][m] = __builtin_amdgcn_rsqf(ssq[row0 + ai * HALF + m * 16] * (1.f / 2048.f) + 1e-6f);
        if (u.pn < 32) {
            const int grp = u.pn >> 2; bf16_t* base = G + (size_t)grp * ((size_t)32768 * 1024) + (u.pn & 3) * 256 + ct; const float sc0 = (grp == 0) ? qscale : 1.f;
            PG8_FOR_AI_M { const int row = row0 + ai * HALF + m * 16; const float rs = rsv[ai][m] * sc0; bf16_t* rp = base + (size_t)row * 1024;
#pragma unroll
                for (int bj = 0; bj < 2; ++bj) *(u32x4*)(rp + bj * HALF) = pack8(acc[ai][bj][m][0] * rs, acc[ai][bj][m][1] * rs); }
        } else {
            PG8_FOR_AI_M { const int row = row0 + ai * HALF + m * 16; const float rs = rsv[ai][m]; float* rp = small + (size_t)row * 256 + ct;
#pragma unroll
                for (int bj = 0; bj < 2; ++bj) { *(f32x4*)(rp + bj * HALF) = acc[ai][bj][m][0] * rs; *(f32x4*)(rp + bj * HALF + 4) = acc[ai][bj][m][1] * rs; } }
        }
    }
};
struct EpiY {
    static constexpr bool PERM = true, AFTER_DRAIN = false;
    bf16_t* Y; float* ssq;
    __device__ __forceinline__ void operator()(const f32x4 (&acc)[2][2][4][2], const Unit& u, int wr, int wc, int fr_, int fq_) const {
        int fr = fr_, fq = fq_; asm volatile("" : "+v"(fr), "+v"(fq));
        const int row0 = u.pm * BM + wr * 64 + fr, col0 = u.pn * BM + wc * 32 + 8 * fq;
        PG8_FOR_AI_M { const int row = row0 + ai * HALF + m * 16; float s = 0.f; bf16_t* rp = Y + (size_t)row * 2048 + col0;
#pragma unroll
            for (int bj = 0; bj < 2; ++bj) { const f32x4 v0 = acc[ai][bj][m][0], v1 = acc[ai][bj][m][1];
                s += (v0[0] * v0[0] + v0[1] * v0[1]) + (v0[2] * v0[2] + v0[3] * v0[3]) + (v1[0] * v1[0] + v1[1] * v1[1]) + (v1[2] * v1[2] + v1[3] * v1[3]);
                *(u32x4*)(rp + bj * HALF) = pack8(v0, v1); }
            s += __shfl_xor(s, 16); s += __shfl_xor(s, 32);
            if (fq == 0) __hip_atomic_fetch_add(ssq + row, s, __ATOMIC_RELAXED, __HIP_MEMORY_SCOPE_AGENT); }
    }
};
struct EpiGate {
    static constexpr bool PERM = true, AFTER_DRAIN = false;
    float* H; const bf16_t* PP; bf16_t* HB; float* ssq;
    __device__ __forceinline__ void operator()(const f32x4 (&acc)[2][2][4][2], const Unit& u, int wr, int wc, int fr_, int fq_) const {
        int fr = fr_, fq = fq_; asm volatile("" : "+v"(fr), "+v"(fq));
        const int row0 = u.pm * BM + wr * 64 + fr, col0 = u.pn * BM + wc * 32 + 8 * fq;
#pragma unroll
        for (int ai = 0; ai < 2; ++ai)
#pragma unroll
            for (int mp = 0; mp < 2; ++mp) {
                f32x4 hh[2][2][2]; u32x4 pq[2][2];
#pragma unroll
                for (int mm = 0; mm < 2; ++mm)
#pragma unroll
                    for (int bj = 0; bj < 2; ++bj) { const size_t off = (size_t)(row0 + ai * HALF + (2 * mp + mm) * 16) * 2048 + col0 + bj * HALF;
                        hh[mm][bj][0] = *(const f32x4*)(H + off); hh[mm][bj][1] = *(const f32x4*)(H + off + 4); pq[mm][bj] = *(const u32x4*)(PP + off); }
#pragma unroll
                for (int mm = 0; mm < 2; ++mm) { const int m = 2 * mp + mm; const int row = row0 + ai * HALF + m * 16; float s = 0.f;
#pragma unroll
                    for (int bj = 0; bj < 2; ++bj) { const size_t off = (size_t)row * 2048 + col0 + bj * HALF; float* hp = H + off;
                        const f32x4 h0 = hh[mm][bj][0], h1 = hh[mm][bj][1]; const u32x4 pp = pq[mm][bj];
                        const f32x4 a0 = acc[ai][bj][m][0], a1 = acc[ai][bj][m][1]; f32x4 o0, o1;
                        o0[0] = h0[0] + bflo(pp.x) * sigm(a0[0]); o0[1] = h0[1] + bfhi(pp.x) * sigm(a0[1]); o0[2] = h0[2] + bflo(pp.y) * sigm(a0[2]); o0[3] = h0[3] + bfhi(pp.y) * sigm(a0[3]);
                        o1[0] = h1[0] + bflo(pp.z) * sigm(a1[0]); o1[1] = h1[1] + bfhi(pp.z) * sigm(a1[1]); o1[2] = h1[2] + bflo(pp.w) * sigm(a1[2]); o1[3] = h1[3] + bfhi(pp.w) * sigm(a1[3]);
                        *(f32x4*)hp = o0; *(f32x4*)(hp + 4) = o1;
                        if (HB) *(u32x4*)(HB + off) = pack8(o0, o1);
                        s += (o0[0] * o0[0] + o0[1] * o0[1]) + (o0[2] * o0[2] + o0[3] * o0[3]) + (o1[0] * o1[0] + o1[1] * o1[1]) + (o1[2] * o1[2] + o1[3] * o1[3]); }
                    if (ssq) { s += __shfl_xor(s, 16); s += __shfl_xor(s, 32); if (fq == 0) __hip_atomic_fetch_add(ssq + row, s, __ATOMIC_RELAXED, __HIP_MEMORY_SCOPE_AGENT); } } }
    }
};
struct EpiC {
    static constexpr bool PERM = true, AFTER_DRAIN = false;
    bf16_t* U0; size_t ustride; const float* ssq; float* vsum; float* vsq;
    __device__ __forceinline__ void operator()(const f32x4 (&acc)[2][2][4][2], const Unit& u, int wr, int wc, int fr_, int fq_) const {
        int fr = fr_, fq = fq_; asm volatile("" : "+v"(fr), "+v"(fq));
        const int seg = u.pn >> 3; bf16_t* base = U0 + (size_t)seg * ustride;
        const int row0 = u.pm * BM + wr * 64 + fr, col0 = (u.pn & 7) * BM + wc * 32 + 8 * fq;
        float rsv[2][4];
        PG8_FOR_AI_M rsv[ai][m] = __builtin_amdgcn_rsqf(ssq[row0 + ai * HALF + m * 16] * (1.f / 2048.f) + 1e-6f);
        PG8_FOR_AI_M { const int row = row0 + ai * HALF + m * 16; const float rs = rsv[ai][m]; float s1 = 0.f, s2 = 0.f; bf16_t* rp = base + (size_t)row * 2048 + col0;
#pragma unroll
            for (int bj = 0; bj < 2; ++bj) { f32x4 v0 = acc[ai][bj][m][0] * rs, v1 = acc[ai][bj][m][1] * rs;
                if (seg < 2) { f32x2 a = gelu_pk((f32x2){v0[0], v0[1]}), b = gelu_pk((f32x2){v0[2], v0[3]}), c = gelu_pk((f32x2){v1[0], v1[1]}), d = gelu_pk((f32x2){v1[2], v1[3]});
                    v0 = (f32x4){a.x, a.y, b.x, b.y}; v1 = (f32x4){c.x, c.y, d.x, d.y}; }
                else {
#pragma unroll
                    for (int i = 0; i < 4; ++i) { v0[i] = v0[i] * sigm(v0[i]); v1[i] = v1[i] * sigm(v1[i]); } }
                *(u32x4*)(rp + bj * HALF) = pack8(v0, v1);
                if (seg == 1) { s1 += (v0[0] + v0[1]) + (v0[2] + v0[3]) + (v1[0] + v1[1]) + (v1[2] + v1[3]);
                    s2 += (v0[0] * v0[0] + v0[1] * v0[1]) + (v0[2] * v0[2] + v0[3] * v0[3]) + (v1[0] * v1[0] + v1[1] * v1[1]) + (v1[2] * v1[2] + v1[3] * v1[3]); } }
            if (seg == 1) { s1 += __shfl_xor(s1, 16); s1 += __shfl_xor(s1, 32); s2 += __shfl_xor(s2, 16); s2 += __shfl_xor(s2, 32);
                if (fq == 0) { __hip_atomic_fetch_add(vsum + row, s1, __ATOMIC_RELAXED, __HIP_MEMORY_SCOPE_AGENT); __hip_atomic_fetch_add(vsq + row, s2, __ATOMIC_RELAXED, __HIP_MEMORY_SCOPE_AGENT); } } }
    }
};
template <class Epi, class Sched, bool ALIGN_EPI = false, bool SP2 = false>
__device__ __forceinline__ void gemm_phase(PG8_LAS unsigned char* lds, const Gemm g, const Sched& S, const Epi& E, const int tid_in) {
    const int tid = tid_in, wid = __builtin_amdgcn_readfirstlane(tid >> 6), lane = tid & 63, wr = wid >> 2, wc = wid & 3, fr = lane & 15, fq = lane >> 4;
    const int K = g.K, nt = K / BK;
    unsigned voffA[2], voffB[2];
#pragma unroll
    for (int i = 0; i < 2; ++i) { int R, C; stage_rc(tid * 16 + i * 8192, R, C); const int Rb = Epi::PERM ? ((R & ~31) + perm32(R & 31)) : R;
        voffA[i] = (unsigned)(R * K + C) * 2u; voffB[i] = (unsigned)(Rb * K + C) * 2u; }
    const size_t kstep = (size_t)(BK * 2);
    const size_t hstep = (size_t)HALF * K * 2;
    const size_t tstep = 2 * hstep;
    const unsigned ldsw = (unsigned)wid * 1024u;
    const int aoff = lds_byte(wr * 64 + fr, fq * 8), boff = lds_byte(wc * 32 + fr, fq * 8);
#define PG8_SA(b, h) (((b) * 2 + (h)) * HTB)
#define PG8_SB(b, h) ((4 + (b) * 2 + (h)) * HTB)
#define PG8_STAGE(bufoff, gbase, voff) do { _Pragma("unroll") for (int _i = 0; _i < 2; ++_i) \
        __builtin_amdgcn_global_load_lds((const unsigned*)((const char*)(gbase) + (voff)[_i]), (PG8_LAS unsigned*)(lds + (bufoff) + ldsw + _i * 8192), 16, 0, 0); } while (0)
#define PG8_LDA(dst, b, h) do { _Pragma("unroll") for (int m = 0; m < 4; ++m) _Pragma("unroll") for (int k = 0; k < 2; ++k) dst[m][k] = *(const PG8_LAS bf16x8*)(lds + PG8_SA(b, h) + aoff + m * 2048 + k * 1024); } while (0)
#define PG8_LDB(dst, b, h) do { _Pragma("unroll") for (int n = 0; n < 2; ++n) _Pragma("unroll") for (int k = 0; k < 2; ++k) dst[n][k] = *(const PG8_LAS bf16x8*)(lds + PG8_SB(b, h) + boff + n * 2048 + k * 1024); } while (0)
#define PG8_MMA(ai, bj, At, Bt) do { __builtin_amdgcn_s_setprio(1); _Pragma("unroll") for (int m = 0; m < 4; ++m) _Pragma("unroll") for (int n = 0; n < 2; ++n) _Pragma("unroll") for (int k = 0; k < 2; ++k) \
        acc[ai][bj][m][n] = __builtin_amdgcn_mfma_f32_16x16x32_bf16(Bt[n][k], At[m][k], acc[ai][bj][m][n], 0, 0, 0); __builtin_amdgcn_s_setprio(0); } while (0)
#define PG8_WAIT_V(n) asm volatile("s_waitcnt vmcnt(" #n ")" ::: "memory")
#define PG8_WAIT_L(n) asm volatile("s_waitcnt lgkmcnt(" #n ")" ::: "memory")
#define PG8_BAR __builtin_amdgcn_s_barrier()
#define PG8_SCHED __builtin_amdgcn_sched_barrier(0)
    Unit cur, nxt; int ui = 0;
    if (!S.next(0, cur)) return;
    f32x4 acc[2][2][4][2];
#pragma unroll
    for (int a = 0; a < 2; ++a)
#pragma unroll
        for (int b = 0; b < 2; ++b)
#pragma unroll
            for (int m = 0; m < 4; ++m)
#pragma unroll
                for (int n = 0; n < 2; ++n) acc[a][b][m][n] = (f32x4){0.f, 0.f, 0.f, 0.f};
    bf16x8 At[4][2], B0[2][2], B1[2][2];
    const char* cA = (const char*)g.A + (size_t)cur.pm * tstep; const char* cB = (const char*)g.Bt + (size_t)cur.pn * tstep;
    S.a_ready(cur);
    if constexpr (SP2) {
        PG8_STAGE(PG8_SB(0, 0), cB, voffB); PG8_STAGE(PG8_SB(0, 1), cB + hstep, voffB); PG8_STAGE(PG8_SA(0, 0), cA, voffA); PG8_STAGE(PG8_SA(0, 1), cA + hstep, voffA);
        if (wr == 1) PG8_BAR;
        PG8_WAIT_V(2); PG8_BAR;
        PG8_STAGE(PG8_SB(1, 0), cB + kstep, voffB); PG8_STAGE(PG8_SA(1, 0), cA + kstep, voffA); PG8_STAGE(PG8_SB(1, 1), cB + hstep + kstep, voffB);
        PG8_WAIT_V(6); PG8_BAR;
    } else {
        PG8_STAGE(PG8_SB(0, 0), cB, voffB); PG8_STAGE(PG8_SA(0, 0), cA, voffA); PG8_STAGE(PG8_SB(0, 1), cB + hstep, voffB); PG8_STAGE(PG8_SA(0, 1), cA + hstep, voffA);
        if (wr == 1) PG8_BAR;
        PG8_WAIT_V(4); PG8_BAR;
        PG8_STAGE(PG8_SB(1, 0), cB + kstep, voffB); PG8_STAGE(PG8_SA(1, 0), cA + kstep, voffA); PG8_STAGE(PG8_SB(1, 1), cB + hstep + kstep, voffB);
        PG8_WAIT_V(6); PG8_BAR;
    }
    for (;;) {
        const bool has_next = S.next(ui + 1, nxt);
        const char* nA = has_next ? (const char*)g.A + (size_t)nxt.pm * tstep : cA; const char* nB = has_next ? (const char*)g.Bt + (size_t)nxt.pn * tstep : cB;
        for (int t = 0; t < nt; t += 2) {
            const bool last = (t == nt - 2);
            const char* a1 = cA + (size_t)(t + 1) * kstep;
            const char* a2 = last ? nA : cA + (size_t)(t + 2) * kstep; const char* b2 = last ? nB : cB + (size_t)(t + 2) * kstep;
            const char* a3 = a2 + kstep; const char* b3 = b2 + kstep;
            if (last && has_next) S.a_ready(nxt);
            if constexpr (SP2) {
            PG8_LDB(B0, 0, 0); PG8_LDB(B1, 0, 1); PG8_SCHED; PG8_LDA(At, 0, 0); PG8_STAGE(PG8_SA(1, 1), a1 + hstep, voffA);
            PG8_WAIT_V(8); PG8_WAIT_L(0); PG8_BAR; PG8_MMA(0, 0, At, B0); PG8_MMA(0, 1, At, B1); PG8_BAR; PG8_SCHED;
            PG8_LDA(At, 0, 1); PG8_STAGE(PG8_SB(0, 0), b2, voffB); PG8_STAGE(PG8_SB(0, 1), b2 + hstep, voffB); PG8_STAGE(PG8_SA(0, 0), a2, voffA);
            PG8_WAIT_V(8); PG8_WAIT_L(0); PG8_BAR; PG8_MMA(1, 0, At, B0); PG8_MMA(1, 1, At, B1); PG8_BAR; PG8_SCHED;
            PG8_LDB(B0, 1, 0); PG8_LDB(B1, 1, 1); PG8_SCHED; PG8_LDA(At, 1, 0); PG8_STAGE(PG8_SA(0, 1), a2 + hstep, voffA);
            PG8_WAIT_V(8); PG8_WAIT_L(0); PG8_BAR; PG8_MMA(0, 0, At, B0); PG8_MMA(0, 1, At, B1); PG8_BAR; PG8_SCHED;
            PG8_LDA(At, 1, 1); PG8_STAGE(PG8_SB(1, 0), b3, voffB); PG8_STAGE(PG8_SB(1, 1), b3 + hstep, voffB); PG8_STAGE(PG8_SA(1, 0), a3, voffA);
            PG8_WAIT_V(8); PG8_WAIT_L(0); PG8_BAR; PG8_MMA(1, 0, At, B0); PG8_MMA(1, 1, At, B1); PG8_BAR; PG8_SCHED;
            } else {
            PG8_LDB(B0, 0, 0); PG8_SCHED; PG8_LDA(At, 0, 0); PG8_STAGE(PG8_SA(1, 1), a1 + hstep, voffA);
            PG8_WAIT_L(8); PG8_BAR; PG8_WAIT_L(0); PG8_MMA(0, 0, At, B0); PG8_BAR; PG8_SCHED;
            PG8_LDB(B1, 0, 1); PG8_STAGE(PG8_SB(0, 0), b2, voffB);
            PG8_BAR; PG8_WAIT_L(0); PG8_MMA(0, 1, At, B1); PG8_BAR;
            PG8_LDA(At, 0, 1); PG8_STAGE(PG8_SA(0, 0), a2, voffA);
            PG8_BAR; PG8_WAIT_L(0); PG8_MMA(1, 0, At, B0); PG8_BAR; PG8_SCHED;
            PG8_STAGE(PG8_SB(0, 1), b2 + hstep, voffB);
            PG8_WAIT_V(6); PG8_BAR; PG8_MMA(1, 1, At, B1); PG8_BAR;
            PG8_LDB(B0, 1, 0); PG8_SCHED; PG8_LDA(At, 1, 0); PG8_STAGE(PG8_SA(0, 1), a2 + hstep, voffA);
            PG8_WAIT_L(8); PG8_BAR; PG8_WAIT_L(0); PG8_MMA(0, 0, At, B0); PG8_BAR; PG8_SCHED;
            PG8_LDB(B1, 1, 1); PG8_STAGE(PG8_SB(1, 0), b3, voffB);
            PG8_BAR; PG8_WAIT_L(0); PG8_MMA(0, 1, At, B1); PG8_BAR;
            PG8_LDA(At, 1, 1); PG8_STAGE(PG8_SA(1, 0), a3, voffA);
            PG8_BAR; PG8_WAIT_L(0); PG8_MMA(1, 0, At, B0); PG8_BAR; PG8_SCHED;
            PG8_STAGE(PG8_SB(1, 1), b3 + hstep, voffB);
            PG8_WAIT_V(6); PG8_BAR; PG8_MMA(1, 1, At, B1); PG8_BAR;
            }
        }
        if constexpr (ALIGN_EPI) { if (wr == 0) PG8_BAR; }
        if constexpr (!Epi::AFTER_DRAIN) { E(acc, cur, wr, wc, fr, fq); S.done(cur); }
        if (!has_next) break;
#pragma unroll
        for (int a = 0; a < 2; ++a)
#pragma unroll
            for (int b = 0; b < 2; ++b)
#pragma unroll
                for (int m = 0; m < 4; ++m)
#pragma unroll
                    for (int n = 0; n < 2; ++n) acc[a][b][m][n] = (f32x4){0.f, 0.f, 0.f, 0.f};
        cur = nxt; cA = nA; cB = nB; ++ui;
        if constexpr (ALIGN_EPI) { if (wr == 1) PG8_BAR; }
    }
    PG8_WAIT_V(0);
    if constexpr (!ALIGN_EPI) { if (wr == 0) PG8_BAR; }
    PG8_BAR;
    if constexpr (Epi::AFTER_DRAIN) { E.fused(acc, cur, wr, wc, fr, fq, lds, wid, lane); S.done(cur); }
#undef PG8_SA
#undef PG8_SB
#undef PG8_STAGE
#undef PG8_LDA
#undef PG8_LDB
#undef PG8_MMA
#undef PG8_WAIT_V
#undef PG8_WAIT_L
#undef PG8_BAR
#undef PG8_SCHED
}
}
constexpr int NB = 16, T = 2048, D = 2048, M = NB * T;
constexpr int N_IN0 = 8448;
constexpr size_t MiB = 1u << 20;
constexpr size_t WS_CTL = 0;
constexpr size_t WS_WIN0 = 2 * MiB, WS_WOUT0 = 35 * MiB, WS_WIN1 = 43 * MiB, WS_WOUT1 = 67 * MiB, WS_WG0 = 75 * MiB, WS_WG1 = 83 * MiB, WS_WP0 = 91 * MiB, WS_WP1 = 92 * MiB;
constexpr size_t WS_HBA = 96 * MiB, WS_PB = 224 * MiB, WS_G = 256 * MiB, WS_SMALL = 768 * MiB, WS_Z = 800 * MiB, WS_END = 928 * MiB;
constexpr int LDS_BYTES = 147456;
constexpr int NWAVES = 8;
typedef unsigned short bf16;
typedef short bf16x8 __attribute__((ext_vector_type(8)));
typedef float f32x4 __attribute__((ext_vector_type(4)));
typedef float f32x16 __attribute__((ext_vector_type(16)));
typedef unsigned u32x4 __attribute__((ext_vector_type(4)));
typedef unsigned u32x2 __attribute__((ext_vector_type(2)));
#define LAS __attribute__((address_space(3)))
#define LDS_WAIT() asm volatile("s_waitcnt lgkmcnt(0)" ::: "memory")
using pg8::cvt_pk_bf16; using pg8::bflo; using pg8::bfhi; using pg8::sigm;
constexpr float LOG2E = 1.4426950408889634f;

__device__ __forceinline__ int my_tid(int wave_s) { return wave_s * 64 + (int)__builtin_amdgcn_mbcnt_hi(~0u, __builtin_amdgcn_mbcnt_lo(~0u, 0u)); }
__device__ __forceinline__ float wave_sum(float v) {
#pragma unroll
    for (int o = 1; o < 64; o <<= 1) v += __shfl_xor(v, o);
    return v;
}
__device__ __forceinline__ float red16(float v) { v += __shfl_xor(v, 1); v += __shfl_xor(v, 2); v += __shfl_xor(v, 4); v += __shfl_xor(v, 8); return v; }

__device__ __forceinline__ void transpose_item(const float* W, int K, int Nsrc, int src_col0, int nvalid, const float* gk, bf16* WT, int dst_row0, float* scr, int kb, int lane) {
    const int k0 = 64 * kb, c = lane & 31;
#pragma unroll 8
    for (int i = 0; i < 32; ++i) { const int kk = 2 * i + (lane >> 5); float v = (c < nvalid) ? W[(size_t)(k0 + kk) * Nsrc + src_col0 + c] : 0.f; if (gk) v *= gk[k0 + kk]; scr[kk * 33 + c] = v; }
    LDS_WAIT();
    const int c8 = lane & 7;
#pragma unroll
    for (int j = 0; j < 4; ++j) { const int n = (lane >> 3) + 8 * j; const float* s = scr + (8 * c8) * 33 + n;
        u32x4 o; o.x = cvt_pk_bf16(s[0 * 33], s[1 * 33]); o.y = cvt_pk_bf16(s[2 * 33], s[3 * 33]); o.z = cvt_pk_bf16(s[4 * 33], s[5 * 33]); o.w = cvt_pk_bf16(s[6 * 33], s[7 * 33]);
        *(u32x4*)(WT + (size_t)(dst_row0 + n) * K + k0 + 8 * c8) = o; }
    LDS_WAIT();
}

struct Ptrs {
    const float *x, *p, *norm_pre, *norm_post, *ab_w_in, *fox_f_bias, *rwkv_mu, *rwkv_w0, *rwkv_w2, *rwkv_a0, *rwkv_a2, *rwkv_k_k, *rwkv_k_a, *rwkv_r_k, *rwkv_ln_g, *rwkv_ln_b,
        *ab_w_out, *c_w_in, *c_ln_g, *c_ln_b, *c_w_s, *c_b_s, *c_w_out, *ple_w_proj, *ple_w_gate;
    float* out; unsigned char* ws; int ph_lo, ph_hi;
};

__device__ __forceinline__ void p0_prologue(const Ptrs& P, unsigned char* lds, const int wave_s) {
    int tid_ = my_tid(wave_s); asm volatile("" : "+v"(tid_)); const int tid = tid_, lane = tid & 63, wave = tid >> 6;
    float* scr = (float*)(lds + wave * 16384);
    const int gw = blockIdx.x * NWAVES + wave, NGW = gridDim.x * NWAVES;
    unsigned char* ws = P.ws;
    if (blockIdx.x < 200) {
        const int c0 = blockIdx.x * 16, r = lane, q = wave; const int bb = r >> 2, t4 = r & 3;
        const float* xr = P.x + ((size_t)bb * T + t4) * D + q * 256; const float* gq = P.norm_pre + q * 256; const float* Wq = P.ab_w_in + (size_t)(q * 256) * 8336 + 4112 + c0;
        f32x4 a0 = {0.f, 0.f, 0.f, 0.f}, a1 = a0, a2 = a0, a3 = a0;
#pragma unroll 2
        for (int k4 = 0; k4 < 64; ++k4) { const f32x4 xv = *(const f32x4*)(xr + 4 * k4) * *(const f32x4*)(gq + 4 * k4);
#pragma unroll
            for (int e = 0; e < 4; ++e) { const float* wr_ = Wq + (size_t)(4 * k4 + e) * 8336; const f32x4 w0 = *(const f32x4*)wr_, w1 = *(const f32x4*)(wr_ + 4), w2 = *(const f32x4*)(wr_ + 8), w3 = *(const f32x4*)(wr_ + 12);
                a0 += xv[e] * w0; a1 += xv[e] * w1; a2 += xv[e] * w2; a3 += xv[e] * w3; } }
        float* part = (float*)lds + (q * 64 + r) * 16;
        *(f32x4*)part = a0; *(f32x4*)(part + 4) = a1; *(f32x4*)(part + 8) = a2; *(f32x4*)(part + 12) = a3;
        __syncthreads();
        float* EXG = (float*)(ws + WS_CTL + 0x100000);
#pragma unroll
        for (int o = tid * 2; o < tid * 2 + 2; ++o) { const int r2 = o >> 4, cc = o & 15; float v = 0.f;
#pragma unroll
            for (int w = 0; w < 8; ++w) v += ((const float*)lds)[(w * 64 + r2) * 16 + cc];
            EXG[(size_t)r2 * 3200 + c0 + cc] = v; }
        __syncthreads();
    }
    { float* z = (float*)(ws + WS_CTL) + M; for (int i = blockIdx.x * 512 + tid; i < 5 * M; i += gridDim.x * 512) z[i] = 0.f; }
    constexpr int I_IN0 = 32 * (N_IN0 / 32), I_SQ = 32 * 64, I_IN1 = 32 * 192, I_PJ = 4 * 64;
    constexpr int NITEMS = I_IN0 + I_SQ + I_IN1 + I_SQ + 2 * I_SQ + 2 * I_PJ;
    for (int it = gw; it < NITEMS; it += NGW) {
        int r = it;
        if (r < I_IN0) { const int nblk = N_IN0 / 32, kb = r / nblk, db = r % nblk; int src, nv = 32;
            if (db < 256) { const int grp = db >> 5; src = grp * 1024 + (grp >= 3 ? 16 : 0) + (grp == 7 ? 128 : 0) + (db & 31) * 32; }
            else if (db < 258) src = 7184 + (db - 256) * 32; else if (db < 260) src = 7248 + (db - 258) * 32; else if (db == 260) { src = 3072; nv = 16; } else { src = 0; nv = 0; }
            transpose_item(P.ab_w_in, 2048, 8336, src, nv, P.norm_pre, (bf16*)(ws + WS_WIN0), db * 32, scr, kb, lane); continue; } r -= I_IN0;
        if (r < I_SQ) { transpose_item(P.ab_w_out, 2048, 2048, (r % 64) * 32, 32, nullptr, (bf16*)(ws + WS_WOUT0), (r % 64) * 32, scr, r / 64, lane); continue; } r -= I_SQ;
        if (r < I_IN1) { transpose_item(P.c_w_in, 2048, 6144, (r % 192) * 32, 32, P.norm_pre + 2048, (bf16*)(ws + WS_WIN1), (r % 192) * 32, scr, r / 192, lane); continue; } r -= I_IN1;
        if (r < I_SQ) { transpose_item(P.c_w_out, 2048, 2048, (r % 64) * 32, 32, nullptr, (bf16*)(ws + WS_WOUT1), (r % 64) * 32, scr, r / 64, lane); continue; } r -= I_SQ;
        if (r < I_SQ) { transpose_item(P.ple_w_gate, 2048, 2048, (r % 64) * 32, 32, nullptr, (bf16*)(ws + WS_WG0), (r % 64) * 32, scr, r / 64, lane); continue; } r -= I_SQ;
        if (r < I_SQ) { transpose_item(P.ple_w_gate + (size_t)2048 * 2048, 2048, 2048, (r % 64) * 32, 32, nullptr, (bf16*)(ws + WS_WG1), (r % 64) * 32, scr, r / 64, lane); continue; } r -= I_SQ;
        if (r < I_PJ) { transpose_item(P.ple_w_proj, 256, 2048, (r % 64) * 32, 32, nullptr, (bf16*)(ws + WS_WP0), (r % 64) * 32, scr, r / 64, lane); continue; } r -= I_PJ;
        transpose_item(P.ple_w_proj + (size_t)256 * 2048, 256, 2048, (r % 64) * 32, 32, nullptr, (bf16*)(ws + WS_WP1), (r % 64) * 32, scr, r / 64, lane);
    }
    { float* ssq0 = (float*)(ws + WS_CTL); bf16* hb = (bf16*)(ws + WS_HBA);
      for (int row = gw; row < M; row += NGW) { const f32x4* xr = (const f32x4*)(P.x + (size_t)row * D) + lane; f32x4 v[8]; float s = 0.f;
#pragma unroll
          for (int j = 0; j < 8; ++j) { v[j] = xr[64 * j]; s += (v[j][0] * v[j][0] + v[j][1] * v[j][1]) + (v[j][2] * v[j][2] + v[j][3] * v[j][3]); }
          s = wave_sum(s); if (lane == 0) ssq0[row] = s;
          u32x2* o = (u32x2*)(hb + (size_t)row * D) + lane;
#pragma unroll
          for (int j = 0; j < 8; ++j) { u32x2 w; w.x = cvt_pk_bf16(v[j][0], v[j][1]); w.y = cvt_pk_bf16(v[j][2], v[j][3]); o[64 * j] = w; } } }
}

__device__ __forceinline__ void post_norm_phase(const float* hin, const bf16* Y, const float* ssq, const float* g, float* hout, bf16* hb, const int wave_s) {
    int tid_ = my_tid(wave_s); asm volatile("" : "+v"(tid_)); const int tid = tid_, lane = tid & 63, wave = tid >> 6;
    const int gw = blockIdx.x * NWAVES + wave, NGW = gridDim.x * NWAVES;
    f32x4 gv[8];
#pragma unroll
    for (int j = 0; j < 8; ++j) gv[j] = *((const f32x4*)g + lane + 64 * j);
    for (int row = gw; row < M; row += NGW) {
        const float rs = __builtin_amdgcn_rsqf(ssq[row] * (1.f / 2048.f) + 1e-6f);
        const f32x4* hr = (const f32x4*)(hin + (size_t)row * D) + lane; const u32x2* yr = (const u32x2*)(Y + (size_t)row * D) + lane;
        f32x4* orow = (f32x4*)(hout + (size_t)row * D) + lane; u32x2* ob = (u32x2*)(hb + (size_t)row * D) + lane;
#pragma unroll
        for (int j = 0; j < 8; ++j) { const f32x4 h = hr[64 * j]; const u32x2 y = yr[64 * j]; f32x4 o;
            o[0] = h[0] + bflo(y.x) * rs * gv[j][0]; o[1] = h[1] + bfhi(y.x) * rs * gv[j][1]; o[2] = h[2] + bflo(y.y) * rs * gv[j][2]; o[3] = h[3] + bfhi(y.y) * rs * gv[j][3];
            orow[64 * j] = o; u32x2 w; w.x = cvt_pk_bf16(o[0], o[1]); w.y = cvt_pk_bf16(o[2], o[3]); ob[64 * j] = w; }
    }
}

__device__ __forceinline__ int crow(int r, int hi) { return (r & 3) + 8 * (r >> 2) + 4 * hi; }
__device__ __forceinline__ void attn_phase(unsigned char* lds, const bf16* Qg, const bf16* Kg, const bf16* Vg, const bf16* GAg, const float* small, const float* fbias, bf16* Z, const int wave_s) {
    int tid_ = my_tid(wave_s); asm volatile("" : "+v"(tid_)); const int tid = tid_, lane = tid & 63, wid = __builtin_amdgcn_readfirstlane(tid >> 6), r32 = lane & 31, hi = lane >> 5;
    float* c2 = (float*)lds;
    float* wtot = (float*)(lds + 8192);
    bf16* Ks = (bf16*)(lds + 8192 + 64);
    bf16* Vt = Ks + 64 * 72;
    for (int bh = blockIdx.x; bh < 256; bh += gridDim.x) {
        const int b = bh >> 4, h = bh & 15; const size_t rowbase = (size_t)b * T;
        __syncthreads();
        { float lf[4]; const float fb = fbias[h]; float run = 0.f;
#pragma unroll
          for (int i = 0; i < 4; ++i) { const float xg = small[(rowbase + 4 * tid + i) * 256 + 128 + h] + fb; const float ls = fminf(xg, 0.f) - log1pf(__expf(-fabsf(xg))); run += ls; lf[i] = run; }
          float sc = run;
#pragma unroll
          for (int o = 1; o < 64; o <<= 1) { const float t = __shfl_up(sc, o); if (lane >= o) sc += t; }
          if (lane == 63) wtot[wid] = sc;
          __syncthreads();
          float off = sc - run;
#pragma unroll
          for (int w = 0; w < 8; ++w) if (w < wid) off += wtot[w];
#pragma unroll
          for (int i = 0; i < 4; ++i) c2[4 * tid + i] = (off + lf[i]) * LOG2E; }
        __syncthreads();
        for (int qb = 0; qb < 8; ++qb) {
            const int q0w = qb * 256 + wid * 32, q = q0w + r32;
            bf16x8 qr[4];
#pragma unroll
            for (int d0 = 0; d0 < 4; ++d0) qr[d0] = *(const bf16x8*)(Qg + (rowbase + q) * 1024 + h * 64 + d0 * 16 + hi * 8);
            const float cq = c2[q];
            f32x16 o0, o1;
#pragma unroll
            for (int r = 0; r < 16; ++r) { o0[r] = 0.f; o1[r] = 0.f; }
            float mrow = -1e30f, l = 0.f;
            const int NT = qb * 4 + 4;
            const int kr = tid >> 3, ch = tid & 7, vr = lane, vc = wid;
            const bf16* kgp = Kg + (rowbase + kr) * 1024 + h * 64 + ch * 8; const bf16* vgp = Vg + (rowbase + vr) * 1024 + h * 64 + vc * 8;
            u32x4 kreg = *(const u32x4*)kgp, vreg = *(const u32x4*)vgp;
            for (int t = 0; t < NT; ++t) {
                asm volatile("s_waitcnt lgkmcnt(0)\n\ts_barrier" ::: "memory");
                { *(u32x4*)(Ks + kr * 72 + ch * 8) = kreg; bf16* vt = Vt + (vc * 8) * 72 + vr;
                  vt[0 * 72] = (bf16)(vreg.x & 0xffffu); vt[1 * 72] = (bf16)(vreg.x >> 16); vt[2 * 72] = (bf16)(vreg.y & 0xffffu); vt[3 * 72] = (bf16)(vreg.y >> 16);
                  vt[4 * 72] = (bf16)(vreg.z & 0xffffu); vt[5 * 72] = (bf16)(vreg.z >> 16); vt[6 * 72] = (bf16)(vreg.w & 0xffffu); vt[7 * 72] = (bf16)(vreg.w >> 16);
                  if (t + 1 < NT) { kreg = *(const u32x4*)(kgp + (size_t)(t + 1) * 64 * 1024); vreg = *(const u32x4*)(vgp + (size_t)(t + 1) * 64 * 1024); } }
                asm volatile("s_waitcnt lgkmcnt(0)\n\ts_barrier" ::: "memory");
                if (t * 64 <= q0w + 31) {
                    f32x16 p0, p1;
#pragma unroll
                    for (int r = 0; r < 16; ++r) { p0[r] = 0.f; p1[r] = 0.f; }
#pragma unroll
                    for (int d0 = 0; d0 < 4; ++d0) { const bf16x8 k0 = *(const bf16x8*)(Ks + r32 * 72 + d0 * 16 + hi * 8), k1 = *(const bf16x8*)(Ks + (32 + r32) * 72 + d0 * 16 + hi * 8);
                        p0 = __builtin_amdgcn_mfma_f32_32x32x16_bf16(k0, qr[d0], p0, 0, 0, 0); p1 = __builtin_amdgcn_mfma_f32_32x32x16_bf16(k1, qr[d0], p1, 0, 0, 0); }
                    const int kvb = t * 64 + 4 * hi;
#pragma unroll
                    for (int g4 = 0; g4 < 4; ++g4) { const f32x4 ca = *(const f32x4*)(c2 + kvb + 8 * g4), cb = *(const f32x4*)(c2 + kvb + 32 + 8 * g4);
#pragma unroll
                        for (int i = 0; i < 4; ++i) { p0[4 * g4 + i] += cq - ca[i]; p1[4 * g4 + i] += cq - cb[i]; } }
                    if (t * 64 + 63 > q0w) {
#pragma unroll
                        for (int r = 0; r < 16; ++r) { const int kv = kvb + (r & 3) + 8 * (r >> 2); if (kv > q) p0[r] = -1e30f; if (kv + 32 > q) p1[r] = -1e30f; } }
                    float mx = fmaxf(p0[0], p1[0]);
#pragma unroll
                    for (int r = 1; r < 16; ++r) mx = fmaxf(mx, fmaxf(p0[r], p1[r]));
                    mx = fmaxf(mx, __shfl_xor(mx, 32));
                    const float mnew = fmaxf(mrow, mx), alpha = __builtin_amdgcn_exp2f(mrow - mnew); mrow = mnew;
                    l *= alpha; float ls = 0.f;
#pragma unroll
                    for (int r = 0; r < 16; ++r) { o0[r] *= alpha; o1[r] *= alpha; p0[r] = __builtin_amdgcn_exp2f(p0[r] - mnew); p1[r] = __builtin_amdgcn_exp2f(p1[r] - mnew); ls += p0[r] + p1[r]; }
                    l += ls;
                    u32x4 pw[4];
#pragma unroll
                    for (int s = 0; s < 2; ++s) { pw[s].x = cvt_pk_bf16(p0[8 * s + 0], p0[8 * s + 1]); pw[s].y = cvt_pk_bf16(p0[8 * s + 2], p0[8 * s + 3]); pw[s].z = cvt_pk_bf16(p0[8 * s + 4], p0[8 * s + 5]); pw[s].w = cvt_pk_bf16(p0[8 * s + 6], p0[8 * s + 7]);
                        pw[2 + s].x = cvt_pk_bf16(p1[8 * s + 0], p1[8 * s + 1]); pw[2 + s].y = cvt_pk_bf16(p1[8 * s + 2], p1[8 * s + 3]); pw[2 + s].z = cvt_pk_bf16(p1[8 * s + 4], p1[8 * s + 5]); pw[2 + s].w = cvt_pk_bf16(p1[8 * s + 6], p1[8 * s + 7]); }
#pragma unroll
                    for (int s = 0; s < 4; ++s) { const bf16x8 pf = __builtin_bit_cast(bf16x8, pw[s]);
                        { const bf16* vp = Vt + r32 * 72 + 16 * s + 4 * hi; const u32x2 lo = *(const u32x2*)vp, hi2 = *(const u32x2*)(vp + 8); u32x4 va; va.x = lo.x; va.y = lo.y; va.z = hi2.x; va.w = hi2.y;
                          o0 = __builtin_amdgcn_mfma_f32_32x32x16_bf16(__builtin_bit_cast(bf16x8, va), pf, o0, 0, 0, 0); }
                        { const bf16* vp = Vt + (32 + r32) * 72 + 16 * s + 4 * hi; const u32x2 lo = *(const u32x2*)vp, hi2 = *(const u32x2*)(vp + 8); u32x4 va; va.x = lo.x; va.y = lo.y; va.z = hi2.x; va.w = hi2.y;
                          o1 = __builtin_amdgcn_mfma_f32_32x32x16_bf16(__builtin_bit_cast(bf16x8, va), pf, o1, 0, 0, 0); } }
                }
            }
            l += __shfl_xor(l, 32); const float inv = 1.f / l;
#pragma unroll
            for (int g4 = 0; g4 < 4; ++g4) {
                { const int d = 8 * g4 + 4 * hi; const u32x2 gg = *(const u32x2*)(GAg + (rowbase + q) * 1024 + h * 64 + d);
                  const float g0 = bflo(gg.x), g1 = bfhi(gg.x), g2 = bflo(gg.y), g3 = bfhi(gg.y); u32x2 w;
                  w.x = cvt_pk_bf16(o0[4 * g4 + 0] * inv * g0 * sigm(g0), o0[4 * g4 + 1] * inv * g1 * sigm(g1)); w.y = cvt_pk_bf16(o0[4 * g4 + 2] * inv * g2 * sigm(g2), o0[4 * g4 + 3] * inv * g3 * sigm(g3));
                  *(u32x2*)(Z + (rowbase + q) * 2048 + h * 64 + d) = w; }
                { const int d = 32 + 8 * g4 + 4 * hi; const u32x2 gg = *(const u32x2*)(GAg + (rowbase + q) * 1024 + h * 64 + d);
                  const float g0 = bflo(gg.x), g1 = bfhi(gg.x), g2 = bflo(gg.y), g3 = bfhi(gg.y); u32x2 w;
                  w.x = cvt_pk_bf16(o1[4 * g4 + 0] * inv * g0 * sigm(g0), o1[4 * g4 + 1] * inv * g1 * sigm(g1)); w.y = cvt_pk_bf16(o1[4 * g4 + 2] * inv * g2 * sigm(g2), o1[4 * g4 + 3] * inv * g3 * sigm(g3));
                  *(u32x2*)(Z + (rowbase + q) * 2048 + h * 64 + d) = w; }
            }
        }
    }
}
__device__ __forceinline__ float exp_fast(float x) { return __builtin_amdgcn_exp2f(1.4426950408889634f * x); }
__device__ __forceinline__ float softplusf_(float z) { return fmaxf(z, 0.f) + 0.6931471805599453f * __builtin_amdgcn_logf(1.0f + exp_fast(-fabsf(z))); }
__device__ __forceinline__ float tanh_fast(float x) { return 1.0f - 2.0f * __builtin_amdgcn_rcpf(1.0f + __builtin_amdgcn_exp2f(2.885390081777927f * x)); }
__device__ __forceinline__ void rwkv_phase(unsigned char* lds, const Ptrs& P, const bf16* Rg, const bf16* Kg, const bf16* Vg, const bf16* GBg, const float* small, bf16* Z, const int wave_s) {
    int tid_ = my_tid(wave_s); asm volatile("" : "+v"(tid_)); const int tid = tid_, lane = tid & 63, wv = __builtin_amdgcn_readfirstlane(tid >> 6);
#define RW_BAR() asm volatile("s_waitcnt lgkmcnt(0)\n\ts_barrier" ::: "memory")
    bf16* W2t = (bf16*)lds;
    bf16* A2t = W2t + 64 * 72;
    float* DL = (float*)lds + 4608;
    float* TW = DL + 4096;
    float* AL = TW + 2176;
    float* Rr = AL + 2176;
    float* Vv = Rr + 10240;
    float* Yb = Vv + 2048;
    float* red = Yb + 2048;
    float* Uu = red + 2048;
    float* CC = Uu + 1024;
    float* Cc = CC + 64;
    const int tt = tid >> 4, c4 = (tid & 15) * 4;
    for (int bh = blockIdx.x; bh < 256; bh += gridDim.x) {
        const int b = bh >> 4, h = bh & 15, hc = h * 64 + c4; const size_t rowbase = (size_t)b * T;
        __syncthreads();
        for (int i = tid; i < 4096; i += 512) { const int k = i >> 6, c = i & 63; W2t[c * 72 + k] = (bf16)(cvt_pk_bf16(P.rwkv_w2[(size_t)k * 1024 + h * 64 + c], 0.f) & 0xffffu); A2t[c * 72 + k] = (bf16)(cvt_pk_bf16(P.rwkv_a2[(size_t)k * 1024 + h * 64 + c], 0.f) & 0xffffu); }
        if (tid < 16) { const int cc = tid * 4, hcc = h * 64 + cc;
            *(f32x4*)(Cc + 0 * 64 + cc) = *(const f32x4*)(P.rwkv_mu + hcc); *(f32x4*)(Cc + 1 * 64 + cc) = *(const f32x4*)(P.rwkv_mu + 1024 + hcc); *(f32x4*)(Cc + 2 * 64 + cc) = *(const f32x4*)(P.rwkv_mu + 2048 + hcc);
            *(f32x4*)(Cc + 3 * 64 + cc) = *(const f32x4*)(P.rwkv_mu + 3072 + cc); *(f32x4*)(Cc + 4 * 64 + cc) = *(const f32x4*)(P.rwkv_mu + 3136 + cc);
            *(f32x4*)(Cc + 5 * 64 + cc) = *(const f32x4*)(P.rwkv_w0 + hcc); *(f32x4*)(Cc + 6 * 64 + cc) = *(const f32x4*)(P.rwkv_a0 + hcc); *(f32x4*)(Cc + 7 * 64 + cc) = *(const f32x4*)(P.rwkv_k_k + hcc);
            *(f32x4*)(Cc + 8 * 64 + cc) = *(const f32x4*)(P.rwkv_k_a + hcc); *(f32x4*)(Cc + 9 * 64 + cc) = *(const f32x4*)(P.rwkv_r_k + hcc); *(f32x4*)(Cc + 10 * 64 + cc) = *(const f32x4*)(P.rwkv_ln_g + hcc);
            *(f32x4*)(Cc + 11 * 64 + cc) = *(const f32x4*)(P.rwkv_ln_b + hcc); }
#define CV(k) (*(const f32x4*)(Cc + (k) * 64 + c4))
        f32x4 Sv[4];
#pragma unroll
        for (int g = 0; g < 4; ++g) Sv[g] = (f32x4){0.f, 0.f, 0.f, 0.f};
        { float* const EX = red; const float* exg = (const float*)(P.ws + WS_CTL + 0x100000) + (size_t)(b * 4) * 3200;
          for (int i = tid; i < 1280; i += 512) { const int q = i / 320, cc = i - q * 320; const int col = (cc < 192) ? ((cc >> 6) * 1024 + h * 64 + (cc & 63)) : (3072 + (cc - 192));
              EX[i] = exg[q * 3200 + col] * __builtin_amdgcn_rsqf(((const float*)(P.ws + WS_CTL))[rowbase + q] * (1.f / 2048.f) + 1e-6f); }
          __syncthreads(); }
        u32x2 n_rc, n_kc, n_vc, n_gg, n_rp = {0u, 0u}, n_kp = {0u, 0u}, n_vp = {0u, 0u}; f32x4 n_wl, n_al, n_wlp = {0.f, 0.f, 0.f, 0.f}, n_alp = {0.f, 0.f, 0.f, 0.f};
#define RW_FETCH(ckk) do { const size_t row_ = rowbase + (ckk) * 32 + tt; \
            n_rc = *(const u32x2*)(Rg + row_ * 1024 + hc); n_kc = *(const u32x2*)(Kg + row_ * 1024 + hc); n_vc = *(const u32x2*)(Vg + row_ * 1024 + hc); \
            n_wl = *(const f32x4*)(small + row_ * 256 + c4); n_al = *(const f32x4*)(small + row_ * 256 + 64 + c4); } while (0)
        RW_FETCH(0); n_gg = *(const u32x2*)(GBg + (rowbase + tt) * 1024 + hc);
#define RW_FETCH_PREV(rowp) do { n_rp = *(const u32x2*)(Rg + (rowp) * 1024 + hc); n_kp = *(const u32x2*)(Kg + (rowp) * 1024 + hc); n_vp = *(const u32x2*)(Vg + (rowp) * 1024 + hc); \
            n_wlp = *(const f32x4*)(small + (rowp) * 256 + c4); n_alp = *(const f32x4*)(small + (rowp) * 256 + 64 + c4); } while (0)
        if (tt > 0) RW_FETCH_PREV(rowbase + tt - 1);
        for (int ck = 0; ck < T / 32; ++ck) {
            const int t = ck * 32 + tt; const size_t row = rowbase + t;
            f32x4 rs, ks, vs;
            { const f32x4 mu_r = CV(0), mu_k = CV(1), mu_v = CV(2), mu_w = CV(3), mu_a = CV(4);
              const u32x2 rc = n_rc, kc = n_kc, vc = n_vc, rp = n_rp, kp = n_kp, vp = n_vp; f32x4 wl = n_wl, al = n_al, wlp = n_wlp, alp = n_alp;
              f32x4 rcf = {bflo(rc.x), bfhi(rc.x), bflo(rc.y), bfhi(rc.y)}, rpf = {bflo(rp.x), bfhi(rp.x), bflo(rp.y), bfhi(rp.y)};
              f32x4 kcf = {bflo(kc.x), bfhi(kc.x), bflo(kc.y), bfhi(kc.y)}, kpf = {bflo(kp.x), bfhi(kp.x), bflo(kp.y), bfhi(kp.y)};
              f32x4 vcf = {bflo(vc.x), bfhi(vc.x), bflo(vc.y), bfhi(vc.y)}, vpf = {bflo(vp.x), bfhi(vp.x), bflo(vp.y), bfhi(vp.y)};
              if (t < 4) { const float* ex = red + t * 320; rcf = *(const f32x4*)(ex + c4); kcf = *(const f32x4*)(ex + 64 + c4); vcf = *(const f32x4*)(ex + 128 + c4); wl = *(const f32x4*)(ex + 192 + c4); al = *(const f32x4*)(ex + 256 + c4);
                  if (t > 0) { const float* ep = ex - 320; rpf = *(const f32x4*)(ep + c4); kpf = *(const f32x4*)(ep + 64 + c4); vpf = *(const f32x4*)(ep + 128 + c4); wlp = *(const f32x4*)(ep + 192 + c4); alp = *(const f32x4*)(ep + 256 + c4); } }
              rs = rcf + (rpf - rcf) * mu_r; ks = kcf + (kpf - kcf) * mu_k; vs = vcf + (vpf - vcf) * mu_v;
              wl = wl + (wlp - wl) * mu_w; al = al + (alp - al) * mu_a;
              f32x4 tw; tw[0] = tanh_fast(wl[0]); tw[1] = tanh_fast(wl[1]); tw[2] = tanh_fast(wl[2]); tw[3] = tanh_fast(wl[3]);
              RW_BAR();
              *(f32x4*)(TW + tt * 68 + c4) = tw; *(f32x4*)(AL + tt * 68 + c4) = al; }
            RW_BAR();
            float bon;
            if (wv < 4) { const int mat = wv >> 1, nt = wv & 1, r32 = lane & 31, hi5 = lane >> 5; const float* X = (mat ? AL : TW) + r32 * 68 + 8 * hi5; const bf16* Wt = (mat ? A2t : W2t) + (nt * 32 + r32) * 72 + 8 * hi5;
                f32x16 acc;
#pragma unroll
                for (int r = 0; r < 16; ++r) acc[r] = 0.f;
#pragma unroll
                for (int ks = 0; ks < 4; ++ks) { const f32x4 xa = *(const f32x4*)(X + 16 * ks), xb = *(const f32x4*)(X + 16 * ks + 4);
                    u32x4 ap; ap.x = cvt_pk_bf16(xa[0], xa[1]); ap.y = cvt_pk_bf16(xa[2], xa[3]); ap.z = cvt_pk_bf16(xb[0], xb[1]); ap.w = cvt_pk_bf16(xb[2], xb[3]);
                    const bf16x8 bp = *(const bf16x8*)(Wt + 16 * ks);
                    acc = __builtin_amdgcn_mfma_f32_32x32x16_bf16(__builtin_bit_cast(bf16x8, ap), bp, acc, 0, 0, 0); }
#pragma unroll
                for (int r = 0; r < 16; ++r) DL[mat * 2048 + ((r & 3) + 8 * (r >> 2) + 4 * hi5) * 64 + nt * 32 + r32] = acc[r]; }
            RW_BAR();
            { const f32x4 w0v = CV(5), a0v = CV(6), kkg = CV(7), kag = CV(8), rkg = CV(9); f32x4 wpre = w0v + *(const f32x4*)(DL + tt * 64 + c4), apre = a0v + *(const f32x4*)(DL + 2048 + tt * 64 + c4);
              f32x4 dec, av, kk, kp, bb; float ss = 0.f, bs = 0.f;
#pragma unroll
              for (int i = 0; i < 4; ++i) { const float wraw = -softplusf_(-wpre[i]) - 0.5f; dec[i] = exp_fast(-exp_fast(wraw)); av[i] = __builtin_amdgcn_rcpf(1.f + exp_fast(-apre[i])); kk[i] = ks[i] * kkg[i]; ss += kk[i] * kk[i]; }
              ss = red16(ss); const float inrm = __builtin_amdgcn_rsqf(fmaxf(ss, 1e-24f));
#pragma unroll
              for (int i = 0; i < 4; ++i) { kk[i] *= inrm; kp[i] = ks[i] * (1.f + (av[i] - 1.f) * kag[i]); bb[i] = kk[i] * av[i]; bs += rs[i] * kp[i] * rkg[i]; }
              bon = red16(bs);
              { float* pp = Rr + (tt >> 1) * 640 + (tt & 1) * 64 + c4;
                *(f32x4*)pp = rs; *(f32x4*)(pp + 128) = dec; *(f32x4*)(pp + 256) = kp; *(f32x4*)(pp + 384) = kk; *(f32x4*)(pp + 512) = bb; *(f32x4*)(Vv + tt * 64 + c4) = vs; } }
            RW_BAR();
            { const int p = tid >> 5, j2 = (tid & 31) * 2; float* pb = Rr + p * 640 + j2; typedef float f32x2v __attribute__((ext_vector_type(2)));
              const f32x2v r0 = *(const f32x2v*)pb, r1 = *(const f32x2v*)(pb + 64), w0 = *(const f32x2v*)(pb + 128), w1 = *(const f32x2v*)(pb + 192), k0 = *(const f32x2v*)(pb + 256), k1 = *(const f32x2v*)(pb + 320),
                            q0 = *(const f32x2v*)(pb + 384), q1 = *(const f32x2v*)(pb + 448), b0 = *(const f32x2v*)(pb + 512), b1 = *(const f32x2v*)(pb + 576);
              const f32x2v w1r1 = w1 * r1, B0 = b0 * w1, K0 = k0 * w1;
              *(f32x2v*)pb = q0; *(f32x2v*)(pb + 64) = w0 * q1; *(f32x2v*)(pb + 128) = w0 * r0; *(f32x2v*)(pb + 192) = w0 * w1r1;
              *(f32x2v*)(pb + 256) = w0 * w1; *(f32x2v*)(pb + 320) = B0; *(f32x2v*)(pb + 384) = K0; *(f32x2v*)(pb + 448) = b1; *(f32x2v*)(pb + 512) = k1;
              float d[8] = { b0.x * q1.x + b0.y * q1.y, k0.x * q1.x + k0.y * q1.y, b0.x * r0.x + b0.y * r0.y, k0.x * r0.x + k0.y * r0.y,
                             B0.x * r1.x + B0.y * r1.y, K0.x * r1.x + K0.y * r1.y, b1.x * r1.x + b1.y * r1.y, k1.x * r1.x + k1.y * r1.y };
#pragma unroll
              for (int o = 1; o < 32; o <<= 1) {
#pragma unroll
                  for (int e = 0; e < 8; ++e) d[e] += __shfl_xor(d[e], o); }
              if ((tid & 31) == 0) { *(f32x4*)(Uu + p * 8) = (f32x4){d[0], d[1], d[2], d[3]}; *(f32x4*)(Uu + p * 8 + 4) = (f32x4){d[4], d[5], d[6], d[7]}; } }
            RW_BAR();
            if (ck + 1 < T / 32) RW_FETCH(ck + 1);
            const int j0 = 16 * (wv & 3);
#define RW_LD16(dst, base) do { _Pragma("unroll") for (int g_ = 0; g_ < 4; ++g_) dst[g_] = *(const f32x4*)((base) + j0 + 4 * g_); } while (0)
#define RW_DOT16(x) ({ f32x4 a_ = Sv[0] * x[0] + Sv[1] * x[1] + Sv[2] * x[2] + Sv[3] * x[3]; (a_[0] + a_[1]) + (a_[2] + a_[3]); })
#pragma unroll 1
            for (int p = 0; p < 16; ++p) {
                const int par = (p & 1) * 1024; const float* pb = Rr + p * 640; const float* sc = Uu + p * 8;
                if (wv < 4) {
                    { f32x4 d0[4], d1[4], d2[4], d3[4]; RW_LD16(d0, pb); RW_LD16(d1, pb + 64); RW_LD16(d2, pb + 128); RW_LD16(d3, pb + 192);
                      red[par + wv * 64 + lane] = RW_DOT16(d0); red[par + 256 + wv * 64 + lane] = RW_DOT16(d1); red[par + 512 + wv * 64 + lane] = RW_DOT16(d2); red[par + 768 + wv * 64 + lane] = RW_DOT16(d3); }
                    asm volatile("" ::: "memory");
                    f32x4 u0[4], u1[4], u2[4], u3[4], u4[4]; RW_LD16(u0, pb + 256); RW_LD16(u1, pb + 320); RW_LD16(u2, pb + 384); RW_LD16(u3, pb + 448); RW_LD16(u4, pb + 512);
                    const float v0 = Vv[(2 * p) * 64 + lane], v1 = Vv[(2 * p + 1) * 64 + lane], c1 = sc[0], c2 = sc[1];
                    RW_BAR();
                    const float sa0 = (red[par + lane] + red[par + 64 + lane]) + (red[par + 128 + lane] + red[par + 192 + lane]);
                    const float q = (red[par + 256 + lane] + red[par + 320 + lane]) + (red[par + 384 + lane] + red[par + 448 + lane]);
                    const float sa1 = q - sa0 * c1 + v0 * c2;
#pragma unroll
                    for (int g = 0; g < 4; ++g) Sv[g] = Sv[g] * u0[g] - sa0 * u1[g] + v0 * u2[g] - sa1 * u3[g] + v1 * u4[g];
                } else {
                    RW_BAR();
                    if (wv < 6) {
                        const float v0 = Vv[(2 * p) * 64 + lane];
                        const float sa0 = (red[par + lane] + red[par + 64 + lane]) + (red[par + 128 + lane] + red[par + 192 + lane]);
                        if (wv == 4) { const float y0 = (red[par + 512 + lane] + red[par + 576 + lane]) + (red[par + 640 + lane] + red[par + 704 + lane]);
                            Yb[(2 * p) * 64 + lane] = y0 - sa0 * sc[2] + v0 * sc[3]; }
                        else { const float v1 = Vv[(2 * p + 1) * 64 + lane];
                            const float q = (red[par + 256 + lane] + red[par + 320 + lane]) + (red[par + 384 + lane] + red[par + 448 + lane]);
                            const float sa1 = q - sa0 * sc[0] + v0 * sc[1];
                            const float y1 = (red[par + 768 + lane] + red[par + 832 + lane]) + (red[par + 896 + lane] + red[par + 960 + lane]);
                            Yb[(2 * p + 1) * 64 + lane] = y1 - sa0 * sc[4] + v0 * sc[5] - sa1 * sc[6] + v1 * sc[7]; } }
                    else if (p == 0) {
                        const size_t i8 = ((size_t)((blockIdx.x * 2 + (wv - 6)) * 64 + ck)) * 64 + lane;
                        const f32x4 pa = *(const f32x4*)(P.p + i8 * 8), pq = *(const f32x4*)(P.p + i8 * 8 + 4);
                        *(u32x4*)((bf16*)(P.ws + WS_PB) + i8 * 8) = pg8::pack8(pa, pq); } }
            }
            if (ck + 1 < T / 32) RW_FETCH_PREV(row + 31);
            RW_BAR();
#undef RW_LD16
#undef RW_BAR
#undef RW_DOT16
            { const f32x4 lng = CV(10), lnb = CV(11); const f32x4 y4 = *(const f32x4*)(Yb + tt * 64 + c4); const float mean = red16((y4[0] + y4[1]) + (y4[2] + y4[3])) * (1.f / 64.f);
              const f32x4 d = y4 - mean; const float var = red16((d[0] * d[0] + d[1] * d[1]) + (d[2] * d[2] + d[3] * d[3])) * (1.f / 64.f); const float rstd = __builtin_amdgcn_rsqf(var + 64e-5f);
              const u32x2 gg = n_gg; if (ck + 1 < T / 32) n_gg = *(const u32x2*)(GBg + (row + 32) * 1024 + hc);
              const float g0 = bflo(gg.x), g1 = bfhi(gg.x), g2 = bflo(gg.y), g3 = bfhi(gg.y);
              const float z0 = (d[0] * rstd * lng[0] + lnb[0] + bon * vs[0]) * g0 * sigm(g0), z1 = (d[1] * rstd * lng[1] + lnb[1] + bon * vs[1]) * g1 * sigm(g1);
              const float z2 = (d[2] * rstd * lng[2] + lnb[2] + bon * vs[2]) * g2 * sigm(g2), z3 = (d[3] * rstd * lng[3] + lnb[3] + bon * vs[3]) * g3 * sigm(g3);
              u32x2 w; w.x = cvt_pk_bf16(z0, z1); w.y = cvt_pk_bf16(z2, z3); *(u32x2*)(Z + row * 2048 + 1024 + hc) = w; }
        }
    }
}

#undef RW_FETCH
#undef RW_FETCH_PREV
#undef CV
__device__ __forceinline__ void gmlp_phase(unsigned char* lds, const Ptrs& P, const bf16* Ug, const bf16* Vg, const bf16* Gg, const float* vsum, const float* vsq, bf16* Z, const int wave_s) {
    int tid_ = my_tid(wave_s); asm volatile("" : "+v"(tid_)); const int tid = tid_, lane = tid & 63, wid = __builtin_amdgcn_readfirstlane(tid >> 6), r32 = lane & 31, hi = lane >> 5;
    bf16* As = (bf16*)lds;
    bf16* Bt = As + 128 * 136;
    float* Ds = (float*)(lds + 2 * 128 * 136 * 2);
    int gcur = -1;
    for (int u = blockIdx.x; u < 4096; u += gridDim.x) {
        const int g = u & 15, bn = u >> 4; const size_t row0 = (size_t)bn * 128; const int C0 = g * 128;
        __syncthreads();
        if (g != gcur) { gcur = g; const float* ws_ = P.c_w_s + (size_t)g * 128 * 128;
            for (int i = tid; i < 128 * 128 / 4; i += 512) { const int t = i >> 5, s4 = (i & 31) * 4; f32x4 w = *(const f32x4*)(ws_ + t * 128 + s4);
                u32x2 o; o.x = cvt_pk_bf16(s4 + 0 <= t ? w[0] : 0.f, s4 + 1 <= t ? w[1] : 0.f); o.y = cvt_pk_bf16(s4 + 2 <= t ? w[2] : 0.f, s4 + 3 <= t ? w[3] : 0.f); *(u32x2*)(As + t * 136 + s4) = o; } }
#pragma unroll
        for (int it = 0; it < 4; ++it) { const int i = tid + it * 512, s = i >> 4, c8 = (i & 15) * 8; const size_t row = row0 + s;
            const float mean = vsum[row] * (1.f / 2048.f), var = vsq[row] * (1.f / 2048.f) - mean * mean, rstd = __builtin_amdgcn_rsqf(fmaxf(var, 0.f) + 1e-5f);
            const u32x4 vv = *(const u32x4*)(Vg + row * 2048 + C0 + c8); const f32x4 lg0 = *(const f32x4*)(P.c_ln_g + C0 + c8), lg1 = *(const f32x4*)(P.c_ln_g + C0 + c8 + 4), lb0 = *(const f32x4*)(P.c_ln_b + C0 + c8), lb1 = *(const f32x4*)(P.c_ln_b + C0 + c8 + 4);
            float x[8] = {bflo(vv.x), bfhi(vv.x), bflo(vv.y), bfhi(vv.y), bflo(vv.z), bfhi(vv.z), bflo(vv.w), bfhi(vv.w)};
#pragma unroll
            for (int j = 0; j < 8; ++j) { const float gn = (x[j] - mean) * rstd * (j < 4 ? lg0[j & 3] : lg1[j & 3]) + (j < 4 ? lb0[j & 3] : lb1[j & 3]); const float nb = __shfl_xor(gn, 0); (void)nb;
                Bt[(c8 + j) * 136 + s] = (bf16)(cvt_pk_bf16(gn, 0.f) & 0xffffu); } }
        __syncthreads();
        { const int tb = wid >> 1, cb = (wid & 1) * 64; f32x16 d0, d1;
#pragma unroll
          for (int r = 0; r < 16; ++r) { d0[r] = 0.f; d1[r] = 0.f; }
          for (int k = 0; k <= 2 * tb + 1; ++k) {
              const bf16x8 a = *(const bf16x8*)(As + (32 * tb + r32) * 136 + 16 * k + 8 * hi);
              const bf16x8 b0 = *(const bf16x8*)(Bt + (cb + r32) * 136 + 16 * k + 8 * hi), b1 = *(const bf16x8*)(Bt + (cb + 32 + r32) * 136 + 16 * k + 8 * hi);
              d0 = __builtin_amdgcn_mfma_f32_32x32x16_bf16(a, b0, d0, 0, 0, 0); d1 = __builtin_amdgcn_mfma_f32_32x32x16_bf16(a, b1, d1, 0, 0, 0); }
#pragma unroll
          for (int r = 0; r < 16; ++r) { const int t = 32 * tb + crow(r, hi); Ds[t * 132 + cb + r32] = d0[r]; Ds[t * 132 + cb + 32 + r32] = d1[r]; } }
        __syncthreads();
#pragma unroll
        for (int it = 0; it < 4; ++it) { const int i = tid + it * 512, t = i >> 4, c8 = (i & 15) * 8; const size_t off = (row0 + t) * 2048 + C0 + c8;
            const float bs = P.c_b_s[g * 128 + t]; const u32x4 uu = *(const u32x4*)(Ug + off), gg = *(const u32x4*)(Gg + off);
            const f32x4 da = *(const f32x4*)(Ds + t * 132 + c8), db = *(const f32x4*)(Ds + t * 132 + c8 + 4); u32x4 o;
            o.x = cvt_pk_bf16(bflo(uu.x) * (da[0] + bs) * bflo(gg.x), bfhi(uu.x) * (da[1] + bs) * bfhi(gg.x)); o.y = cvt_pk_bf16(bflo(uu.y) * (da[2] + bs) * bflo(gg.y), bfhi(uu.y) * (da[3] + bs) * bfhi(gg.y));
            o.z = cvt_pk_bf16(bflo(uu.z) * (db[0] + bs) * bflo(gg.z), bfhi(uu.z) * (db[1] + bs) * bfhi(gg.z)); o.w = cvt_pk_bf16(bflo(uu.w) * (db[2] + bs) * bflo(gg.w), bfhi(uu.w) * (db[3] + bs) * bfhi(gg.w));
            *(u32x4*)(Z + off) = o; }
    }
}

__global__ void __launch_bounds__(512, 2) mega_fwd(Ptrs P) {
    extern __shared__ __attribute__((aligned(16))) unsigned char lds[];
    cg::grid_group grid = cg::this_grid();
    const int wave_s = __builtin_amdgcn_readfirstlane((int)threadIdx.x >> 6);
    unsigned char* ws = P.ws;
    float* ctl = (float*)(ws + WS_CTL);
    float *ssq0 = ctl, *ssqA = ctl + M, *ssqB = ctl + 2 * M, *ssqC = ctl + 3 * M, *vsum = ctl + 4 * M, *vsq = ctl + 5 * M;
    bf16* G = (bf16*)(ws + WS_G); const size_t GS = (size_t)M * 1024;
    bf16* HBA = (bf16*)(ws + WS_HBA); bf16* PB = (bf16*)(ws + WS_PB); float* SMALL = (float*)(ws + WS_SMALL); bf16* Zb = (bf16*)(ws + WS_Z);
    bf16* Y0 = G; bf16* PP0 = G + 2 * GS; bf16* HBB = G + 6 * GS;
    bf16* U_u = G; bf16* U_v = G + 2 * GS; bf16* U_g = G + 4 * GS;
    bf16* Y1 = G + 6 * GS; bf16* PP1 = G;
    const int lo = P.ph_lo, hi = P.ph_hi;
    PG8_LAS unsigned char* lds3 = (PG8_LAS unsigned char*)lds;
#define IN(k) (lo <= (k) && (k) < hi)
    unsigned* const gbar = (unsigned*)(ws + WS_CTL + 0x1F0000);
#define SEAM(k) do { if (IN(k) && IN((k) + 1)) { if ((k) == 0) grid.sync(); else { \
        asm volatile("s_waitcnt vmcnt(0) lgkmcnt(0)" ::: "memory"); __syncthreads(); \
        if (my_tid(wave_s) == 0) { __builtin_amdgcn_fence(__ATOMIC_RELEASE, "agent"); asm volatile("s_waitcnt vmcnt(0)" ::: "memory"); \
            __hip_atomic_fetch_add(gbar, 1u, __ATOMIC_RELAXED, __HIP_MEMORY_SCOPE_AGENT); \
            while (__hip_atomic_load(gbar, __ATOMIC_RELAXED, __HIP_MEMORY_SCOPE_AGENT) < 256u * (unsigned)(k)) __builtin_amdgcn_s_sleep(4); \
            __builtin_amdgcn_fence(__ATOMIC_ACQUIRE, "agent"); asm volatile("s_waitcnt vmcnt(0)" ::: "memory"); } \
        __syncthreads(); } } } while (0)
    if (IN(0)) { p0_prologue(P, lds, wave_s); } SEAM(0);
    if (IN(1)) { pg8::Gemm g{HBA, (const bf16*)(ws + WS_WIN0), M, N_IN0, 2048}; pg8::StaticOrder S; S.init(M, N_IN0, gridDim.x, blockIdx.x);
        pg8::EpiIn0 E{G, SMALL, ssq0, 0.125f * LOG2E}; pg8::gemm_phase<pg8::EpiIn0, pg8::StaticOrder, true, true>(lds3, g, S, E, my_tid(wave_s)); } SEAM(1);
    if (IN(2)) { attn_phase(lds, G, G + GS, G + 2 * GS, G + 3 * GS, SMALL, P.fox_f_bias, Zb, wave_s);
        rwkv_phase(lds, P, G + 4 * GS, G + 5 * GS, G + 6 * GS, G + 7 * GS, SMALL, Zb, wave_s); } SEAM(2);
    if (IN(3)) { { pg8::Gemm g{Zb, (const bf16*)(ws + WS_WOUT0), M, 2048, 2048}; pg8::StaticOrder S; S.init(M, 2048, gridDim.x, blockIdx.x);
          pg8::EpiY E{Y0, ssqA}; pg8::gemm_phase<pg8::EpiY, pg8::StaticOrder, true, true>(lds3, g, S, E, my_tid(wave_s)); }
        { pg8::Gemm g{PB, (const bf16*)(ws + WS_WP0), M, 2048, 256}; pg8::StaticOrder S; S.init(M, 2048, gridDim.x, blockIdx.x);
          pg8::EpiBf16<0> E{PP0, 2048, nullptr, 0, 0, 1.f}; pg8::gemm_phase<pg8::EpiBf16<0>, pg8::StaticOrder, true, true>(lds3, g, S, E, my_tid(wave_s)); } } SEAM(3);
    if (IN(4)) { post_norm_phase(P.x, Y0, ssqA, P.norm_post, P.out, HBA, wave_s); } SEAM(4);
    if (IN(5)) { pg8::Gemm g{HBA, (const bf16*)(ws + WS_WG0), M, 2048, 2048}; pg8::StaticOrder S; S.init(M, 2048, gridDim.x, blockIdx.x);
        pg8::EpiGate E{P.out, PP0, HBB, ssqB}; pg8::gemm_phase<pg8::EpiGate, pg8::StaticOrder, true, true>(lds3, g, S, E, my_tid(wave_s)); } SEAM(5);
    if (IN(6)) { pg8::Gemm g{HBB, (const bf16*)(ws + WS_WIN1), M, 6144, 2048}; pg8::StaticOrder S; S.init(M, 6144, gridDim.x, blockIdx.x);
        pg8::EpiC E{U_u, 2 * GS, ssqB, vsum, vsq}; pg8::gemm_phase<pg8::EpiC, pg8::StaticOrder, true, true>(lds3, g, S, E, my_tid(wave_s)); } SEAM(6);
    if (IN(7)) { gmlp_phase(lds, P, U_u, U_v, U_g, vsum, vsq, Zb, wave_s); } SEAM(7);
    if (IN(8)) { { pg8::Gemm g{Zb, (const bf16*)(ws + WS_WOUT1), M, 2048, 2048}; pg8::StaticOrder S; S.init(M, 2048, gridDim.x, blockIdx.x);
          pg8::EpiY E{Y1, ssqC}; pg8::gemm_phase<pg8::EpiY, pg8::StaticOrder, true, true>(lds3, g, S, E, my_tid(wave_s)); }
        { pg8::Gemm g{PB + (size_t)M * 256, (const bf16*)(ws + WS_WP1), M, 2048, 256}; pg8::StaticOrder S; S.init(M, 2048, gridDim.x, blockIdx.x);
          pg8::EpiBf16<0> E{PP1, 2048, nullptr, 0, 0, 1.f}; pg8::gemm_phase<pg8::EpiBf16<0>, pg8::StaticOrder, true, true>(lds3, g, S, E, my_tid(wave_s)); } } SEAM(8);
    if (IN(9)) { post_norm_phase(P.out, Y1, ssqC, P.norm_post + 2048, P.out, HBA, wave_s); } SEAM(9);
    if (IN(10)) { pg8::Gemm g{HBA, (const bf16*)(ws + WS_WG1), M, 2048, 2048}; pg8::StaticOrder S; S.init(M, 2048, gridDim.x, blockIdx.x);
        pg8::EpiGate E{P.out, PP1, nullptr, nullptr}; pg8::gemm_phase<pg8::EpiGate, pg8::StaticOrder, true, true>(lds3, g, S, E, my_tid(wave_s)); }
#undef IN
#undef SEAM
}

#ifndef MK_PER_PHASE
#define MK_PER_PHASE 0
#endif
constexpr int N_PHASES = 11;
extern "C" void kernel_launch(void* const* d_in, const int* in_sizes, int n_in, void* d_out, int out_size, void* d_ws, size_t ws_size, hipStream_t stream) {
    static int grid = 0;
    if (grid == 0) {
        if (n_in != 25 || ws_size < WS_END) { fprintf(stderr, "kernel_launch: need 25 inputs and %zu bytes of workspace (got %d, %zu)\n", (size_t)WS_END, n_in, ws_size); grid = -1; return; }
        int dev = 0, cus = 0, per_cu = 0;
        hipGetDevice(&dev); hipDeviceGetAttribute(&cus, hipDeviceAttributeMultiprocessorCount, dev);
        if (hipFuncSetAttribute((const void*)mega_fwd, hipFuncAttributeMaxDynamicSharedMemorySize, LDS_BYTES) != hipSuccess) { fprintf(stderr, "kernel_launch: hipFuncSetAttribute failed\n"); grid = -1; return; }
        hipOccupancyMaxActiveBlocksPerMultiprocessor(&per_cu, (const void*)mega_fwd, 512, LDS_BYTES);
        (void)hipGetLastError();
        if (per_cu < 1) { fprintf(stderr, "kernel_launch: occupancy query says %d blocks per CU\n", per_cu); per_cu = 1; }
        if (cus < 256) { fprintf(stderr, "kernel_launch: built for a 256-CU device (got %d CUs)\n", cus); grid = -1; return; }
        grid = 256;
    }
    if (grid < 0) return;
    (void)hipMemsetAsync((char*)d_ws + WS_CTL + 0x1F0000, 0, 256, stream);
    Ptrs p{};
    const float** pp = (const float**)&p;
    for (int i = 0; i < 25; ++i) pp[i] = (const float*)d_in[i];
    p.out = (float*)d_out; p.ws = (unsigned char*)d_ws;
#if MK_PER_PHASE
    for (int k = 0; k < N_PHASES; ++k) { p.ph_lo = k; p.ph_hi = k + 1; hipLaunchKernelGGL(mega_fwd, dim3(grid), dim3(512), LDS_BYTES, stream, p); }
#else
    p.ph_lo = 0; p.ph_hi = N_PHASES;
    void* args[] = {&p};
    hipError_t e = hipLaunchCooperativeKernel((const void*)mega_fwd, dim3(grid), dim3(512), args, LDS_BYTES, stream);
    if (e != hipSuccess) fprintf(stderr, "cooperative launch failed: %s (grid %d)\n", hipGetErrorString(e), grid);
#endif
}
```

```cpp
#include <hip/hip_runtime.h>
#include <hip/hip_cooperative_groups.h>
#include <cstdio>
#include <cstdint>
namespace cg = cooperative_groups;
namespace pg8 {
#define PG8_LAS __attribute__((address_space(3)))
typedef unsigned short bf16_t;
typedef short bf16x8 __attribute__((ext_vector_type(8)));
typedef float f32x4 __attribute__((ext_vector_type(4)));
typedef unsigned u32x4 __attribute__((ext_vector_type(4)));
constexpr int BM = 256, BK = 64, HALF = 128, HTB = HALF * BK * 2  , STAGE_BYTES = 8 * HTB, NXCD = 8, WGM = 8;

__host__ __device__ __forceinline__ int lds_byte(int r, int c) { const int st = (r >> 4) * 2 + (c >> 5), rr = r & 15, cc = c & 31, ob = rr * 64 + cc * 2; return st * 1024 + (ob ^ (((ob >> 9) & 1) << 5)); }
__host__ __device__ __forceinline__ void stage_rc(int b, int& R, int& C) { const int st = b / 1024, sb = b % 1024, swz = sb ^ (((sb >> 9) & 1) << 5); R = (st >> 1) * 16 + swz / 64; C = (st & 1) * 32 + (swz % 64) / 2; }
__host__ __device__ __forceinline__ int perm32(int rho) { const int n = rho >> 4, i = rho & 15; return 8 * (i >> 2) + 4 * n + (i & 3); }

struct Unit { int pm, pn; };
struct Gemm { const bf16_t* A; const bf16_t* Bt; int M, N, K; };

struct StaticOrder {
    int nM, nN, nwg, G, c;
    __host__ __device__ void init(int M, int N, int G_, int c_) { nM = M / BM; nN = N / BM; nwg = nM * nN; G = G_; c = c_; }
    __host__ __device__ bool next(int i, Unit& u) const {
        const long L = (long)i * G + c; if (L >= nwg) return false;
        int wgid = (int)L; { const int q = nwg / NXCD, r = nwg % NXCD, xcd = wgid % NXCD, off = wgid / NXCD; wgid = (xcd < r ? xcd * (q + 1) : r * (q + 1) + (xcd - r) * q) + off; }
        const int nig = WGM * nN, gid = wgid / nig, fm = gid * WGM, gsz = (nM - fm) < WGM ? (nM - fm) : WGM;
        u.pm = fm + ((wgid % nig) % gsz); u.pn = (wgid % nig) / gsz; return true;
    }
    __device__ __forceinline__ void a_ready(const Unit&) const {}
    __device__ __forceinline__ void done(const Unit&) const {}
};

__device__ __forceinline__ unsigned cvt_pk_bf16(float lo, float hi) { unsigned r; asm volatile("v_cvt_pk_bf16_f32 %0, %1, %2" : "=v"(r) : "v"(lo), "v"(hi)); return r; }
typedef float f32x2 __attribute__((ext_vector_type(2)));
__device__ __forceinline__ f32x2 gelu_pk(f32x2 v) {
    const f32x2 av = __builtin_elementwise_abs(v), d = av * 0.2316418882f + 1.0f;
    f32x2 t; t.x = __builtin_amdgcn_rcpf(d.x); t.y = __builtin_amdgcn_rcpf(d.y);
    f32x2 q = t * 0.5307027145f + (-0.7265760135f); q = q * t + 0.7107068705f; q = q * t + (-0.142248368f); q = q * t + 0.127414796f; q = q * t;
    const f32x2 s = (v * v) * (-0.72134752044f);
    f32x2 e; e.x = __builtin_amdgcn_exp2f(s.x); e.y = __builtin_amdgcn_exp2f(s.y);
    const f32x2 m = v * (q * e), r = v - m;
    f32x2 o; o.x = v.x < 0.f ? m.x : r.x; o.y = v.y < 0.f ? m.y : r.y; return o;
}
template <int ACT  > struct EpiBf16 {
    static constexpr bool PERM = true, AFTER_DRAIN = false; static_assert(ACT == 0 || ACT == 1, "EpiBf16: ACT is 0 (none) or 1 (gelu_pk)");
    bf16_t* O; int ldc; const float* bias; int split_cols; size_t split_stride; float scale0;
    __device__ __forceinline__ void operator()(const f32x4 (&acc)[2][2][4][2], const Unit& u, int wr, int wc, int fr, int fq) const {
        const int row0 = u.pm * BM + wr * 64 + fr; int colt = u.pn * BM; bf16_t* base = O;
        float sc = 1.f; if (split_cols) { const int t = colt / split_cols; base += (size_t)t * split_stride; colt -= t * split_cols; if (t == 0) sc = scale0; }
        const int col0 = colt + wc * 32 + 8 * fq, bcol0 = u.pn * BM + wc * 32 + 8 * fq;
        f32x4 bv[2][2];
#pragma unroll
        for (int bj = 0; bj < 2; ++bj)
#pragma unroll
            for (int n = 0; n < 2; ++n) bv[bj][n] = bias ? *(const f32x4*)(bias + bcol0 + bj * HALF + 4 * n) : (f32x4){0.f, 0.f, 0.f, 0.f};
#pragma unroll
        for (int ai = 0; ai < 2; ++ai)
#pragma unroll
            for (int m = 0; m < 4; ++m) { bf16_t* rowp = base + (size_t)(row0 + ai * HALF + m * 16) * ldc + col0;
#pragma unroll
                for (int bj = 0; bj < 2; ++bj) { f32x4 v0 = acc[ai][bj][m][0] + bv[bj][0], v1 = acc[ai][bj][m][1] + bv[bj][1];
                    if (ACT == 1) { f32x2 a = gelu_pk((f32x2){v0[0], v0[1]}), b = gelu_pk((f32x2){v0[2], v0[3]}), c = gelu_pk((f32x2){v1[0], v1[1]}), d = gelu_pk((f32x2){v1[2], v1[3]});
                        v0 = (f32x4){a.x, a.y, b.x, b.y}; v1 = (f32x4){c.x, c.y, d.x, d.y}; }
                    v0 = v0 * sc; v1 = v1 * sc; u32x4 w; w.x = cvt_pk_bf16(v0[0], v0[1]); w.y = cvt_pk_bf16(v0[2], v0[3]); w.z = cvt_pk_bf16(v1[0], v1[1]); w.w = cvt_pk_bf16(v1[2], v1[3]);
                    *(u32x4*)(rowp + bj * HALF) = w; } }
    }
};
__device__ __forceinline__ u32x4 pack8(const f32x4 v0, const f32x4 v1) { u32x4 w; w.x = cvt_pk_bf16(v0[0], v0[1]); w.y = cvt_pk_bf16(v0[2], v0[3]); w.z = cvt_pk_bf16(v1[0], v1[1]); w.w = cvt_pk_bf16(v1[2], v1[3]); return w; }
__device__ __forceinline__ float bflo(unsigned u) { return __uint_as_float(u << 16); }
__device__ __forceinline__ float bfhi(unsigned u) { return __uint_as_float(u & 0xffff0000u); }
__device__ __forceinline__ float sigm(float x) { return __builtin_amdgcn_rcpf(1.0f + __builtin_amdgcn_exp2f(-1.4426950408889634f * x)); }
#define PG8_FOR_AI_M _Pragma("unroll") for (int ai = 0; ai < 2; ++ai) _Pragma("unroll") for (int m = 0; m < 4; ++m)
struct EpiIn0 {
    static constexpr bool PERM = true, AFTER_DRAIN = false;
    bf16_t* G; float* small; const float* ssq; float qscale;
    __device__ __forceinline__ void operator()(const f32x4 (&acc)[2][2][4][2], const Unit& u, int wr, int wc, int fr_, int fq_) const {
        int fr = fr_, fq = fq_; asm volatile("" : "+v"(fr), "+v"(fq));
        const int row0 = u.pm * BM + wr * 64 + fr, ct = wc * 32 + 8 * fq;
        float rsv[2][4];
        PG8_FOR_AI_M rsv[ai][m] = __builtin_amdgcn_rsqf(ssq[row0 + ai * HALF + m * 16] * (1.f / 2048.f) + 1e-6f);
        if (u.pn < 32) {
            const int grp = u.pn >> 2; bf16_t* base = G + (size_t)grp * ((size_t)32768 * 1024) + (u.pn & 3) * 256 + ct; const float sc0 = (grp == 0) ? qscale : 1.f;
            PG8_FOR_AI_M { const int row = row0 + ai * HALF + m * 16; const float rs = rsv[ai][m] * sc0; bf16_t* rp = base + (size_t)row * 1024;
#pragma unroll
                for (int bj = 0; bj < 2; ++bj) *(u32x4*)(rp + bj * HALF) = pack8(acc[ai][bj][m][0] * rs, acc[ai][bj][m][1] * rs); }
        } else {
            PG8_FOR_AI_M { const int row = row0 + ai * HALF + m * 16; const float rs = rsv[ai][m]; float* rp = small + (size_t)row * 256 + ct;
#pragma unroll
                for (int bj = 0; bj < 2; ++bj) { *(f32x4*)(rp + bj * HALF) = acc[ai][bj][m][0] * rs; *(f32x4*)(rp + bj * HALF + 4) = acc[ai][bj][m][1] * rs; } }
        }
    }
};
struct EpiY {
    static constexpr bool PERM = true, AFTER_DRAIN = false;
    bf16_t* Y; float* ssq;
    __device__ __forceinline__ void operator()(const f32x4 (&acc)[2][2][4][2], const Unit& u, int wr, int wc, int fr_, int fq_) const {
        int fr = fr_, fq = fq_; asm volatile("" : "+v"(fr), "+v"(fq));
        const int row0 = u.pm * BM + wr * 64 + fr, col0 = u.pn * BM + wc * 32 + 8 * fq;
        PG8_FOR_AI_M { const int row = row0 + ai * HALF + m * 16; float s = 0.f; bf16_t* rp = Y + (size_t)row * 2048 + col0;
#pragma unroll
            for (int bj = 0; bj < 2; ++bj) { const f32x4 v0 = acc[ai][bj][m][0], v1 = acc[ai][bj][m][1];
                s += (v0[0] * v0[0] + v0[1] * v0[1]) + (v0[2] * v0[2] + v0[3] * v0[3]) + (v1[0] * v1[0] + v1[1] * v1[1]) + (v1[2] * v1[2] + v1[3] * v1[3]);
                *(u32x4*)(rp + bj * HALF) = pack8(v0, v1); }
            s += __shfl_xor(s, 16); s += __shfl_xor(s, 32);
            if (fq == 0) __hip_atomic_fetch_add(ssq + row, s, __ATOMIC_RELAXED, __HIP_MEMORY_SCOPE_AGENT); }
    }
};
struct EpiGate {
    static constexpr bool PERM = true, AFTER_DRAIN = false;
    float* H; const bf16_t* PP; bf16_t* HB; float* ssq;
    __device__ __forceinline__ void operator()(const f32x4 (&acc)[2][2][4][2], const Unit& u, int wr, int wc, int fr_, int fq_) const {
        int fr = fr_, fq = fq_; asm volatile("" : "+v"(fr), "+v"(fq));
        const int row0 = u.pm * BM + wr * 64 + fr, col0 = u.pn * BM + wc * 32 + 8 * fq;
#pragma unroll
        for (int ai = 0; ai < 2; ++ai)
#pragma unroll
            for (int mp = 0; mp < 2; ++mp) {
                f32x4 hh[2][2][2]; u32x4 pq[2][2];
#pragma unroll
                for (int mm = 0; mm < 2; ++mm)
#pragma unroll
                    for (int bj = 0; bj < 2; ++bj) { const size_t off = (size_t)(row0 + ai * HALF + (2 * mp + mm) * 16) * 2048 + col0 + bj * HALF;
                        hh[mm][bj][0] = *(const f32x4*)(H + off); hh[mm][bj][1] = *(const f32x4*)(H + off + 4); pq[mm][bj] = *(const u32x4*)(PP + off); }
#pragma unroll
                for (int mm = 0; mm < 2; ++mm) { const int m = 2 * mp + mm; const int row = row0 + ai * HALF + m * 16; float s = 0.f;
#pragma unroll
                    for (int bj = 0; bj < 2; ++bj) { const size_t off = (size_t)row * 2048 + col0 + bj * HALF; float* hp = H + off;
                        const f32x4 h0 = hh[mm][bj][0], h1 = hh[mm][bj][1]; const u32x4 pp = pq[mm][bj];
                        const f32x4 a0 = acc[ai][bj][m][0], a1 = acc[ai][bj][m][1]; f32x4 o0, o1;
                        o0[0] = h0[0] + bflo(pp.x) * sigm(a0[0]); o0[1] = h0[1] + bfhi(pp.x) * sigm(a0[1]); o0[2] = h0[2] + bflo(pp.y) * sigm(a0[2]); o0[3] = h0[3] + bfhi(pp.y) * sigm(a0[3]);
                        o1[0] = h1[0] + bflo(pp.z) * sigm(a1[0]); o1[1] = h1[1] + bfhi(pp.z) * sigm(a1[1]); o1[2] = h1[2] + bflo(pp.w) * sigm(a1[2]); o1[3] = h1[3] + bfhi(pp.w) * sigm(a1[3]);
                        *(f32x4*)hp = o0; *(f32x4*)(hp + 4) = o1;
                        if (HB) *(u32x4*)(HB + off) = pack8(o0, o1);
                        s += (o0[0] * o0[0] + o0[1] * o0[1]) + (o0[2] * o0[2] + o0[3] * o0[3]) + (o1[0] * o1[0] + o1[1] * o1[1]) + (o1[2] * o1[2] + o1[3] * o1[3]); }
                    if (ssq) { s += __shfl_xor(s, 16); s += __shfl_xor(s, 32); if (fq == 0) __hip_atomic_fetch_add(ssq + row, s, __ATOMIC_RELAXED, __HIP_MEMORY_SCOPE_AGENT); } } }
    }
};
struct EpiC {
    static constexpr bool PERM = true, AFTER_DRAIN = false;
    bf16_t* U0; size_t ustride; const float* ssq; float* vsum; float* vsq;
    __device__ __forceinline__ void operator()(const f32x4 (&acc)[2][2][4][2], const Unit& u, int wr, int wc, int fr_, int fq_) const {
        int fr = fr_, fq = fq_; asm volatile("" : "+v"(fr), "+v"(fq));
        const int seg = u.pn >> 3; bf16_t* base = U0 + (size_t)seg * ustride;
        const int row0 = u.pm * BM + wr * 64 + fr, col0 = (u.pn & 7) * BM + wc * 32 + 8 * fq;
        float rsv[2][4];
        PG8_FOR_AI_M rsv[ai][m] = __builtin_amdgcn_rsqf(ssq[row0 + ai * HALF + m * 16] * (1.f / 2048.f) + 1e-6f);
        PG8_FOR_AI_M { const int row = row0 + ai * HALF + m * 16; const float rs = rsv[ai][m]; float s1 = 0.f, s2 = 0.f; bf16_t* rp = base + (size_t)row * 2048 + col0;
#pragma unroll
            for (int bj = 0; bj < 2; ++bj) { f32x4 v0 = acc[ai][bj][m][0] * rs, v1 = acc[ai][bj][m][1] * rs;
                if (seg < 2) { f32x2 a = gelu_pk((f32x2){v0[0], v0[1]}), b = gelu_pk((f32x2){v0[2], v0[3]}), c = gelu_pk((f32x2){v1[0], v1[1]}), d = gelu_pk((f32x2){v1[2], v1[3]});
                    v0 = (f32x4){a.x, a.y, b.x, b.y}; v1 = (f32x4){c.x, c.y, d.x, d.y}; }
                else {
#pragma unroll
                    for (int i = 0; i < 4; ++i) { v0[i] = v0[i] * sigm(v0[i]); v1[i] = v1[i] * sigm(v1[i]); } }
                *(u32x4*)(rp + bj * HALF) = pack8(v0, v1);
                if (seg == 1) { s1 += (v0[0] + v0[1]) + (v0[2] + v0[3]) + (v1[0] + v1[1]) + (v1[2] + v1[3]);
                    s2 += (v0[0] * v0[0] + v0[1] * v0[1]) + (v0[2] * v0[2] + v0[3] * v0[3]) + (v1[0] * v1[0] + v1[1] * v1[1]) + (v1[2] * v1[2] + v1[3] * v1[3]); } }
            if (seg == 1) { s1 += __shfl_xor(s1, 16); s1 += __shfl_xor(s1, 32); s2 += __shfl_xor(s2, 16); s2 += __shfl_xor(s2, 32);
                if (fq == 0) { __hip_atomic_fetch_add(vsum + row, s1, __ATOMIC_RELAXED, __HIP_MEMORY_SCOPE_AGENT); __hip_atomic_fetch_add(vsq + row, s2, __ATOMIC_RELAXED, __HIP_MEMORY_SCOPE_AGENT); } } }
    }
};
template <class Epi, class Sched, bool ALIGN_EPI = false, bool SP2 = false>
__device__ __forceinline__ void gemm_phase(PG8_LAS unsigned char* lds, const Gemm g, const Sched& S, const Epi& E, const int tid_in) {
    const int tid = tid_in, wid = __builtin_amdgcn_readfirstlane(tid >> 6), lane = tid & 63, wr = wid >> 2, wc = wid & 3, fr = lane & 15, fq = lane >> 4;
    const int K = g.K, nt = K / BK;
    unsigned voffA[2], voffB[2];
#pragma unroll
    for (int i = 0; i < 2; ++i) { int R, C; stage_rc(tid * 16 + i * 8192, R, C); const int Rb = Epi::PERM ? ((R & ~31) + perm32(R & 31)) : R;
        voffA[i] = (unsigned)(R * K + C) * 2u; voffB[i] = (unsigned)(Rb * K + C) * 2u; }
    const size_t kstep = (size_t)(BK * 2);
    const size_t hstep = (size_t)HALF * K * 2;
    const size_t tstep = 2 * hstep;
    const unsigned ldsw = (unsigned)wid * 1024u;
    const int aoff = lds_byte(wr * 64 + fr, fq * 8), boff = lds_byte(wc * 32 + fr, fq * 8);
#define PG8_SA(b, h) (((b) * 2 + (h)) * HTB)
#define PG8_SB(b, h) ((4 + (b) * 2 + (h)) * HTB)
#define PG8_STAGE(bufoff, gbase, voff) do { _Pragma("unroll") for (int _i = 0; _i < 2; ++_i) \
        __builtin_amdgcn_global_load_lds((const unsigned*)((const char*)(gbase) + (voff)[_i]), (PG8_LAS unsigned*)(lds + (bufoff) + ldsw + _i * 8192), 16, 0, 0); } while (0)
#define PG8_LDA(dst, b, h) do { _Pragma("unroll") for (int m = 0; m < 4; ++m) _Pragma("unroll") for (int k = 0; k < 2; ++k) dst[m][k] = *(const PG8_LAS bf16x8*)(lds + PG8_SA(b, h) + aoff + m * 2048 + k * 1024); } while (0)
#define PG8_LDB(dst, b, h) do { _Pragma("unroll") for (int n = 0; n < 2; ++n) _Pragma("unroll") for (int k = 0; k < 2; ++k) dst[n][k] = *(const PG8_LAS bf16x8*)(lds + PG8_SB(b, h) + boff + n * 2048 + k * 1024); } while (0)
#define PG8_MMA(ai, bj, At, Bt) do { __builtin_amdgcn_s_setprio(1); _Pragma("unroll") for (int m = 0; m < 4; ++m) _Pragma("unroll") for (int n = 0; n < 2; ++n) _Pragma("unroll") for (int k = 0; k < 2; ++k) \
        acc[ai][bj][m][n] = __builtin_amdgcn_mfma_f32_16x16x32_bf16(Bt[n][k], At[m][k], acc[ai][bj][m][n], 0, 0, 0); __builtin_amdgcn_s_setprio(0); } while (0)
#define PG8_WAIT_V(n) asm volatile("s_waitcnt vmcnt(" #n ")" ::: "memory")
#define PG8_WAIT_L(n) asm volatile("s_waitcnt lgkmcnt(" #n ")" ::: "memory")
#define PG8_BAR __builtin_amdgcn_s_barrier()
#define PG8_SCHED __builtin_amdgcn_sched_barrier(0)
    Unit cur, nxt; int ui = 0;
    if (!S.next(0, cur)) return;
    f32x4 acc[2][2][4][2];
#pragma unroll
    for (int a = 0; a < 2; ++a)
#pragma unroll
        for (int b = 0; b < 2; ++b)
#pragma unroll
            for (int m = 0; m < 4; ++m)
#pragma unroll
                for (int n = 0; n < 2; ++n) acc[a][b][m][n] = (f32x4){0.f, 0.f, 0.f, 0.f};
    bf16x8 At[4][2], B0[2][2], B1[2][2];
    const char* cA = (const char*)g.A + (size_t)cur.pm * tstep; const char* cB = (const char*)g.Bt + (size_t)cur.pn * tstep;
    S.a_ready(cur);
    if constexpr (SP2) {
        PG8_STAGE(PG8_SB(0, 0), cB, voffB); PG8_STAGE(PG8_SB(0, 1), cB + hstep, voffB); PG8_STAGE(PG8_SA(0, 0), cA, voffA); PG8_STAGE(PG8_SA(0, 1), cA + hstep, voffA);
        if (wr == 1) PG8_BAR;
        PG8_WAIT_V(2); PG8_BAR;
        PG8_STAGE(PG8_SB(1, 0), cB + kstep, voffB); PG8_STAGE(PG8_SA(1, 0), cA + kstep, voffA); PG8_STAGE(PG8_SB(1, 1), cB + hstep + kstep, voffB);
        PG8_WAIT_V(6); PG8_BAR;
    } else {
        PG8_STAGE(PG8_SB(0, 0), cB, voffB); PG8_STAGE(PG8_SA(0, 0), cA, voffA); PG8_STAGE(PG8_SB(0, 1), cB + hstep, voffB); PG8_STAGE(PG8_SA(0, 1), cA + hstep, voffA);
        if (wr == 1) PG8_BAR;
        PG8_WAIT_V(4); PG8_BAR;
        PG8_STAGE(PG8_SB(1, 0), cB + kstep, voffB); PG8_STAGE(PG8_SA(1, 0), cA + kstep, voffA); PG8_STAGE(PG8_SB(1, 1), cB + hstep + kstep, voffB);
        PG8_WAIT_V(6); PG8_BAR;
    }
    for (;;) {
        const bool has_next = S.next(ui + 1, nxt);
        const char* nA = has_next ? (const char*)g.A + (size_t)nxt.pm * tstep : cA; const char* nB = has_next ? (const char*)g.Bt + (size_t)nxt.pn * tstep : cB;
        for (int t = 0; t < nt; t += 2) {
            const bool last = (t == nt - 2);
            const char* a1 = cA + (size_t)(t + 1) * kstep;
            const char* a2 = last ? nA : cA + (size_t)(t + 2) * kstep; const char* b2 = last ? nB : cB + (size_t)(t + 2) * kstep;
            const char* a3 = a2 + kstep; const char* b3 = b2 + kstep;
            if (last && has_next) S.a_ready(nxt);
            if constexpr (SP2) {
            PG8_LDB(B0, 0, 0); PG8_LDB(B1, 0, 1); PG8_SCHED; PG8_LDA(At, 0, 0); PG8_STAGE(PG8_SA(1, 1), a1 + hstep, voffA);
            PG8_WAIT_V(8); PG8_WAIT_L(0); PG8_BAR; PG8_MMA(0, 0, At, B0); PG8_MMA(0, 1, At, B1); PG8_BAR; PG8_SCHED;
            PG8_LDA(At, 0, 1); PG8_STAGE(PG8_SB(0, 0), b2, voffB); PG8_STAGE(PG8_SB(0, 1), b2 + hstep, voffB); PG8_STAGE(PG8_SA(0, 0), a2, voffA);
            PG8_WAIT_V(8); PG8_WAIT_L(0); PG8_BAR; PG8_MMA(1, 0, At, B0); PG8_MMA(1, 1, At, B1); PG8_BAR; PG8_SCHED;
            PG8_LDB(B0, 1, 0); PG8_LDB(B1, 1, 1); PG8_SCHED; PG8_LDA(At, 1, 0); PG8_STAGE(PG8_SA(0, 1), a2 + hstep, voffA);
            PG8_WAIT_V(8); PG8_WAIT_L(0); PG8_BAR; PG8_MMA(0, 0, At, B0); PG8_MMA(0, 1, At, B1); PG8_BAR; PG8_SCHED;
            PG8_LDA(At, 1, 1); PG8_STAGE(PG8_SB(1, 0), b3, voffB); PG8_STAGE(PG8_SB(1, 1), b3 + hstep, voffB); PG8_STAGE(PG8_SA(1, 0), a3, voffA);
            PG8_WAIT_V(8); PG8_WAIT_L(0); PG8_BAR; PG8_MMA(1, 0, At, B0); PG8_MMA(1, 1, At, B1); PG8_BAR; PG8_SCHED;
            } else {
            PG8_LDB(B0, 0, 0); PG8_SCHED; PG8_LDA(At, 0, 0); PG8_STAGE(PG8_SA(1, 1), a1 + hstep, voffA);
            PG8_WAIT_L(8); PG8_BAR; PG8_WAIT_L(0); PG8_MMA(0, 0, At, B0); PG8_BAR; PG8_SCHED;
            PG8_LDB(B1, 0, 1); PG8_STAGE(PG8_SB(0, 0), b2, voffB);
            PG8_BAR; PG8_WAIT_L(0); PG8_MMA(0, 1, At, B1); PG8_BAR;
            PG8_LDA(At, 0, 1); PG8_STAGE(PG8_SA(0, 0), a2, voffA);
            PG8_BAR; PG8_WAIT_L(0); PG8_MMA(1, 0, At, B0); PG8_BAR; PG8_SCHED;
            PG8_STAGE(PG8_SB(0, 1), b2 + hstep, voffB);
            PG8_WAIT_V(6); PG8_BAR; PG8_MMA(1, 1, At, B1); PG8_BAR;
            PG8_LDB(B0, 1, 0); PG8_SCHED; PG8_LDA(At, 1, 0); PG8_STAGE(PG8_SA(0, 1), a2 + hstep, voffA);
            PG8_WAIT_L(8); PG8_BAR; PG8_WAIT_L(0); PG8_MMA(0, 0, At, B0); PG8_BAR; PG8_SCHED;
            PG8_LDB(B1, 1, 1); PG8_STAGE(PG8_SB(1, 0), b3, voffB);
            PG8_BAR; PG8_WAIT_L(0); PG8_MMA(0, 1, At, B1); PG8_BAR;
            PG8_LDA(At, 1, 1); PG8_STAGE(PG8_SA(1, 0), a3, voffA);
            PG8_BAR; PG8_WAIT_L(0); PG8_MMA(1, 0, At, B0); PG8_BAR; PG8_SCHED;
            PG8_STAGE(PG8_SB(1, 1), b3 + hstep, voffB);
            PG8_WAIT_V(6); PG8_BAR; PG8_MMA(1, 1, At, B1); PG8_BAR;
            }
        }
        if constexpr (ALIGN_EPI) { if (wr == 0) PG8_BAR; }
        if constexpr (!Epi::AFTER_DRAIN) { E(acc, cur, wr, wc, fr, fq); S.done(cur); }
        if (!has_next) break;
#pragma unroll
        for (int a = 0; a < 2; ++a)
#pragma unroll
            for (int b = 0; b < 2; ++b)
#pragma unroll
                for (int m = 0; m < 4; ++m)
#pragma unroll
                    for (int n = 0; n < 2; ++n) acc[a][b][m][n] = (f32x4){0.f, 0.f, 0.f, 0.f};
        cur = nxt; cA = nA; cB = nB; ++ui;
        if constexpr (ALIGN_EPI) { if (wr == 1) PG8_BAR; }
    }
    PG8_WAIT_V(0);
    if constexpr (!ALIGN_EPI) { if (wr == 0) PG8_BAR; }
    PG8_BAR;
    if constexpr (Epi::AFTER_DRAIN) { E.fused(acc, cur, wr, wc, fr, fq, lds, wid, lane); S.done(cur); }
#undef PG8_SA
#undef PG8_SB
#undef PG8_STAGE
#undef PG8_LDA
#undef PG8_LDB
#undef PG8_MMA
#undef PG8_WAIT_V
#undef PG8_WAIT_L
#undef PG8_BAR
#undef PG8_SCHED
}
}
constexpr int NB = 16, T = 2048, D = 2048, M = NB * T;
constexpr int N_IN0 = 8448;
constexpr size_t MiB = 1u << 20;
constexpr size_t WS_CTL = 0;
constexpr size_t WS_WIN0 = 2 * MiB, WS_WOUT0 = 35 * MiB, WS_WIN1 = 43 * MiB, WS_WOUT1 = 67 * MiB, WS_WG0 = 75 * MiB, WS_WG1 = 83 * MiB, WS_WP0 = 91 * MiB, WS_WP1 = 92 * MiB;
constexpr size_t WS_HBA = 96 * MiB, WS_PB = 224 * MiB, WS_G = 256 * MiB, WS_SMALL = 768 * MiB, WS_Z = 800 * MiB, WS_END = 928 * MiB;
constexpr int LDS_BYTES = 147456;
constexpr int NWAVES = 8;
typedef unsigned short bf16;
typedef short bf16x8 __attribute__((ext_vector_type(8)));
typedef float f32x4 __attribute__((ext_vector_type(4)));
typedef float f32x16 __attribute__((ext_vector_type(16)));
typedef unsigned u32x4 __attribute__((ext_vector_type(4)));
typedef unsigned u32x2 __attribute__((ext_vector_type(2)));
#define LAS __attribute__((address_space(3)))
#define LDS_WAIT() asm volatile("s_waitcnt lgkmcnt(0)" ::: "memory")
using pg8::cvt_pk_bf16; using pg8::bflo; using pg8::bfhi; using pg8::sigm;
constexpr float LOG2E = 1.4426950408889634f;

__device__ __forceinline__ int my_tid(int wave_s) { return wave_s * 64 + (int)__builtin_amdgcn_mbcnt_hi(~0u, __builtin_amdgcn_mbcnt_lo(~0u, 0u)); }
__device__ __forceinline__ float wave_sum(float v) {
#pragma unroll
    for (int o = 1; o < 64; o <<= 1) v += __shfl_xor(v, o);
    return v;
}
__device__ __forceinline__ float red16(float v) { v += __shfl_xor(v, 1); v += __shfl_xor(v, 2); v += __shfl_xor(v, 4); v += __shfl_xor(v, 8); return v; }

__device__ __forceinline__ void transpose_item(const float* W, int K, int Nsrc, int src_col0, int nvalid, const float* gk, bf16* WT, int dst_row0, float* scr, int kb, int lane) {
    const int k0 = 64 * kb, c = lane & 31;
#pragma unroll 8
    for (int i = 0; i < 32; ++i) { const int kk = 2 * i + (lane >> 5); float v = (c < nvalid) ? W[(size_t)(k0 + kk) * Nsrc + src_col0 + c] : 0.f; if (gk) v *= gk[k0 + kk]; scr[kk * 33 + c] = v; }
    LDS_WAIT();
    const int c8 = lane & 7;
#pragma unroll
    for (int j = 0; j < 4; ++j) { const int n = (lane >> 3) + 8 * j; const float* s = scr + (8 * c8) * 33 + n;
        u32x4 o; o.x = cvt_pk_bf16(s[0 * 33], s[1 * 33]); o.y = cvt_pk_bf16(s[2 * 33], s[3 * 33]); o.z = cvt_pk_bf16(s[4 * 33], s[5 * 33]); o.w = cvt_pk_bf16(s[6 * 33], s[7 * 33]);
        *(u32x4*)(WT + (size_t)(dst_row0 + n) * K + k0 + 8 * c8) = o; }
    LDS_WAIT();
}

struct Ptrs {
    const float *x, *p, *norm_pre, *norm_post, *ab_w_in, *fox_f_bias, *rwkv_mu, *rwkv_w0, *rwkv_w2, *rwkv_a0, *rwkv_a2, *rwkv_k_k, *rwkv_k_a, *rwkv_r_k, *rwkv_ln_g, *rwkv_ln_b,
        *ab_w_out, *c_w_in, *c_ln_g, *c_ln_b, *c_w_s, *c_b_s, *c_w_out, *ple_w_proj, *ple_w_gate;
    float* out; unsigned char* ws; int ph_lo, ph_hi;
};

__device__ __forceinline__ void p0_prologue(const Ptrs& P, unsigned char* lds, const int wave_s) {
    int tid_ = my_tid(wave_s); asm volatile("" : "+v"(tid_)); const int tid = tid_, lane = tid & 63, wave = tid >> 6;
    float* scr = (float*)(lds + wave * 16384);
    const int gw = blockIdx.x * NWAVES + wave, NGW = gridDim.x * NWAVES;
    unsigned char* ws = P.ws;
    if (blockIdx.x < 200) {
        const int c0 = blockIdx.x * 16, q = wave, cq = lane & 3, bb = lane >> 2;
        const float* xr = P.x + (size_t)bb * T * D + q * 256; const float* gq = P.norm_pre + q * 256; const float* Wq = P.ab_w_in + (size_t)(q * 256) * 8336 + 4112 + c0 + 4 * cq;
        f32x4 a0 = {0.f, 0.f, 0.f, 0.f}, a1 = a0, a2 = a0, a3 = a0;
#pragma unroll 2
        for (int k4 = 0; k4 < 64; ++k4) { const f32x4 gv = *(const f32x4*)(gq + 4 * k4);
            const f32x4 x0 = *(const f32x4*)(xr + 4 * k4) * gv, x1 = *(const f32x4*)(xr + D + 4 * k4) * gv, x2 = *(const f32x4*)(xr + 2 * D + 4 * k4) * gv, x3 = *(const f32x4*)(xr + 3 * D + 4 * k4) * gv;
#pragma unroll
            for (int e = 0; e < 4; ++e) { const f32x4 wv_ = *(const f32x4*)(Wq + (size_t)(4 * k4 + e) * 8336);
                a0 += x0[e] * wv_; a1 += x1[e] * wv_; a2 += x2[e] * wv_; a3 += x3[e] * wv_; } }
        { float* part = (float*)lds + (q * 64 + bb * 4) * 16 + 4 * cq;
          *(f32x4*)part = a0; *(f32x4*)(part + 16) = a1; *(f32x4*)(part + 32) = a2; *(f32x4*)(part + 48) = a3; }
        __syncthreads();
        float* EXG = (float*)(ws + WS_CTL + 0x100000);
#pragma unroll
        for (int o = tid * 2; o < tid * 2 + 2; ++o) { const int r2 = o >> 4, cc = o & 15; float v = 0.f;
#pragma unroll
            for (int w = 0; w < 8; ++w) v += ((const float*)lds)[(w * 64 + r2) * 16 + cc];
            EXG[(size_t)r2 * 3200 + c0 + cc] = v; }
        __syncthreads();
    }
    { float* z = (float*)(ws + WS_CTL) + M; for (int i = blockIdx.x * 512 + tid; i < 5 * M; i += gridDim.x * 512) z[i] = 0.f; }
    constexpr int I_IN0 = 32 * (N_IN0 / 32), I_SQ = 32 * 64, I_IN1 = 32 * 192, I_PJ = 4 * 64;
    constexpr int NITEMS = I_IN0 + I_SQ + I_IN1 + I_SQ + 2 * I_SQ + 2 * I_PJ;
    for (int it = gw; it < NITEMS; it += NGW) {
        int r = it;
        if (r < I_IN0) { const int nblk = N_IN0 / 32, kb = r / nblk, db = r % nblk; int src, nv = 32;
            if (db < 256) { const int grp = db >> 5; src = grp * 1024 + (grp >= 3 ? 16 : 0) + (grp == 7 ? 128 : 0) + (db & 31) * 32; }
            else if (db < 258) src = 7184 + (db - 256) * 32; else if (db < 260) src = 7248 + (db - 258) * 32; else if (db == 260) { src = 3072; nv = 16; } else { src = 0; nv = 0; }
            transpose_item(P.ab_w_in, 2048, 8336, src, nv, P.norm_pre, (bf16*)(ws + WS_WIN0), db * 32, scr, kb, lane); continue; } r -= I_IN0;
        if (r < I_SQ) { transpose_item(P.ab_w_out, 2048, 2048, (r % 64) * 32, 32, nullptr, (bf16*)(ws + WS_WOUT0), (r % 64) * 32, scr, r / 64, lane); continue; } r -= I_SQ;
        if (r < I_IN1) { transpose_item(P.c_w_in, 2048, 6144, (r % 192) * 32, 32, P.norm_pre + 2048, (bf16*)(ws + WS_WIN1), (r % 192) * 32, scr, r / 192, lane); continue; } r -= I_IN1;
        if (r < I_SQ) { transpose_item(P.c_w_out, 2048, 2048, (r % 64) * 32, 32, nullptr, (bf16*)(ws + WS_WOUT1), (r % 64) * 32, scr, r / 64, lane); continue; } r -= I_SQ;
        if (r < I_SQ) { transpose_item(P.ple_w_gate, 2048, 2048, (r % 64) * 32, 32, nullptr, (bf16*)(ws + WS_WG0), (r % 64) * 32, scr, r / 64, lane); continue; } r -= I_SQ;
        if (r < I_SQ) { transpose_item(P.ple_w_gate + (size_t)2048 * 2048, 2048, 2048, (r % 64) * 32, 32, nullptr, (bf16*)(ws + WS_WG1), (r % 64) * 32, scr, r / 64, lane); continue; } r -= I_SQ;
        if (r < I_PJ) { transpose_item(P.ple_w_proj, 256, 2048, (r % 64) * 32, 32, nullptr, (bf16*)(ws + WS_WP0), (r % 64) * 32, scr, r / 64, lane); continue; } r -= I_PJ;
        transpose_item(P.ple_w_proj + (size_t)256 * 2048, 256, 2048, (r % 64) * 32, 32, nullptr, (bf16*)(ws + WS_WP1), (r % 64) * 32, scr, r / 64, lane);
    }
    { float* ssq0 = (float*)(ws + WS_CTL); bf16* hb = (bf16*)(ws + WS_HBA);
      for (int row = gw; row < M; row += NGW) { const f32x4* xr = (const f32x4*)(P.x + (size_t)row * D) + lane; f32x4 v[8]; float s = 0.f;
#pragma unroll
          for (int j = 0; j < 8; ++j) { v[j] = xr[64 * j]; s += (v[j][0] * v[j][0] + v[j][1] * v[j][1]) + (v[j][2] * v[j][2] + v[j][3] * v[j][3]); }
          s = wave_sum(s); if (lane == 0) ssq0[row] = s;
          u32x2* o = (u32x2*)(hb + (size_t)row * D) + lane;
#pragma unroll
          for (int j = 0; j < 8; ++j) { u32x2 w; w.x = cvt_pk_bf16(v[j][0], v[j][1]); w.y = cvt_pk_bf16(v[j][2], v[j][3]); o[64 * j] = w; } } }
}

__device__ __forceinline__ void post_norm_phase(const float* hin, const bf16* Y, const float* ssq, const float* g, float* hout, bf16* hb, const int wave_s) {
    int tid_ = my_tid(wave_s); asm volatile("" : "+v"(tid_)); const int tid = tid_, lane = tid & 63, wave = tid >> 6;
    const int gw = blockIdx.x * NWAVES + wave, NGW = gridDim.x * NWAVES;
    f32x4 gv[8];
#pragma unroll
    for (int j = 0; j < 8; ++j) gv[j] = *((const f32x4*)g + lane + 64 * j);
    for (int row = gw; row < M; row += NGW) {
        const float rs = __builtin_amdgcn_rsqf(ssq[row] * (1.f / 2048.f) + 1e-6f);
        const f32x4* hr = (const f32x4*)(hin + (size_t)row * D) + lane; const u32x2* yr = (const u32x2*)(Y + (size_t)row * D) + lane;
        f32x4* orow = (f32x4*)(hout + (size_t)row * D) + lane; u32x2* ob = (u32x2*)(hb + (size_t)row * D) + lane;
#pragma unroll
        for (int j = 0; j < 8; ++j) { const f32x4 h = hr[64 * j]; const u32x2 y = yr[64 * j]; f32x4 o;
            o[0] = h[0] + bflo(y.x) * rs * gv[j][0]; o[1] = h[1] + bfhi(y.x) * rs * gv[j][1]; o[2] = h[2] + bflo(y.y) * rs * gv[j][2]; o[3] = h[3] + bfhi(y.y) * rs * gv[j][3];
            orow[64 * j] = o; u32x2 w; w.x = cvt_pk_bf16(o[0], o[1]); w.y = cvt_pk_bf16(o[2], o[3]); ob[64 * j] = w; }
    }
}

__device__ __forceinline__ int crow(int r, int hi) { return (r & 3) + 8 * (r >> 2) + 4 * hi; }
__device__ __forceinline__ void attn_phase(unsigned char* lds, const bf16* Qg, const bf16* Kg, const bf16* Vg, const bf16* GAg, const float* small, const float* fbias, bf16* Z, const int wave_s) {
    int tid_ = my_tid(wave_s); asm volatile("" : "+v"(tid_)); const int tid = tid_, lane = tid & 63, wid = __builtin_amdgcn_readfirstlane(tid >> 6), r32 = lane & 31, hi = lane >> 5;
    float* c2 = (float*)lds;
    float* wtot = (float*)(lds + 8192);
    bf16* Ks = (bf16*)(lds + 8192 + 64);
    bf16* Vt = Ks + 64 * 72;
    for (int bh = blockIdx.x; bh < 256; bh += gridDim.x) {
        const int b = bh >> 4, h = bh & 15; const size_t rowbase = (size_t)b * T;
        __syncthreads();
        { float lf[4]; const float fb = fbias[h]; float run = 0.f;
#pragma unroll
          for (int i = 0; i < 4; ++i) { const float xg = small[(rowbase + 4 * tid + i) * 256 + 128 + h] + fb; const float ls = fminf(xg, 0.f) - log1pf(__expf(-fabsf(xg))); run += ls; lf[i] = run; }
          float sc = run;
#pragma unroll
          for (int o = 1; o < 64; o <<= 1) { const float t = __shfl_up(sc, o); if (lane >= o) sc += t; }
          if (lane == 63) wtot[wid] = sc;
          __syncthreads();
          float off = sc - run;
#pragma unroll
          for (int w = 0; w < 8; ++w) if (w < wid) off += wtot[w];
#pragma unroll
          for (int i = 0; i < 4; ++i) c2[4 * tid + i] = (off + lf[i]) * LOG2E; }
        __syncthreads();
        for (int qb = 0; qb < 8; ++qb) {
            const int q0w = qb * 256 + wid * 32, q = q0w + r32;
            bf16x8 qr[4];
#pragma unroll
            for (int d0 = 0; d0 < 4; ++d0) qr[d0] = *(const bf16x8*)(Qg + (rowbase + q) * 1024 + h * 64 + d0 * 16 + hi * 8);
            const float cq = c2[q];
            f32x16 o0, o1;
#pragma unroll
            for (int r = 0; r < 16; ++r) { o0[r] = 0.f; o1[r] = 0.f; }
            float mrow = -1e30f, l = 0.f;
            const int NT = qb * 4 + 4;
            const int kr = tid >> 3, ch = tid & 7, vr = lane, vc = wid;
            const bf16* kgp = Kg + (rowbase + kr) * 1024 + h * 64 + ch * 8; const bf16* vgp = Vg + (rowbase + vr) * 1024 + h * 64 + vc * 8;
            u32x4 kreg = *(const u32x4*)kgp, vreg = *(const u32x4*)vgp;
            for (int t = 0; t < NT; ++t) {
                asm volatile("s_waitcnt lgkmcnt(0)\n\ts_barrier" ::: "memory");
                { *(u32x4*)(Ks + kr * 72 + ch * 8) = kreg; bf16* vt = Vt + (vc * 8) * 72 + vr;
                  vt[0 * 72] = (bf16)(vreg.x & 0xffffu); vt[1 * 72] = (bf16)(vreg.x >> 16); vt[2 * 72] = (bf16)(vreg.y & 0xffffu); vt[3 * 72] = (bf16)(vreg.y >> 16);
                  vt[4 * 72] = (bf16)(vreg.z & 0xffffu); vt[5 * 72] = (bf16)(vreg.z >> 16); vt[6 * 72] = (bf16)(vreg.w & 0xffffu); vt[7 * 72] = (bf16)(vreg.w >> 16);
                  if (t + 1 < NT) { kreg = *(const u32x4*)(kgp + (size_t)(t + 1) * 64 * 1024); vreg = *(const u32x4*)(vgp + (size_t)(t + 1) * 64 * 1024); } }
                asm volatile("s_waitcnt lgkmcnt(0)\n\ts_barrier" ::: "memory");
                if (t * 64 <= q0w + 31) {
                    f32x16 p0, p1;
#pragma unroll
                    for (int r = 0; r < 16; ++r) { p0[r] = 0.f; p1[r] = 0.f; }
#pragma unroll
                    for (int d0 = 0; d0 < 4; ++d0) { const bf16x8 k0 = *(const bf16x8*)(Ks + r32 * 72 + d0 * 16 + hi * 8), k1 = *(const bf16x8*)(Ks + (32 + r32) * 72 + d0 * 16 + hi * 8);
                        p0 = __builtin_amdgcn_mfma_f32_32x32x16_bf16(k0, qr[d0], p0, 0, 0, 0); p1 = __builtin_amdgcn_mfma_f32_32x32x16_bf16(k1, qr[d0], p1, 0, 0, 0); }
                    const int kvb = t * 64 + 4 * hi;
#pragma unroll
                    for (int g4 = 0; g4 < 4; ++g4) { const f32x4 ca = *(const f32x4*)(c2 + kvb + 8 * g4), cb = *(const f32x4*)(c2 + kvb + 32 + 8 * g4);
#pragma unroll
                        for (int i = 0; i < 4; ++i) { p0[4 * g4 + i] += cq - ca[i]; p1[4 * g4 + i] += cq - cb[i]; } }
                    if (t * 64 + 63 > q0w) {
#pragma unroll
                        for (int r = 0; r < 16; ++r) { const int kv = kvb + (r & 3) + 8 * (r >> 2); if (kv > q) p0[r] = -1e30f; if (kv + 32 > q) p1[r] = -1e30f; } }
                    float mx = fmaxf(p0[0], p1[0]);
#pragma unroll
                    for (int r = 1; r < 16; ++r) mx = fmaxf(mx, fmaxf(p0[r], p1[r]));
                    mx = fmaxf(mx, __shfl_xor(mx, 32));
                    const float mnew = fmaxf(mrow, mx), alpha = __builtin_amdgcn_exp2f(mrow - mnew); mrow = mnew;
                    l *= alpha; float ls = 0.f;
#pragma unroll
                    for (int r = 0; r < 16; ++r) { o0[r] *= alpha; o1[r] *= alpha; p0[r] = __builtin_amdgcn_exp2f(p0[r] - mnew); p1[r] = __builtin_amdgcn_exp2f(p1[r] - mnew); ls += p0[r] + p1[r]; }
                    l += ls;
                    u32x4 pw[4];
#pragma unroll
                    for (int s = 0; s < 2; ++s) { pw[s].x = cvt_pk_bf16(p0[8 * s + 0], p0[8 * s + 1]); pw[s].y = cvt_pk_bf16(p0[8 * s + 2], p0[8 * s + 3]); pw[s].z = cvt_pk_bf16(p0[8 * s + 4], p0[8 * s + 5]); pw[s].w = cvt_pk_bf16(p0[8 * s + 6], p0[8 * s + 7]);
                        pw[2 + s].x = cvt_pk_bf16(p1[8 * s + 0], p1[8 * s + 1]); pw[2 + s].y = cvt_pk_bf16(p1[8 * s + 2], p1[8 * s + 3]); pw[2 + s].z = cvt_pk_bf16(p1[8 * s + 4], p1[8 * s + 5]); pw[2 + s].w = cvt_pk_bf16(p1[8 * s + 6], p1[8 * s + 7]); }
#pragma unroll
                    for (int s = 0; s < 4; ++s) { const bf16x8 pf = __builtin_bit_cast(bf16x8, pw[s]);
                        { const bf16* vp = Vt + r32 * 72 + 16 * s + 4 * hi; const u32x2 lo = *(const u32x2*)vp, hi2 = *(const u32x2*)(vp + 8); u32x4 va; va.x = lo.x; va.y = lo.y; va.z = hi2.x; va.w = hi2.y;
                          o0 = __builtin_amdgcn_mfma_f32_32x32x16_bf16(__builtin_bit_cast(bf16x8, va), pf, o0, 0, 0, 0); }
                        { const bf16* vp = Vt + (32 + r32) * 72 + 16 * s + 4 * hi; const u32x2 lo = *(const u32x2*)vp, hi2 = *(const u32x2*)(vp + 8); u32x4 va; va.x = lo.x; va.y = lo.y; va.z = hi2.x; va.w = hi2.y;
                          o1 = __builtin_amdgcn_mfma_f32_32x32x16_bf16(__builtin_bit_cast(bf16x8, va), pf, o1, 0, 0, 0); } }
                }
            }
            l += __shfl_xor(l, 32); const float inv = 1.f / l;
#pragma unroll
            for (int g4 = 0; g4 < 4; ++g4) {
                { const int d = 8 * g4 + 4 * hi; const u32x2 gg = *(const u32x2*)(GAg + (rowbase + q) * 1024 + h * 64 + d);
                  const float g0 = bflo(gg.x), g1 = bfhi(gg.x), g2 = bflo(gg.y), g3 = bfhi(gg.y); u32x2 w;
                  w.x = cvt_pk_bf16(o0[4 * g4 + 0] * inv * g0 * sigm(g0), o0[4 * g4 + 1] * inv * g1 * sigm(g1)); w.y = cvt_pk_bf16(o0[4 * g4 + 2] * inv * g2 * sigm(g2), o0[4 * g4 + 3] * inv * g3 * sigm(g3));
                  *(u32x2*)(Z + (rowbase + q) * 2048 + h * 64 + d) = w; }
                { const int d = 32 + 8 * g4 + 4 * hi; const u32x2 gg = *(const u32x2*)(GAg + (rowbase + q) * 1024 + h * 64 + d);
                  const float g0 = bflo(gg.x), g1 = bfhi(gg.x), g2 = bflo(gg.y), g3 = bfhi(gg.y); u32x2 w;
                  w.x = cvt_pk_bf16(o1[4 * g4 + 0] * inv * g0 * sigm(g0), o1[4 * g4 + 1] * inv * g1 * sigm(g1)); w.y = cvt_pk_bf16(o1[4 * g4 + 2] * inv * g2 * sigm(g2), o1[4 * g4 + 3] * inv * g3 * sigm(g3));
                  *(u32x2*)(Z + (rowbase + q) * 2048 + h * 64 + d) = w; }
            }
        }
    }
}
__device__ __forceinline__ float exp_fast(float x) { return __builtin_amdgcn_exp2f(1.4426950408889634f * x); }
__device__ __forceinline__ float softplusf_(float z) { return fmaxf(z, 0.f) + 0.6931471805599453f * __builtin_amdgcn_logf(1.0f + exp_fast(-fabsf(z))); }
__device__ __forceinline__ float tanh_fast(float x) { return 1.0f - 2.0f * __builtin_amdgcn_rcpf(1.0f + __builtin_amdgcn_exp2f(2.885390081777927f * x)); }
__device__ __forceinline__ void rwkv_phase(unsigned char* lds, const Ptrs& P, const bf16* Rg, const bf16* Kg, const bf16* Vg, const bf16* GBg, const float* small, bf16* Z, const int wave_s) {
    int tid_ = my_tid(wave_s); asm volatile("" : "+v"(tid_)); const int tid = tid_, lane = tid & 63, wv = __builtin_amdgcn_readfirstlane(tid >> 6);
#define RW_BAR() asm volatile("s_waitcnt lgkmcnt(0)\n\ts_barrier" ::: "memory")
    bf16* W2t = (bf16*)lds;
    bf16* A2t = W2t + 64 * 72;
    float* DL = (float*)lds + 4608;
    float* TW = DL + 4096;
    float* AL = TW + 2176;
    float* Rr = AL + 2176;
    float* Vv = Rr + 10240;
    float* Yb = Vv + 2048;
    float* red = Yb + 2048;
    float* Uu = red + 2048;
    float* CC = Uu + 1024;
    float* Cc = CC + 64;
    const int tt = tid >> 4, c4 = (tid & 15) * 4;
    for (int bh = blockIdx.x; bh < 256; bh += gridDim.x) {
        const int b = bh >> 4, h = bh & 15, hc = h * 64 + c4; const size_t rowbase = (size_t)b * T;
        __syncthreads();
        for (int i = tid; i < 4096; i += 512) { const int k = i >> 6, c = i & 63; W2t[c * 72 + k] = (bf16)(cvt_pk_bf16(P.rwkv_w2[(size_t)k * 1024 + h * 64 + c], 0.f) & 0xffffu); A2t[c * 72 + k] = (bf16)(cvt_pk_bf16(P.rwkv_a2[(size_t)k * 1024 + h * 64 + c], 0.f) & 0xffffu); }
        if (tid < 16) { const int cc = tid * 4, hcc = h * 64 + cc;
            *(f32x4*)(Cc + 0 * 64 + cc) = *(const f32x4*)(P.rwkv_mu + hcc); *(f32x4*)(Cc + 1 * 64 + cc) = *(const f32x4*)(P.rwkv_mu + 1024 + hcc); *(f32x4*)(Cc + 2 * 64 + cc) = *(const f32x4*)(P.rwkv_mu + 2048 + hcc);
            *(f32x4*)(Cc + 3 * 64 + cc) = *(const f32x4*)(P.rwkv_mu + 3072 + cc); *(f32x4*)(Cc + 4 * 64 + cc) = *(const f32x4*)(P.rwkv_mu + 3136 + cc);
            *(f32x4*)(Cc + 5 * 64 + cc) = *(const f32x4*)(P.rwkv_w0 + hcc); *(f32x4*)(Cc + 6 * 64 + cc) = *(const f32x4*)(P.rwkv_a0 + hcc); *(f32x4*)(Cc + 7 * 64 + cc) = *(const f32x4*)(P.rwkv_k_k + hcc);
            *(f32x4*)(Cc + 8 * 64 + cc) = *(const f32x4*)(P.rwkv_k_a + hcc); *(f32x4*)(Cc + 9 * 64 + cc) = *(const f32x4*)(P.rwkv_r_k + hcc); *(f32x4*)(Cc + 10 * 64 + cc) = *(const f32x4*)(P.rwkv_ln_g + hcc);
            *(f32x4*)(Cc + 11 * 64 + cc) = *(const f32x4*)(P.rwkv_ln_b + hcc); }
#define CV(k) (*(const f32x4*)(Cc + (k) * 64 + c4))
        f32x4 Sv[4];
#pragma unroll
        for (int g = 0; g < 4; ++g) Sv[g] = (f32x4){0.f, 0.f, 0.f, 0.f};
        { float* const EX = red; const float* exg = (const float*)(P.ws + WS_CTL + 0x100000) + (size_t)(b * 4) * 3200;
          for (int i = tid; i < 1280; i += 512) { const int q = i / 320, cc = i - q * 320; const int col = (cc < 192) ? ((cc >> 6) * 1024 + h * 64 + (cc & 63)) : (3072 + (cc - 192));
              EX[i] = exg[q * 3200 + col] * __builtin_amdgcn_rsqf(((const float*)(P.ws + WS_CTL))[rowbase + q] * (1.f / 2048.f) + 1e-6f); }
          __syncthreads(); }
        u32x2 n_rc, n_kc, n_vc, n_gg, n_rp = {0u, 0u}, n_kp = {0u, 0u}, n_vp = {0u, 0u}; f32x4 n_wl, n_al, n_wlp = {0.f, 0.f, 0.f, 0.f}, n_alp = {0.f, 0.f, 0.f, 0.f};
#define RW_FETCH(ckk) do { const size_t row_ = rowbase + (ckk) * 32 + tt; \
            n_rc = *(const u32x2*)(Rg + row_ * 1024 + hc); n_kc = *(const u32x2*)(Kg + row_ * 1024 + hc); n_vc = *(const u32x2*)(Vg + row_ * 1024 + hc); \
            n_wl = *(const f32x4*)(small + row_ * 256 + c4); n_al = *(const f32x4*)(small + row_ * 256 + 64 + c4); } while (0)
        RW_FETCH(0); n_gg = *(const u32x2*)(GBg + (rowbase + tt) * 1024 + hc);
#define RW_FETCH_PREV(rowp) do { n_rp = *(const u32x2*)(Rg + (rowp) * 1024 + hc); n_kp = *(const u32x2*)(Kg + (rowp) * 1024 + hc); n_vp = *(const u32x2*)(Vg + (rowp) * 1024 + hc); \
            n_wlp = *(const f32x4*)(small + (rowp) * 256 + c4); n_alp = *(const f32x4*)(small + (rowp) * 256 + 64 + c4); } while (0)
        if (tt > 0) RW_FETCH_PREV(rowbase + tt - 1);
        for (int ck = 0; ck < T / 32; ++ck) {
            const int t = ck * 32 + tt; const size_t row = rowbase + t;
            f32x4 rs, ks, vs;
            { const f32x4 mu_r = CV(0), mu_k = CV(1), mu_v = CV(2), mu_w = CV(3), mu_a = CV(4);
              const u32x2 rc = n_rc, kc = n_kc, vc = n_vc, rp = n_rp, kp = n_kp, vp = n_vp; f32x4 wl = n_wl, al = n_al, wlp = n_wlp, alp = n_alp;
              f32x4 rcf = {bflo(rc.x), bfhi(rc.x), bflo(rc.y), bfhi(rc.y)}, rpf = {bflo(rp.x), bfhi(rp.x), bflo(rp.y), bfhi(rp.y)};
              f32x4 kcf = {bflo(kc.x), bfhi(kc.x), bflo(kc.y), bfhi(kc.y)}, kpf = {bflo(kp.x), bfhi(kp.x), bflo(kp.y), bfhi(kp.y)};
              f32x4 vcf = {bflo(vc.x), bfhi(vc.x), bflo(vc.y), bfhi(vc.y)}, vpf = {bflo(vp.x), bfhi(vp.x), bflo(vp.y), bfhi(vp.y)};
              if (t < 4) { const float* ex = red + t * 320; rcf = *(const f32x4*)(ex + c4); kcf = *(const f32x4*)(ex + 64 + c4); vcf = *(const f32x4*)(ex + 128 + c4); wl = *(const f32x4*)(ex + 192 + c4); al = *(const f32x4*)(ex + 256 + c4);
                  if (t > 0) { const float* ep = ex - 320; rpf = *(const f32x4*)(ep + c4); kpf = *(const f32x4*)(ep + 64 + c4); vpf = *(const f32x4*)(ep + 128 + c4); wlp = *(const f32x4*)(ep + 192 + c4); alp = *(const f32x4*)(ep + 256 + c4); } }
              rs = rcf + (rpf - rcf) * mu_r; ks = kcf + (kpf - kcf) * mu_k; vs = vcf + (vpf - vcf) * mu_v;
              wl = wl + (wlp - wl) * mu_w; al = al + (alp - al) * mu_a;
              f32x4 tw; tw[0] = tanh_fast(wl[0]); tw[1] = tanh_fast(wl[1]); tw[2] = tanh_fast(wl[2]); tw[3] = tanh_fast(wl[3]);
              *(f32x4*)(TW + tt * 68 + c4) = tw; *(f32x4*)(AL + tt * 68 + c4) = al; }
            RW_BAR();
            float bon;
            if (wv < 4) { const int mat = wv >> 1, nt = wv & 1, r32 = lane & 31, hi5 = lane >> 5; const float* X = (mat ? AL : TW) + r32 * 68 + 8 * hi5; const bf16* Wt = (mat ? A2t : W2t) + (nt * 32 + r32) * 72 + 8 * hi5;
                f32x16 acc;
#pragma unroll
                for (int r = 0; r < 16; ++r) acc[r] = 0.f;
#pragma unroll
                for (int ks = 0; ks < 4; ++ks) { const f32x4 xa = *(const f32x4*)(X + 16 * ks), xb = *(const f32x4*)(X + 16 * ks + 4);
                    u32x4 ap; ap.x = cvt_pk_bf16(xa[0], xa[1]); ap.y = cvt_pk_bf16(xa[2], xa[3]); ap.z = cvt_pk_bf16(xb[0], xb[1]); ap.w = cvt_pk_bf16(xb[2], xb[3]);
                    const bf16x8 bp = *(const bf16x8*)(Wt + 16 * ks);
                    acc = __builtin_amdgcn_mfma_f32_32x32x16_bf16(__builtin_bit_cast(bf16x8, ap), bp, acc, 0, 0, 0); }
#pragma unroll
                for (int r = 0; r < 16; ++r) DL[mat * 2048 + ((r & 3) + 8 * (r >> 2) + 4 * hi5) * 64 + nt * 32 + r32] = acc[r]; }
            RW_BAR();
            { const f32x4 w0v = CV(5), a0v = CV(6), kkg = CV(7), kag = CV(8), rkg = CV(9); f32x4 wpre = w0v + *(const f32x4*)(DL + tt * 64 + c4), apre = a0v + *(const f32x4*)(DL + 2048 + tt * 64 + c4);
              f32x4 dec, av, kk, kp, bb; float ss = 0.f, bs = 0.f;
#pragma unroll
              for (int i = 0; i < 4; ++i) { const float wraw = -softplusf_(-wpre[i]) - 0.5f; dec[i] = exp_fast(-exp_fast(wraw)); av[i] = __builtin_amdgcn_rcpf(1.f + exp_fast(-apre[i])); kk[i] = ks[i] * kkg[i]; ss += kk[i] * kk[i]; }
              ss = red16(ss); const float inrm = __builtin_amdgcn_rsqf(fmaxf(ss, 1e-24f));
#pragma unroll
              for (int i = 0; i < 4; ++i) { kk[i] *= inrm; kp[i] = ks[i] * (1.f + (av[i] - 1.f) * kag[i]); bb[i] = kk[i] * av[i]; bs += rs[i] * kp[i] * rkg[i]; }
              bon = red16(bs);
              { float* pp = Rr + (tt >> 1) * 640 + (tt & 1) * 64 + c4;
                *(f32x4*)pp = rs; *(f32x4*)(pp + 128) = dec; *(f32x4*)(pp + 256) = kp; *(f32x4*)(pp + 384) = kk; *(f32x4*)(pp + 512) = bb; *(f32x4*)(Vv + tt * 64 + c4) = vs; } }
            RW_BAR();
            { const int p = tid >> 5, j2 = (tid & 31) * 2; float* pb = Rr + p * 640 + j2; typedef float f32x2v __attribute__((ext_vector_type(2)));
              const f32x2v r0 = *(const f32x2v*)pb, r1 = *(const f32x2v*)(pb + 64), w0 = *(const f32x2v*)(pb + 128), w1 = *(const f32x2v*)(pb + 192), k0 = *(const f32x2v*)(pb + 256), k1 = *(const f32x2v*)(pb + 320),
                            q0 = *(const f32x2v*)(pb + 384), q1 = *(const f32x2v*)(pb + 448), b0 = *(const f32x2v*)(pb + 512), b1 = *(const f32x2v*)(pb + 576);
              const f32x2v w1r1 = w1 * r1, B0 = b0 * w1, K0 = k0 * w1;
              *(f32x2v*)pb = q0; *(f32x2v*)(pb + 64) = w0 * q1; *(f32x2v*)(pb + 128) = w0 * r0; *(f32x2v*)(pb + 192) = w0 * w1r1;
              *(f32x2v*)(pb + 256) = w0 * w1; *(f32x2v*)(pb + 320) = B0; *(f32x2v*)(pb + 384) = K0; *(f32x2v*)(pb + 448) = b1; *(f32x2v*)(pb + 512) = k1;
              float d[8] = { b0.x * q1.x + b0.y * q1.y, k0.x * q1.x + k0.y * q1.y, b0.x * r0.x + b0.y * r0.y, k0.x * r0.x + k0.y * r0.y,
                             B0.x * r1.x + B0.y * r1.y, K0.x * r1.x + K0.y * r1.y, b1.x * r1.x + b1.y * r1.y, k1.x * r1.x + k1.y * r1.y };
#pragma unroll
              for (int o = 1; o < 32; o <<= 1) {
#pragma unroll
                  for (int e = 0; e < 8; ++e) d[e] += __shfl_xor(d[e], o); }
              if ((tid & 31) == 0) { *(f32x4*)(Uu + p * 8) = (f32x4){d[0], d[1], d[2], d[3]}; *(f32x4*)(Uu + p * 8 + 4) = (f32x4){d[4], d[5], d[6], d[7]}; } }
            RW_BAR();
            if (ck + 1 < T / 32) RW_FETCH(ck + 1);
            const int j0 = 16 * (wv & 3);
#define RW_LD16(dst, base) do { _Pragma("unroll") for (int g_ = 0; g_ < 4; ++g_) dst[g_] = *(const f32x4*)((base) + j0 + 4 * g_); } while (0)
#define RW_DOT16(x) ({ f32x4 a_ = Sv[0] * x[0] + Sv[1] * x[1] + Sv[2] * x[2] + Sv[3] * x[3]; (a_[0] + a_[1]) + (a_[2] + a_[3]); })
#pragma unroll 1
            for (int p = 0; p < 16; ++p) {
                const int par = (p & 1) * 1024; const float* pb = Rr + p * 640; const float* sc = Uu + p * 8;
                if (wv < 4) {
                    { f32x4 d0[4], d1[4], d2[4], d3[4]; RW_LD16(d0, pb); RW_LD16(d1, pb + 64); RW_LD16(d2, pb + 128); RW_LD16(d3, pb + 192);
                      red[par + wv * 64 + lane] = RW_DOT16(d0); red[par + 256 + wv * 64 + lane] = RW_DOT16(d1); red[par + 512 + wv * 64 + lane] = RW_DOT16(d2); red[par + 768 + wv * 64 + lane] = RW_DOT16(d3); }
                    asm volatile("" ::: "memory");
                    f32x4 u0[4], u1[4], u2[4], u3[4], u4[4]; RW_LD16(u0, pb + 256); RW_LD16(u1, pb + 320); RW_LD16(u2, pb + 384); RW_LD16(u3, pb + 448); RW_LD16(u4, pb + 512);
                    const float v0 = Vv[(2 * p) * 64 + lane], v1 = Vv[(2 * p + 1) * 64 + lane], c1 = sc[0], c2 = sc[1];
                    RW_BAR();
                    const float sa0 = (red[par + lane] + red[par + 64 + lane]) + (red[par + 128 + lane] + red[par + 192 + lane]);
                    const float q = (red[par + 256 + lane] + red[par + 320 + lane]) + (red[par + 384 + lane] + red[par + 448 + lane]);
                    const float sa1 = q - sa0 * c1 + v0 * c2;
#pragma unroll
                    for (int g = 0; g < 4; ++g) Sv[g] = Sv[g] * u0[g] - sa0 * u1[g] + v0 * u2[g] - sa1 * u3[g] + v1 * u4[g];
                } else {
                    RW_BAR();
                    if (wv < 6) {
                        const float v0 = Vv[(2 * p) * 64 + lane];
                        const float sa0 = (red[par + lane] + red[par + 64 + lane]) + (red[par + 128 + lane] + red[par + 192 + lane]);
                        if (wv == 4) { const float y0 = (red[par + 512 + lane] + red[par + 576 + lane]) + (red[par + 640 + lane] + red[par + 704 + lane]);
                            Yb[(2 * p) * 64 + lane] = y0 - sa0 * sc[2] + v0 * sc[3]; }
                        else { const float v1 = Vv[(2 * p + 1) * 64 + lane];
                            const float q = (red[par + 256 + lane] + red[par + 320 + lane]) + (red[par + 384 + lane] + red[par + 448 + lane]);
                            const float sa1 = q - sa0 * sc[0] + v0 * sc[1];
                            const float y1 = (red[par + 768 + lane] + red[par + 832 + lane]) + (red[par + 896 + lane] + red[par + 960 + lane]);
                            Yb[(2 * p + 1) * 64 + lane] = y1 - sa0 * sc[4] + v0 * sc[5] - sa1 * sc[6] + v1 * sc[7]; } }
                    else if (p == 0) {
                        const size_t i8 = ((size_t)((blockIdx.x * 2 + (wv - 6)) * 64 + ck)) * 64 + lane;
                        const f32x4 pa = *(const f32x4*)(P.p + i8 * 8), pq = *(const f32x4*)(P.p + i8 * 8 + 4);
                        *(u32x4*)((bf16*)(P.ws + WS_PB) + i8 * 8) = pg8::pack8(pa, pq); } }
            }
            if (ck + 1 < T / 32) RW_FETCH_PREV(row + 31);
            RW_BAR();
#undef RW_LD16
#undef RW_BAR
#undef RW_DOT16
            { const f32x4 lng = CV(10), lnb = CV(11); const f32x4 y4 = *(const f32x4*)(Yb + tt * 64 + c4); const float mean = red16((y4[0] + y4[1]) + (y4[2] + y4[3])) * (1.f / 64.f);
              const f32x4 d = y4 - mean; const float var = red16((d[0] * d[0] + d[1] * d[1]) + (d[2] * d[2] + d[3] * d[3])) * (1.f / 64.f); const float rstd = __builtin_amdgcn_rsqf(var + 64e-5f);
              const u32x2 gg = n_gg; if (ck + 1 < T / 32) n_gg = *(const u32x2*)(GBg + (row + 32) * 1024 + hc);
              const float g0 = bflo(gg.x), g1 = bfhi(gg.x), g2 = bflo(gg.y), g3 = bfhi(gg.y);
              const float z0 = (d[0] * rstd * lng[0] + lnb[0] + bon * vs[0]) * g0 * sigm(g0), z1 = (d[1] * rstd * lng[1] + lnb[1] + bon * vs[1]) * g1 * sigm(g1);
              const float z2 = (d[2] * rstd * lng[2] + lnb[2] + bon * vs[2]) * g2 * sigm(g2), z3 = (d[3] * rstd * lng[3] + lnb[3] + bon * vs[3]) * g3 * sigm(g3);
              u32x2 w; w.x = cvt_pk_bf16(z0, z1); w.y = cvt_pk_bf16(z2, z3); *(u32x2*)(Z + row * 2048 + 1024 + hc) = w; }
        }
    }
}

#undef RW_FETCH
#undef RW_FETCH_PREV
#undef CV
__device__ __forceinline__ void gmlp_phase(unsigned char* lds, const Ptrs& P, const bf16* Ug, const bf16* Vg, const bf16* Gg, const float* vsum, const float* vsq, bf16* Z, const int wave_s) {
    int tid_ = my_tid(wave_s); asm volatile("" : "+v"(tid_)); const int tid = tid_, lane = tid & 63, wid = __builtin_amdgcn_readfirstlane(tid >> 6), r32 = lane & 31, hi = lane >> 5;
    bf16* As = (bf16*)lds;
    bf16* Bt = As + 128 * 136;
    float* Ds = (float*)(lds + 2 * 128 * 136 * 2 + 256);
    int gcur = -1;
    for (int u = blockIdx.x; u < 4096; u += gridDim.x) {
        const int g = u & 15, bn = u >> 4; const size_t row0 = (size_t)bn * 128; const int C0 = g * 128;
        __syncthreads();
        if (g != gcur) { gcur = g; const float* ws_ = P.c_w_s + (size_t)g * 128 * 128;
            for (int i = tid; i < 128 * 128 / 4; i += 512) { const int t = i >> 5, s4 = (i & 31) * 4; f32x4 w = *(const f32x4*)(ws_ + t * 128 + s4);
                u32x2 o; o.x = cvt_pk_bf16(s4 + 0 <= t ? w[0] : 0.f, s4 + 1 <= t ? w[1] : 0.f); o.y = cvt_pk_bf16(s4 + 2 <= t ? w[2] : 0.f, s4 + 3 <= t ? w[3] : 0.f); *(u32x2*)(As + t * 136 + s4) = o; } }
#pragma unroll
        for (int it = 0; it < 4; ++it) { const int i = tid + it * 512, s = i >> 4, c8 = (i & 15) * 8; const size_t row = row0 + s;
            const float mean = vsum[row] * (1.f / 2048.f), var = vsq[row] * (1.f / 2048.f) - mean * mean, rstd = __builtin_amdgcn_rsqf(fmaxf(var, 0.f) + 1e-5f);
            const u32x4 vv = *(const u32x4*)(Vg + row * 2048 + C0 + c8); const f32x4 lg0 = *(const f32x4*)(P.c_ln_g + C0 + c8), lg1 = *(const f32x4*)(P.c_ln_g + C0 + c8 + 4), lb0 = *(const f32x4*)(P.c_ln_b + C0 + c8), lb1 = *(const f32x4*)(P.c_ln_b + C0 + c8 + 4);
            float x[8] = {bflo(vv.x), bfhi(vv.x), bflo(vv.y), bfhi(vv.y), bflo(vv.z), bfhi(vv.z), bflo(vv.w), bfhi(vv.w)};
#pragma unroll
            for (int j = 0; j < 8; ++j) { const float gn = (x[j] - mean) * rstd * (j < 4 ? lg0[j & 3] : lg1[j & 3]) + (j < 4 ? lb0[j & 3] : lb1[j & 3]); const float nb = __shfl_xor(gn, 0); (void)nb;
                Bt[(c8 + j) * 136 + (c8 >> 3) * 8 + s] = (bf16)(cvt_pk_bf16(gn, 0.f) & 0xffffu); } }
        __syncthreads();
        { const int tb = wid >> 1, cb = (wid & 1) * 64; f32x16 d0, d1;
#pragma unroll
          for (int r = 0; r < 16; ++r) { d0[r] = 0.f; d1[r] = 0.f; }
          for (int k = 0; k <= 2 * tb + 1; ++k) {
              const bf16x8 a = *(const bf16x8*)(As + (32 * tb + r32) * 136 + 16 * k + 8 * hi);
              const bf16x8 b0 = *(const bf16x8*)(Bt + (cb + r32) * 136 + ((cb + r32) >> 3) * 8 + 16 * k + 8 * hi), b1 = *(const bf16x8*)(Bt + (cb + 32 + r32) * 136 + ((cb + 32 + r32) >> 3) * 8 + 16 * k + 8 * hi);
              d0 = __builtin_amdgcn_mfma_f32_32x32x16_bf16(a, b0, d0, 0, 0, 0); d1 = __builtin_amdgcn_mfma_f32_32x32x16_bf16(a, b1, d1, 0, 0, 0); }
#pragma unroll
          for (int r = 0; r < 16; ++r) { const int t = 32 * tb + crow(r, hi); Ds[t * 132 + cb + r32] = d0[r]; Ds[t * 132 + cb + 32 + r32] = d1[r]; } }
        __syncthreads();
#pragma unroll
        for (int it = 0; it < 4; ++it) { const int i = tid + it * 512, t = i >> 4, c8 = (i & 15) * 8; const size_t off = (row0 + t) * 2048 + C0 + c8;
            const float bs = P.c_b_s[g * 128 + t]; const u32x4 uu = *(const u32x4*)(Ug + off), gg = *(const u32x4*)(Gg + off);
            const f32x4 da = *(const f32x4*)(Ds + t * 132 + c8), db = *(const f32x4*)(Ds + t * 132 + c8 + 4); u32x4 o;
            o.x = cvt_pk_bf16(bflo(uu.x) * (da[0] + bs) * bflo(gg.x), bfhi(uu.x) * (da[1] + bs) * bfhi(gg.x)); o.y = cvt_pk_bf16(bflo(uu.y) * (da[2] + bs) * bflo(gg.y), bfhi(uu.y) * (da[3] + bs) * bfhi(gg.y));
            o.z = cvt_pk_bf16(bflo(uu.z) * (db[0] + bs) * bflo(gg.z), bfhi(uu.z) * (db[1] + bs) * bfhi(gg.z)); o.w = cvt_pk_bf16(bflo(uu.w) * (db[2] + bs) * bflo(gg.w), bfhi(uu.w) * (db[3] + bs) * bfhi(gg.w));
            *(u32x4*)(Z + off) = o; }
    }
}

__global__ void __launch_bounds__(512, 2) mega_fwd(Ptrs P) {
    extern __shared__ __attribute__((aligned(16))) unsigned char lds[];
    cg::grid_group grid = cg::this_grid();
    const int wave_s = __builtin_amdgcn_readfirstlane((int)threadIdx.x >> 6);
    unsigned char* ws = P.ws;
    float* ctl = (float*)(ws + WS_CTL);
    float *ssq0 = ctl, *ssqA = ctl + M, *ssqB = ctl + 2 * M, *ssqC = ctl + 3 * M, *vsum = ctl + 4 * M, *vsq = ctl + 5 * M;
    bf16* G = (bf16*)(ws + WS_G); const size_t GS = (size_t)M * 1024;
    bf16* HBA = (bf16*)(ws + WS_HBA); bf16* PB = (bf16*)(ws + WS_PB); float* SMALL = (float*)(ws + WS_SMALL); bf16* Zb = (bf16*)(ws + WS_Z);
    bf16* Y0 = G; bf16* PP0 = G + 2 * GS; bf16* HBB = G + 6 * GS;
    bf16* U_u = G; bf16* U_v = G + 2 * GS; bf16* U_g = G + 4 * GS;
    bf16* Y1 = G + 6 * GS; bf16* PP1 = G;
    const int lo = P.ph_lo, hi = P.ph_hi;
    PG8_LAS unsigned char* lds3 = (PG8_LAS unsigned char*)lds;
#define IN(k) (lo <= (k) && (k) < hi)
    unsigned* const gbar = (unsigned*)(ws + WS_CTL + 0x1F0000);
#define SEAM(k) do { if (IN(k) && IN((k) + 1)) { if ((k) == 0) grid.sync(); else { \
        asm volatile("s_waitcnt vmcnt(0) lgkmcnt(0)" ::: "memory"); __syncthreads(); \
        if (my_tid(wave_s) == 0) { __builtin_amdgcn_fence(__ATOMIC_RELEASE, "agent"); asm volatile("s_waitcnt vmcnt(0)" ::: "memory"); \
            __hip_atomic_fetch_add(gbar, 1u, __ATOMIC_RELAXED, __HIP_MEMORY_SCOPE_AGENT); \
            while (__hip_atomic_load(gbar, __ATOMIC_RELAXED, __HIP_MEMORY_SCOPE_AGENT) < 256u * (unsigned)(k)) __builtin_amdgcn_s_sleep(4); \
            __builtin_amdgcn_fence(__ATOMIC_ACQUIRE, "agent"); asm volatile("s_waitcnt vmcnt(0)" ::: "memory"); } \
        __syncthreads(); } } } while (0)
    if (IN(0)) { p0_prologue(P, lds, wave_s); } SEAM(0);
    if (IN(1)) { pg8::Gemm g{HBA, (const bf16*)(ws + WS_WIN0), M, N_IN0, 2048}; pg8::StaticOrder S; S.init(M, N_IN0, gridDim.x, blockIdx.x);
        pg8::EpiIn0 E{G, SMALL, ssq0, 0.125f * LOG2E}; pg8::gemm_phase<pg8::EpiIn0, pg8::StaticOrder, true, true>(lds3, g, S, E, my_tid(wave_s)); } SEAM(1);
    if (IN(2)) { attn_phase(lds, G, G + GS, G + 2 * GS, G + 3 * GS, SMALL, P.fox_f_bias, Zb, wave_s);
        rwkv_phase(lds, P, G + 4 * GS, G + 5 * GS, G + 6 * GS, G + 7 * GS, SMALL, Zb, wave_s); } SEAM(2);
    if (IN(3)) { { pg8::Gemm g{Zb, (const bf16*)(ws + WS_WOUT0), M, 2048, 2048}; pg8::StaticOrder S; S.init(M, 2048, gridDim.x, blockIdx.x);
          pg8::EpiY E{Y0, ssqA}; pg8::gemm_phase<pg8::EpiY, pg8::StaticOrder, true, true>(lds3, g, S, E, my_tid(wave_s)); }
        { pg8::Gemm g{PB, (const bf16*)(ws + WS_WP0), M, 2048, 256}; pg8::StaticOrder S; S.init(M, 2048, gridDim.x, blockIdx.x);
          pg8::EpiBf16<0> E{PP0, 2048, nullptr, 0, 0, 1.f}; pg8::gemm_phase<pg8::EpiBf16<0>, pg8::StaticOrder, true, true>(lds3, g, S, E, my_tid(wave_s)); } } SEAM(3);
    if (IN(4)) { post_norm_phase(P.x, Y0, ssqA, P.norm_post, P.out, HBA, wave_s); } SEAM(4);
    if (IN(5)) { pg8::Gemm g{HBA, (const bf16*)(ws + WS_WG0), M, 2048, 2048}; pg8::StaticOrder S; S.init(M, 2048, gridDim.x, blockIdx.x);
        pg8::EpiGate E{P.out, PP0, HBB, ssqB}; pg8::gemm_phase<pg8::EpiGate, pg8::StaticOrder, true, true>(lds3, g, S, E, my_tid(wave_s)); } SEAM(5);
    if (IN(6)) { pg8::Gemm g{HBB, (const bf16*)(ws + WS_WIN1), M, 6144, 2048}; pg8::StaticOrder S; S.init(M, 6144, gridDim.x, blockIdx.x);
        pg8::EpiC E{U_u, 2 * GS, ssqB, vsum, vsq}; pg8::gemm_phase<pg8::EpiC, pg8::StaticOrder, true, true>(lds3, g, S, E, my_tid(wave_s)); } SEAM(6);
    if (IN(7)) { gmlp_phase(lds, P, U_u, U_v, U_g, vsum, vsq, Zb, wave_s); } SEAM(7);
    if (IN(8)) { { pg8::Gemm g{Zb, (const bf16*)(ws + WS_WOUT1), M, 2048, 2048}; pg8::StaticOrder S; S.init(M, 2048, gridDim.x, blockIdx.x);
          pg8::EpiY E{Y1, ssqC}; pg8::gemm_phase<pg8::EpiY, pg8::StaticOrder, true, true>(lds3, g, S, E, my_tid(wave_s)); }
        { pg8::Gemm g{PB + (size_t)M * 256, (const bf16*)(ws + WS_WP1), M, 2048, 256}; pg8::StaticOrder S; S.init(M, 2048, gridDim.x, blockIdx.x);
          pg8::EpiBf16<0> E{PP1, 2048, nullptr, 0, 0, 1.f}; pg8::gemm_phase<pg8::EpiBf16<0>, pg8::StaticOrder, true, true>(lds3, g, S, E, my_tid(wave_s)); } } SEAM(8);
    if (IN(9)) { post_norm_phase(P.out, Y1, ssqC, P.norm_post + 2048, P.out, HBA, wave_s); } SEAM(9);
    if (IN(10)) { pg8::Gemm g{HBA, (const bf16*)(ws + WS_WG1), M, 2048, 2048}; pg8::StaticOrder S; S.init(M, 2048, gridDim.x, blockIdx.x);
        pg8::EpiGate E{P.out, PP1, nullptr, nullptr}; pg8::gemm_phase<pg8::EpiGate, pg8::StaticOrder, true, true>(lds3, g, S, E, my_tid(wave_s)); }
#undef IN
#undef SEAM
}

#ifndef MK_PER_PHASE
#define MK_PER_PHASE 0
#endif
constexpr int N_PHASES = 11;
extern "C" void kernel_launch(void* const* d_in, const int* in_sizes, int n_in, void* d_out, int out_size, void* d_ws, size_t ws_size, hipStream_t stream) {
    static int grid = 0;
    if (grid == 0) {
        if (n_in != 25 || ws_size < WS_END) { fprintf(stderr, "kernel_launch: need 25 inputs and %zu bytes of workspace (got %d, %zu)\n", (size_t)WS_END, n_in, ws_size); grid = -1; return; }
        int dev = 0, cus = 0, per_cu = 0;
        hipGetDevice(&dev); hipDeviceGetAttribute(&cus, hipDeviceAttributeMultiprocessorCount, dev);
        if (hipFuncSetAttribute((const void*)mega_fwd, hipFuncAttributeMaxDynamicSharedMemorySize, LDS_BYTES) != hipSuccess) { fprintf(stderr, "kernel_launch: hipFuncSetAttribute failed\n"); grid = -1; return; }
        hipOccupancyMaxActiveBlocksPerMultiprocessor(&per_cu, (const void*)mega_fwd, 512, LDS_BYTES);
        (void)hipGetLastError();
        if (per_cu < 1) { fprintf(stderr, "kernel_launch: occupancy query says %d blocks per CU\n", per_cu); per_cu = 1; }
        if (cus < 256) { fprintf(stderr, "kernel_launch: built for a 256-CU device (got %d CUs)\n", cus); grid = -1; return; }
        grid = 256;
    }
    if (grid < 0) return;
    (void)hipMemsetAsync((char*)d_ws + WS_CTL + 0x1F0000, 0, 256, stream);
    Ptrs p{};
    const float** pp = (const float**)&p;
    for (int i = 0; i < 25; ++i) pp[i] = (const float*)d_in[i];
    p.out = (float*)d_out; p.ws = (unsigned char*)d_ws;
#if MK_PER_PHASE
    for (int k = 0; k < N_PHASES; ++k) { p.ph_lo = k; p.ph_hi = k + 1; hipLaunchKernelGGL(mega_fwd, dim3(grid), dim3(512), LDS_BYTES, stream, p); }
#else
    p.ph_lo = 0; p.ph_hi = N_PHASES;
    void* args[] = {&p};
    hipError_t e = hipLaunchCooperativeKernel((const void*)mega_fwd, dim3(grid), dim3(512), args, LDS_BYTES, stream);
    if (e != hipSuccess) fprintf(stderr, "cooperative launch failed: %s (grid %d)\n", hipGetErrorString(e), grid);
#endif
}
```

```cpp
#include <hip/hip_runtime.h>
#include <hip/hip_cooperative_groups.h>
#include <cstdio>
#include <cstdint>
namespace cg = cooperative_groups;
namespace pg8 {
#define PG8_LAS __attribute__((address_space(3)))
typedef unsigned short bf16_t;
typedef short bf16x8 __attribute__((ext_vector_type(8)));
typedef float f32x4 __attribute__((ext_vector_type(4)));
typedef unsigned u32x4 __attribute__((ext_vector_type(4)));
constexpr int BM = 256, BK = 64, HALF = 128, HTB = HALF * BK * 2  , STAGE_BYTES = 8 * HTB, NXCD = 8, WGM = 8;

__host__ __device__ __forceinline__ int lds_byte(int r, int c) { const int st = (r >> 4) * 2 + (c >> 5), rr = r & 15, cc = c & 31, ob = rr * 64 + cc * 2; return st * 1024 + (ob ^ (((ob >> 9) & 1) << 5)); }
__host__ __device__ __forceinline__ void stage_rc(int b, int& R, int& C) { const int st = b / 1024, sb = b % 1024, swz = sb ^ (((sb >> 9) & 1) << 5); R = (st >> 1) * 16 + swz / 64; C = (st & 1) * 32 + (swz % 64) / 2; }
__host__ __device__ __forceinline__ int perm32(int rho) { const int n = rho >> 4, i = rho & 15; return 8 * (i >> 2) + 4 * n + (i & 3); }

struct Unit { int pm, pn; };
struct Gemm { const bf16_t* A; const bf16_t* Bt; int M, N, K; };

struct StaticOrder {
    int nM, nN, nwg, G, c;
    __host__ __device__ void init(int M, int N, int G_, int c_) { nM = M / BM; nN = N / BM; nwg = nM * nN; G = G_; c = c_; }
    __host__ __device__ bool next(int i, Unit& u) const {
        const long L = (long)i * G + c; if (L >= nwg) return false;
        int wgid = (int)L; { const int q = nwg / NXCD, r = nwg % NXCD, xcd = wgid % NXCD, off = wgid / NXCD; wgid = (xcd < r ? xcd * (q + 1) : r * (q + 1) + (xcd - r) * q) + off; }
        const int nig = WGM * nN, gid = wgid / nig, fm = gid * WGM, gsz = (nM - fm) < WGM ? (nM - fm) : WGM;
        u.pm = fm + ((wgid % nig) % gsz); u.pn = (wgid % nig) / gsz; return true;
    }
    __device__ __forceinline__ void a_ready(const Unit&) const {}
    __device__ __forceinline__ void done(const Unit&) const {}
};

__device__ __forceinline__ unsigned cvt_pk_bf16(float lo, float hi) { unsigned r; asm volatile("v_cvt_pk_bf16_f32 %0, %1, %2" : "=v"(r) : "v"(lo), "v"(hi)); return r; }
typedef float f32x2 __attribute__((ext_vector_type(2)));
__device__ __forceinline__ f32x2 gelu_pk(f32x2 v) {
    const f32x2 av = __builtin_elementwise_abs(v), d = av * 0.2316418882f + 1.0f;
    f32x2 t; t.x = __builtin_amdgcn_rcpf(d.x); t.y = __builtin_amdgcn_rcpf(d.y);
    f32x2 q = t * 0.5307027145f + (-0.7265760135f); q = q * t + 0.7107068705f; q = q * t + (-0.142248368f); q = q * t + 0.127414796f; q = q * t;
    const f32x2 s = (v * v) * (-0.72134752044f);
    f32x2 e; e.x = __builtin_amdgcn_exp2f(s.x); e.y = __builtin_amdgcn_exp2f(s.y);
    const f32x2 m = v * (q * e), r = v - m;
    f32x2 o; o.x = v.x < 0.f ? m.x : r.x; o.y = v.y < 0.f ? m.y : r.y; return o;
}
template <int ACT  > struct EpiBf16 {
    static constexpr bool PERM = true, AFTER_DRAIN = false; static_assert(ACT == 0 || ACT == 1, "EpiBf16: ACT is 0 (none) or 1 (gelu_pk)");
    bf16_t* O; int ldc; const float* bias; int split_cols; size_t split_stride; float scale0;
    __device__ __forceinline__ void operator()(const f32x4 (&acc)[2][2][4][2], const Unit& u, int wr, int wc, int fr, int fq) const {
        const int row0 = u.pm * BM + wr * 64 + fr; int colt = u.pn * BM; bf16_t* base = O;
        float sc = 1.f; if (split_cols) { const int t = colt / split_cols; base += (size_t)t * split_stride; colt -= t * split_cols; if (t == 0) sc = scale0; }
        const int col0 = colt + wc * 32 + 8 * fq, bcol0 = u.pn * BM + wc * 32 + 8 * fq;
        f32x4 bv[2][2];
#pragma unroll
        for (int bj = 0; bj < 2; ++bj)
#pragma unroll
            for (int n = 0; n < 2; ++n) bv[bj][n] = bias ? *(const f32x4*)(bias + bcol0 + bj * HALF + 4 * n) : (f32x4){0.f, 0.f, 0.f, 0.f};
#pragma unroll
        for (int ai = 0; ai < 2; ++ai)
#pragma unroll
            for (int m = 0; m < 4; ++m) { bf16_t* rowp = base + (size_t)(row0 + ai * HALF + m * 16) * ldc + col0;
#pragma unroll
                for (int bj = 0; bj < 2; ++bj) { f32x4 v0 = acc[ai][bj][m][0] + bv[bj][0], v1 = acc[ai][bj][m][1] + bv[bj][1];
                    if (ACT == 1) { f32x2 a = gelu_pk((f32x2){v0[0], v0[1]}), b = gelu_pk((f32x2){v0[2], v0[3]}), c = gelu_pk((f32x2){v1[0], v1[1]}), d = gelu_pk((f32x2){v1[2], v1[3]});
                        v0 = (f32x4){a.x, a.y, b.x, b.y}; v1 = (f32x4){c.x, c.y, d.x, d.y}; }
                    v0 = v0 * sc; v1 = v1 * sc; u32x4 w; w.x = cvt_pk_bf16(v0[0], v0[1]); w.y = cvt_pk_bf16(v0[2], v0[3]); w.z = cvt_pk_bf16(v1[0], v1[1]); w.w = cvt_pk_bf16(v1[2], v1[3]);
                    *(u32x4*)(rowp + bj * HALF) = w; } }
    }
};
__device__ __forceinline__ u32x4 pack8(const f32x4 v0, const f32x4 v1) { u32x4 w; w.x = cvt_pk_bf16(v0[0], v0[1]); w.y = cvt_pk_bf16(v0[2], v0[3]); w.z = cvt_pk_bf16(v1[0], v1[1]); w.w = cvt_pk_bf16(v1[2], v1[3]); return w; }
__device__ __forceinline__ float bflo(unsigned u) { return __uint_as_float(u << 16); }
__device__ __forceinline__ float bfhi(unsigned u) { return __uint_as_float(u & 0xffff0000u); }
__device__ __forceinline__ float sigm(float x) { return __builtin_amdgcn_rcpf(1.0f + __builtin_amdgcn_exp2f(-1.4426950408889634f * x)); }
#define PG8_FOR_AI_M _Pragma("unroll") for (int ai = 0; ai < 2; ++ai) _Pragma("unroll") for (int m = 0; m < 4; ++m)
struct EpiIn0 {
    static constexpr bool PERM = true, AFTER_DRAIN = false;
    bf16_t* G; float* small; const float* ssq; float qscale;
    __device__ __forceinline__ void operator()(const f32x4 (&acc)[2][2][4][2], const Unit& u, int wr, int wc, int fr_, int fq_) const {
        int fr = fr_, fq = fq_; asm volatile("" : "+v"(fr), "+v"(fq));
        const int row0 = u.pm * BM + wr * 64 + fr, ct = wc * 32 + 8 * fq;
        float rsv[2][4];
        PG8_FOR_AI_M rsv[ai][m] = __builtin_amdgcn_rsqf(ssq[row0 + ai * HALF + m * 16] * (1.f / 2048.f) + 1e-6f);
        if (u.pn < 32) {
            const int grp = u.pn >> 2; bf16_t* base = G + (size_t)grp * ((size_t)32768 * 1024) + (u.pn & 3) * 256 + ct; const float sc0 = (grp == 0) ? qscale : 1.f;
            PG8_FOR_AI_M { const int row = row0 + ai * HALF + m * 16; const float rs = rsv[ai][m] * sc0; bf16_t* rp = base + (size_t)row * 1024;
#pragma unroll
                for (int bj = 0; bj < 2; ++bj) *(u32x4*)(rp + bj * HALF) = pack8(acc[ai][bj][m][0] * rs, acc[ai][bj][m][1] * rs); }
        } else {
            PG8_FOR_AI_M { const int row = row0 + ai * HALF + m * 16; const float rs = rsv[ai][m]; float* rp = small + (size_t)row * 256 + ct;
#pragma unroll
                for (int bj = 0; bj < 2; ++bj) { *(f32x4*)(rp + bj * HALF) = acc[ai][bj][m][0] * rs; *(f32x4*)(rp + bj * HALF + 4) = acc[ai][bj][m][1] * rs; } }
        }
    }
};
struct EpiY {
    static constexpr bool PERM = true, AFTER_DRAIN = false;
    bf16_t* Y; float* ssq;
    __device__ __forceinline__ void operator()(const f32x4 (&acc)[2][2][4][2], const Unit& u, int wr, int wc, int fr_, int fq_) const {
        int fr = fr_, fq = fq_; asm volatile("" : "+v"(fr), "+v"(fq));
        const int row0 = u.pm * BM + wr * 64 + fr, col0 = u.pn * BM + wc * 32 + 8 * fq;
        PG8_FOR_AI_M { const int row = row0 + ai * HALF + m * 16; float s = 0.f; bf16_t* rp = Y + (size_t)row * 2048 + col0;
#pragma unroll
            for (int bj = 0; bj < 2; ++bj) { const f32x4 v0 = acc[ai][bj][m][0], v1 = acc[ai][bj][m][1];
                s += (v0[0] * v0[0] + v0[1] * v0[1]) + (v0[2] * v0[2] + v0[3] * v0[3]) + (v1[0] * v1[0] + v1[1] * v1[1]) + (v1[2] * v1[2] + v1[3] * v1[3]);
                *(u32x4*)(rp + bj * HALF) = pack8(v0, v1); }
            s += __shfl_xor(s, 16); s += __shfl_xor(s, 32);
            if (fq == 0) __hip_atomic_fetch_add(ssq + row, s, __ATOMIC_RELAXED, __HIP_MEMORY_SCOPE_AGENT); }
    }
};
struct EpiGate {
    static constexpr bool PERM = true, AFTER_DRAIN = false;
    float* H; const bf16_t* PP; bf16_t* HB; float* ssq;
    __device__ __forceinline__ void operator()(const f32x4 (&acc)[2][2][4][2], const Unit& u, int wr, int wc, int fr_, int fq_) const {
        int fr = fr_, fq = fq_; asm volatile("" : "+v"(fr), "+v"(fq));
        const int row0 = u.pm * BM + wr * 64 + fr, col0 = u.pn * BM + wc * 32 + 8 * fq;
#pragma unroll
        for (int ai = 0; ai < 2; ++ai)
#pragma unroll
            for (int mp = 0; mp < 2; ++mp) {
                f32x4 hh[2][2][2]; u32x4 pq[2][2];
#pragma unroll
                for (int mm = 0; mm < 2; ++mm)
#pragma unroll
                    for (int bj = 0; bj < 2; ++bj) { const size_t off = (size_t)(row0 + ai * HALF + (2 * mp + mm) * 16) * 2048 + col0 + bj * HALF;
                        hh[mm][bj][0] = *(const f32x4*)(H + off); hh[mm][bj][1] = *(const f32x4*)(H + off + 4); pq[mm][bj] = *(const u32x4*)(PP + off); }
#pragma unroll
                for (int mm = 0; mm < 2; ++mm) { const int m = 2 * mp + mm; const int row = row0 + ai * HALF + m * 16; float s = 0.f;
#pragma unroll
                    for (int bj = 0; bj < 2; ++bj) { const size_t off = (size_t)row * 2048 + col0 + bj * HALF; float* hp = H + off;
                        const f32x4 h0 = hh[mm][bj][0], h1 = hh[mm][bj][1]; const u32x4 pp = pq[mm][bj];
                        const f32x4 a0 = acc[ai][bj][m][0], a1 = acc[ai][bj][m][1]; f32x4 o0, o1;
                        o0[0] = h0[0] + bflo(pp.x) * sigm(a0[0]); o0[1] = h0[1] + bfhi(pp.x) * sigm(a0[1]); o0[2] = h0[2] + bflo(pp.y) * sigm(a0[2]); o0[3] = h0[3] + bfhi(pp.y) * sigm(a0[3]);
                        o1[0] = h1[0] + bflo(pp.z) * sigm(a1[0]); o1[1] = h1[1] + bfhi(pp.z) * sigm(a1[1]); o1[2] = h1[2] + bflo(pp.w) * sigm(a1[2]); o1[3] = h1[3] + bfhi(pp.w) * sigm(a1[3]);
                        *(f32x4*)hp = o0; *(f32x4*)(hp + 4) = o1;
                        if (HB) *(u32x4*)(HB + off) = pack8(o0, o1);
                        s += (o0[0] * o0[0] + o0[1] * o0[1]) + (o0[2] * o0[2] + o0[3] * o0[3]) + (o1[0] * o1[0] + o1[1] * o1[1]) + (o1[2] * o1[2] + o1[3] * o1[3]); }
                    if (ssq) { s += __shfl_xor(s, 16); s += __shfl_xor(s, 32); if (fq == 0) __hip_atomic_fetch_add(ssq + row, s, __ATOMIC_RELAXED, __HIP_MEMORY_SCOPE_AGENT); } } }
    }
};
struct EpiC {
    static constexpr bool PERM = true, AFTER_DRAIN = false;
    bf16_t* U0; size_t ustride; const float* ssq; float* vsum; float* vsq;
    __device__ __forceinline__ void operator()(const f32x4 (&acc)[2][2][4][2], const Unit& u, int wr, int wc, int fr_, int fq_) const {
        int fr = fr_, fq = fq_; asm volatile("" : "+v"(fr), "+v"(fq));
        const int seg = u.pn >> 3; bf16_t* base = U0 + (size_t)seg * ustride;
        const int row0 = u.pm * BM + wr * 64 + fr, col0 = (u.pn & 7) * BM + wc * 32 + 8 * fq;
        float rsv[2][4];
        PG8_FOR_AI_M rsv[ai][m] = __builtin_amdgcn_rsqf(ssq[row0 + ai * HALF + m * 16] * (1.f / 2048.f) + 1e-6f);
        PG8_FOR_AI_M { const int row = row0 + ai * HALF + m * 16; const float rs = rsv[ai][m]; float s1 = 0.f, s2 = 0.f; bf16_t* rp = base + (size_t)row * 2048 + col0;
#pragma unroll
            for (int bj = 0; bj < 2; ++bj) { f32x4 v0 = acc[ai][bj][m][0] * rs, v1 = acc[ai][bj][m][1] * rs;
                if (seg < 2) { f32x2 a = gelu_pk((f32x2){v0[0], v0[1]}), b = gelu_pk((f32x2){v0[2], v0[3]}), c = gelu_pk((f32x2){v1[0], v1[1]}), d = gelu_pk((f32x2){v1[2], v1[3]});
                    v0 = (f32x4){a.x, a.y, b.x, b.y}; v1 = (f32x4){c.x, c.y, d.x, d.y}; }
                else {
#pragma unroll
                    for (int i = 0; i < 4; ++i) { v0[i] = v0[i] * sigm(v0[i]); v1[i] = v1[i] * sigm(v1[i]); } }
                *(u32x4*)(rp + bj * HALF) = pack8(v0, v1);
                if (seg == 1) { s1 += (v0[0] + v0[1]) + (v0[2] + v0[3]) + (v1[0] + v1[1]) + (v1[2] + v1[3]);
                    s2 += (v0[0] * v0[0] + v0[1] * v0[1]) + (v0[2] * v0[2] + v0[3] * v0[3]) + (v1[0] * v1[0] + v1[1] * v1[1]) + (v1[2] * v1[2] + v1[3] * v1[3]); } }
            if (seg == 1) { s1 += __shfl_xor(s1, 16); s1 += __shfl_xor(s1, 32); s2 += __shfl_xor(s2, 16); s2 += __shfl_xor(s2, 32);
                if (fq == 0) { __hip_atomic_fetch_add(vsum + row, s1, __ATOMIC_RELAXED, __HIP_MEMORY_SCOPE_AGENT); __hip_atomic_fetch_add(vsq + row, s2, __ATOMIC_RELAXED, __HIP_MEMORY_SCOPE_AGENT); } } }
    }
};
template <class Epi, class Sched, bool ALIGN_EPI = false, bool SP2 = false>
__device__ __forceinline__ void gemm_phase(PG8_LAS unsigned char* lds, const Gemm g, const Sched& S, const Epi& E, const int tid_in) {
    const int tid = tid_in, wid = __builtin_amdgcn_readfirstlane(tid >> 6), lane = tid & 63, wr = wid >> 2, wc = wid & 3, fr = lane & 15, fq = lane >> 4;
    const int K = g.K, nt = K / BK;
    unsigned voffA[2], voffB[2];
#pragma unroll
    for (int i = 0; i < 2; ++i) { int R, C; stage_rc(tid * 16 + i * 8192, R, C); const int Rb = Epi::PERM ? ((R & ~31) + perm32(R & 31)) : R;
        voffA[i] = (unsigned)(R * K + C) * 2u; voffB[i] = (unsigned)(Rb * K + C) * 2u; }
    const size_t kstep = (size_t)(BK * 2);
    const size_t hstep = (size_t)HALF * K * 2;
    const size_t tstep = 2 * hstep;
    const unsigned ldsw = (unsigned)wid * 1024u;
    const int aoff = lds_byte(wr * 64 + fr, fq * 8), boff = lds_byte(wc * 32 + fr, fq * 8);
#define PG8_SA(b, h) (((b) * 2 + (h)) * HTB)
#define PG8_SB(b, h) ((4 + (b) * 2 + (h)) * HTB)
#define PG8_STAGE(bufoff, gbase, voff) do { _Pragma("unroll") for (int _i = 0; _i < 2; ++_i) \
        __builtin_amdgcn_global_load_lds((const unsigned*)((const char*)(gbase) + (voff)[_i]), (PG8_LAS unsigned*)(lds + (bufoff) + ldsw + _i * 8192), 16, 0, 0); } while (0)
#define PG8_LDA(dst, b, h) do { _Pragma("unroll") for (int m = 0; m < 4; ++m) _Pragma("unroll") for (int k = 0; k < 2; ++k) dst[m][k] = *(const PG8_LAS bf16x8*)(lds + PG8_SA(b, h) + aoff + m * 2048 + k * 1024); } while (0)
#define PG8_LDB(dst, b, h) do { _Pragma("unroll") for (int n = 0; n < 2; ++n) _Pragma("unroll") for (int k = 0; k < 2; ++k) dst[n][k] = *(const PG8_LAS bf16x8*)(lds + PG8_SB(b, h) + boff + n * 2048 + k * 1024); } while (0)
#define PG8_MMA(ai, bj, At, Bt) do { __builtin_amdgcn_s_setprio(1); _Pragma("unroll") for (int m = 0; m < 4; ++m) _Pragma("unroll") for (int n = 0; n < 2; ++n) _Pragma("unroll") for (int k = 0; k < 2; ++k) \
        acc[ai][bj][m][n] = __builtin_amdgcn_mfma_f32_16x16x32_bf16(Bt[n][k], At[m][k], acc[ai][bj][m][n], 0, 0, 0); __builtin_amdgcn_s_setprio(0); } while (0)
#define PG8_WAIT_V(n) asm volatile("s_waitcnt vmcnt(" #n ")" ::: "memory")
#define PG8_WAIT_L(n) asm volatile("s_waitcnt lgkmcnt(" #n ")" ::: "memory")
#define PG8_BAR __builtin_amdgcn_s_barrier()
#define PG8_SCHED __builtin_amdgcn_sched_barrier(0)
    Unit cur, nxt; int ui = 0;
    if (!S.next(0, cur)) return;
    f32x4 acc[2][2][4][2];
#pragma unroll
    for (int a = 0; a < 2; ++a)
#pragma unroll
        for (int b = 0; b < 2; ++b)
#pragma unroll
            for (int m = 0; m < 4; ++m)
#pragma unroll
                for (int n = 0; n < 2; ++n) acc[a][b][m][n] = (f32x4){0.f, 0.f, 0.f, 0.f};
    bf16x8 At[4][2], B0[2][2], B1[2][2];
    const char* cA = (const char*)g.A + (size_t)cur.pm * tstep; const char* cB = (const char*)g.Bt + (size_t)cur.pn * tstep;
    S.a_ready(cur);
    if constexpr (SP2) {
        PG8_STAGE(PG8_SB(0, 0), cB, voffB); PG8_STAGE(PG8_SB(0, 1), cB + hstep, voffB); PG8_STAGE(PG8_SA(0, 0), cA, voffA); PG8_STAGE(PG8_SA(0, 1), cA + hstep, voffA);
        if (wr == 1) PG8_BAR;
        PG8_WAIT_V(2); PG8_BAR;
        PG8_STAGE(PG8_SB(1, 0), cB + kstep, voffB); PG8_STAGE(PG8_SA(1, 0), cA + kstep, voffA); PG8_STAGE(PG8_SB(1, 1), cB + hstep + kstep, voffB);
        PG8_WAIT_V(6); PG8_BAR;
    } else {
        PG8_STAGE(PG8_SB(0, 0), cB, voffB); PG8_STAGE(PG8_SA(0, 0), cA, voffA); PG8_STAGE(PG8_SB(0, 1), cB + hstep, voffB); PG8_STAGE(PG8_SA(0, 1), cA + hstep, voffA);
        if (wr == 1) PG8_BAR;
        PG8_WAIT_V(4); PG8_BAR;
        PG8_STAGE(PG8_SB(1, 0), cB + kstep, voffB); PG8_STAGE(PG8_SA(1, 0), cA + kstep, voffA); PG8_STAGE(PG8_SB(1, 1), cB + hstep + kstep, voffB);
        PG8_WAIT_V(6); PG8_BAR;
    }
    for (;;) {
        const bool has_next = S.next(ui + 1, nxt);
        const char* nA = has_next ? (const char*)g.A + (size_t)nxt.pm * tstep : cA; const char* nB = has_next ? (const char*)g.Bt + (size_t)nxt.pn * tstep : cB;
        for (int t = 0; t < nt; t += 2) {
            const bool last = (t == nt - 2);
            const char* a1 = cA + (size_t)(t + 1) * kstep;
            const char* a2 = last ? nA : cA + (size_t)(t + 2) * kstep; const char* b2 = last ? nB : cB + (size_t)(t + 2) * kstep;
            const char* a3 = a2 + kstep; const char* b3 = b2 + kstep;
            if (last && has_next) S.a_ready(nxt);
            if constexpr (SP2) {
            PG8_LDB(B0, 0, 0); PG8_LDB(B1, 0, 1); PG8_SCHED; PG8_LDA(At, 0, 0); PG8_STAGE(PG8_SA(1, 1), a1 + hstep, voffA);
            PG8_WAIT_V(8); PG8_WAIT_L(0); PG8_BAR; PG8_MMA(0, 0, At, B0); PG8_MMA(0, 1, At, B1); PG8_BAR; PG8_SCHED;
            PG8_LDA(At, 0, 1); PG8_STAGE(PG8_SB(0, 0), b2, voffB); PG8_STAGE(PG8_SB(0, 1), b2 + hstep, voffB); PG8_STAGE(PG8_SA(0, 0), a2, voffA);
            PG8_WAIT_V(8); PG8_WAIT_L(0); PG8_BAR; PG8_MMA(1, 0, At, B0); PG8_MMA(1, 1, At, B1); PG8_BAR; PG8_SCHED;
            PG8_LDB(B0, 1, 0); PG8_LDB(B1, 1, 1); PG8_SCHED; PG8_LDA(At, 1, 0); PG8_STAGE(PG8_SA(0, 1), a2 + hstep, voffA);
            PG8_WAIT_V(8); PG8_WAIT_L(0); PG8_BAR; PG8_MMA(0, 0, At, B0); PG8_MMA(0, 1, At, B1); PG8_BAR; PG8_SCHED;
            PG8_LDA(At, 1, 1); PG8_STAGE(PG8_SB(1, 0), b3, voffB); PG8_STAGE(PG8_SB(1, 1), b3 + hstep, voffB); PG8_STAGE(PG8_SA(1, 0), a3, voffA);
            PG8_WAIT_V(8); PG8_WAIT_L(0); PG8_BAR; PG8_MMA(1, 0, At, B0); PG8_MMA(1, 1, At, B1); PG8_BAR; PG8_SCHED;
            } else {
            PG8_LDB(B0, 0, 0); PG8_SCHED; PG8_LDA(At, 0, 0); PG8_STAGE(PG8_SA(1, 1), a1 + hstep, voffA);
            PG8_WAIT_L(8); PG8_BAR; PG8_WAIT_L(0); PG8_MMA(0, 0, At, B0); PG8_BAR; PG8_SCHED;
            PG8_LDB(B1, 0, 1); PG8_STAGE(PG8_SB(0, 0), b2, voffB);
            PG8_BAR; PG8_WAIT_L(0); PG8_MMA(0, 1, At, B1); PG8_BAR;
            PG8_LDA(At, 0, 1); PG8_STAGE(PG8_SA(0, 0), a2, voffA);
            PG8_BAR; PG8_WAIT_L(0); PG8_MMA(1, 0, At, B0); PG8_BAR; PG8_SCHED;
            PG8_STAGE(PG8_SB(0, 1), b2 + hstep, voffB);
            PG8_WAIT_V(6); PG8_BAR; PG8_MMA(1, 1, At, B1); PG8_BAR;
            PG8_LDB(B0, 1, 0); PG8_SCHED; PG8_LDA(At, 1, 0); PG8_STAGE(PG8_SA(0, 1), a2 + hstep, voffA);
            PG8_WAIT_L(8); PG8_BAR; PG8_WAIT_L(0); PG8_MMA(0, 0, At, B0); PG8_BAR; PG8_SCHED;
            PG8_LDB(B1, 1, 1); PG8_STAGE(PG8_SB(1, 0), b3, voffB);
            PG8_BAR; PG8_WAIT_L(0); PG8_MMA(0, 1, At, B1); PG8_BAR;
            PG8_LDA(At, 1, 1); PG8_STAGE(PG8_SA(1, 0), a3, voffA);
            PG8_BAR; PG8_WAIT_L(0); PG8_MMA(1, 0, At, B0); PG8_BAR; PG8_SCHED;
            PG8_STAGE(PG8_SB(1, 1), b3 + hstep, voffB);
            PG8_WAIT_V(6); PG8_BAR; PG8_MMA(1, 1, At, B1); PG8_BAR;
            }
        }
        if constexpr (ALIGN_EPI) { if (wr == 0) PG8_BAR; }
        if constexpr (!Epi::AFTER_DRAIN) { E(acc, cur, wr, wc, fr, fq); S.done(cur); }
        if (!has_next) break;
#pragma unroll
        for (int a = 0; a < 2; ++a)
#pragma unroll
            for (int b = 0; b < 2; ++b)
#pragma unroll
                for (int m = 0; m < 4; ++m)
#pragma unroll
                    for (int n = 0; n < 2; ++n) acc[a][b][m][n] = (f32x4){0.f, 0.f, 0.f, 0.f};
        cur = nxt; cA = nA; cB = nB; ++ui;
        if constexpr (ALIGN_EPI) { if (wr == 1) PG8_BAR; }
    }
    PG8_WAIT_V(0);
    if constexpr (!ALIGN_EPI) { if (wr == 0) PG8_BAR; }
    PG8_BAR;
    if constexpr (Epi::AFTER_DRAIN) { E.fused(acc, cur, wr, wc, fr, fq, lds, wid, lane); S.done(cur); }
#undef PG8_SA
#undef PG8_SB
#undef PG8_STAGE
#undef PG8_LDA
#undef PG8_LDB
#undef PG8_MMA
#undef PG8_WAIT_V
#undef PG8_WAIT_L
#undef PG8_BAR
#undef PG8_SCHED
}
}
constexpr int NB = 16, T = 2048, D = 2048, M = NB * T;
constexpr int N_IN0 = 8448;
constexpr size_t MiB = 1u << 20;
constexpr size_t WS_CTL = 0;
constexpr size_t WS_WIN0 = 2 * MiB, WS_WOUT0 = 35 * MiB, WS_WIN1 = 43 * MiB, WS_WOUT1 = 67 * MiB, WS_WG0 = 75 * MiB, WS_WG1 = 83 * MiB, WS_WP0 = 91 * MiB, WS_WP1 = 92 * MiB;
constexpr size_t WS_HBA = 96 * MiB, WS_PB = 224 * MiB, WS_G = 256 * MiB, WS_SMALL = 768 * MiB, WS_Z = 800 * MiB, WS_END = 928 * MiB;
constexpr int LDS_BYTES = 147456;
constexpr int NWAVES = 8;
typedef unsigned short bf16;
typedef short bf16x8 __attribute__((ext_vector_type(8)));
typedef float f32x4 __attribute__((ext_vector_type(4)));
typedef float f32x16 __attribute__((ext_vector_type(16)));
typedef unsigned u32x4 __attribute__((ext_vector_type(4)));
typedef unsigned u32x2 __attribute__((ext_vector_type(2)));
#define LAS __attribute__((address_space(3)))
#define LDS_WAIT() asm volatile("s_waitcnt lgkmcnt(0)" ::: "memory")
using pg8::cvt_pk_bf16; using pg8::bflo; using pg8::bfhi; using pg8::sigm;
constexpr float LOG2E = 1.4426950408889634f;

__device__ __forceinline__ int my_tid(int wave_s) { return wave_s * 64 + (int)__builtin_amdgcn_mbcnt_hi(~0u, __builtin_amdgcn_mbcnt_lo(~0u, 0u)); }
__device__ __forceinline__ float wave_sum(float v) {
#pragma unroll
    for (int o = 1; o < 64; o <<= 1) v += __shfl_xor(v, o);
    return v;
}
__device__ __forceinline__ float red16(float v) { v += __shfl_xor(v, 1); v += __shfl_xor(v, 2); v += __shfl_xor(v, 4); v += __shfl_xor(v, 8); return v; }

__device__ __forceinline__ void transpose_item(const float* W, int K, int Nsrc, int src_col0, int nvalid, const float* gk, bf16* WT, int dst_row0, float* scr, int kb, int lane) {
    const int k0 = 64 * kb, c = lane & 31;
#pragma unroll 8
    for (int i = 0; i < 32; ++i) { const int kk = 2 * i + (lane >> 5); float v = (c < nvalid) ? W[(size_t)(k0 + kk) * Nsrc + src_col0 + c] : 0.f; if (gk) v *= gk[k0 + kk]; scr[kk * 33 + c] = v; }
    LDS_WAIT();
    const int c8 = lane & 7;
#pragma unroll
    for (int j = 0; j < 4; ++j) { const int n = (lane >> 3) + 8 * j; const float* s = scr + (8 * c8) * 33 + n;
        u32x4 o; o.x = cvt_pk_bf16(s[0 * 33], s[1 * 33]); o.y = cvt_pk_bf16(s[2 * 33], s[3 * 33]); o.z = cvt_pk_bf16(s[4 * 33], s[5 * 33]); o.w = cvt_pk_bf16(s[6 * 33], s[7 * 33]);
        *(u32x4*)(WT + (size_t)(dst_row0 + n) * K + k0 + 8 * c8) = o; }
    LDS_WAIT();
}

struct Ptrs {
    const float *x, *p, *norm_pre, *norm_post, *ab_w_in, *fox_f_bias, *rwkv_mu, *rwkv_w0, *rwkv_w2, *rwkv_a0, *rwkv_a2, *rwkv_k_k, *rwkv_k_a, *rwkv_r_k, *rwkv_ln_g, *rwkv_ln_b,
        *ab_w_out, *c_w_in, *c_ln_g, *c_ln_b, *c_w_s, *c_b_s, *c_w_out, *ple_w_proj, *ple_w_gate;
    float* out; unsigned char* ws; int ph_lo, ph_hi;
};

__device__ __forceinline__ void p0_prologue(const Ptrs& P, unsigned char* lds, const int wave_s) {
    int tid_ = my_tid(wave_s); asm volatile("" : "+v"(tid_)); const int tid = tid_, lane = tid & 63, wave = tid >> 6;
    float* scr = (float*)(lds + wave * 16384);
    const int gw = blockIdx.x * NWAVES + wave, NGW = gridDim.x * NWAVES;
    unsigned char* ws = P.ws;
    if (blockIdx.x < 200) {
        const int c0 = blockIdx.x * 16, q = wave, cq = lane & 3, bb = lane >> 2;
        const float* xr = P.x + (size_t)bb * T * D + q * 256; const float* gq = P.norm_pre + q * 256; const float* Wq = P.ab_w_in + (size_t)(q * 256) * 8336 + 4112 + c0 + 4 * cq;
        f32x4 a0 = {0.f, 0.f, 0.f, 0.f}, a1 = a0, a2 = a0, a3 = a0;
#pragma unroll 2
        for (int k4 = 0; k4 < 64; ++k4) { const f32x4 gv = *(const f32x4*)(gq + 4 * k4);
            const f32x4 x0 = *(const f32x4*)(xr + 4 * k4) * gv, x1 = *(const f32x4*)(xr + D + 4 * k4) * gv, x2 = *(const f32x4*)(xr + 2 * D + 4 * k4) * gv, x3 = *(const f32x4*)(xr + 3 * D + 4 * k4) * gv;
#pragma unroll
            for (int e = 0; e < 4; ++e) { const f32x4 wv_ = *(const f32x4*)(Wq + (size_t)(4 * k4 + e) * 8336);
                a0 += x0[e] * wv_; a1 += x1[e] * wv_; a2 += x2[e] * wv_; a3 += x3[e] * wv_; } }
        { float* part = (float*)lds + (q * 64 + bb * 4) * 16 + 4 * cq;
          *(f32x4*)part = a0; *(f32x4*)(part + 16) = a1; *(f32x4*)(part + 32) = a2; *(f32x4*)(part + 48) = a3; }
        __syncthreads();
        float* EXG = (float*)(ws + WS_CTL + 0x100000);
#pragma unroll
        for (int o = tid * 2; o < tid * 2 + 2; ++o) { const int r2 = o >> 4, cc = o & 15; float v = 0.f;
#pragma unroll
            for (int w = 0; w < 8; ++w) v += ((const float*)lds)[(w * 64 + r2) * 16 + cc];
            EXG[(size_t)r2 * 3200 + c0 + cc] = v; }
        __syncthreads();
    }
    { float* z = (float*)(ws + WS_CTL) + M; for (int i = blockIdx.x * 512 + tid; i < 5 * M; i += gridDim.x * 512) z[i] = 0.f; }
    constexpr int I_IN0 = 32 * (N_IN0 / 32), I_SQ = 32 * 64, I_IN1 = 32 * 192, I_PJ = 4 * 64;
    constexpr int NITEMS = I_IN0 + I_SQ + I_IN1 + I_SQ + 2 * I_SQ + 2 * I_PJ;
    for (int it = gw; it < NITEMS; it += NGW) {
        int r = it;
        if (r < I_IN0) { const int nblk = N_IN0 / 32, kb = r / nblk, db = r % nblk; int src, nv = 32;
            if (db < 256) { const int grp = db >> 5; src = grp * 1024 + (grp >= 3 ? 16 : 0) + (grp == 7 ? 128 : 0) + (db & 31) * 32; }
            else if (db < 258) src = 7184 + (db - 256) * 32; else if (db < 260) src = 7248 + (db - 258) * 32; else if (db == 260) { src = 3072; nv = 16; } else { src = 0; nv = 0; }
            transpose_item(P.ab_w_in, 2048, 8336, src, nv, P.norm_pre, (bf16*)(ws + WS_WIN0), db * 32, scr, kb, lane); continue; } r -= I_IN0;
        if (r < I_SQ) { transpose_item(P.ab_w_out, 2048, 2048, (r % 64) * 32, 32, nullptr, (bf16*)(ws + WS_WOUT0), (r % 64) * 32, scr, r / 64, lane); continue; } r -= I_SQ;
        if (r < I_IN1) { transpose_item(P.c_w_in, 2048, 6144, (r % 192) * 32, 32, P.norm_pre + 2048, (bf16*)(ws + WS_WIN1), (r % 192) * 32, scr, r / 192, lane); continue; } r -= I_IN1;
        if (r < I_SQ) { transpose_item(P.c_w_out, 2048, 2048, (r % 64) * 32, 32, nullptr, (bf16*)(ws + WS_WOUT1), (r % 64) * 32, scr, r / 64, lane); continue; } r -= I_SQ;
        if (r < I_SQ) { transpose_item(P.ple_w_gate, 2048, 2048, (r % 64) * 32, 32, nullptr, (bf16*)(ws + WS_WG0), (r % 64) * 32, scr, r / 64, lane); continue; } r -= I_SQ;
        if (r < I_SQ) { transpose_item(P.ple_w_gate + (size_t)2048 * 2048, 2048, 2048, (r % 64) * 32, 32, nullptr, (bf16*)(ws + WS_WG1), (r % 64) * 32, scr, r / 64, lane); continue; } r -= I_SQ;
        if (r < I_PJ) { transpose_item(P.ple_w_proj, 256, 2048, (r % 64) * 32, 32, nullptr, (bf16*)(ws + WS_WP0), (r % 64) * 32, scr, r / 64, lane); continue; } r -= I_PJ;
        transpose_item(P.ple_w_proj + (size_t)256 * 2048, 256, 2048, (r % 64) * 32, 32, nullptr, (bf16*)(ws + WS_WP1), (r % 64) * 32, scr, r / 64, lane);
    }
    { float* ssq0 = (float*)(ws + WS_CTL); bf16* hb = (bf16*)(ws + WS_HBA);
      for (int row = gw; row < M; row += NGW) { const f32x4* xr = (const f32x4*)(P.x + (size_t)row * D) + lane; f32x4 v[8]; float s = 0.f;
#pragma unroll
          for (int j = 0; j < 8; ++j) { v[j] = xr[64 * j]; s += (v[j][0] * v[j][0] + v[j][1] * v[j][1]) + (v[j][2] * v[j][2] + v[j][3] * v[j][3]); }
          s = wave_sum(s); if (lane == 0) ssq0[row] = s;
          u32x2* o = (u32x2*)(hb + (size_t)row * D) + lane;
#pragma unroll
          for (int j = 0; j < 8; ++j) { u32x2 w; w.x = cvt_pk_bf16(v[j][0], v[j][1]); w.y = cvt_pk_bf16(v[j][2], v[j][3]); o[64 * j] = w; } } }
}

__device__ __forceinline__ void post_norm_phase(const float* hin, const bf16* Y, const float* ssq, const float* g, float* hout, bf16* hb, const int wave_s) {
    int tid_ = my_tid(wave_s); asm volatile("" : "+v"(tid_)); const int tid = tid_, lane = tid & 63, wave = tid >> 6;
    const int gw = blockIdx.x * NWAVES + wave, NGW = gridDim.x * NWAVES;
    f32x4 gv[8];
#pragma unroll
    for (int j = 0; j < 8; ++j) gv[j] = *((const f32x4*)g + lane + 64 * j);
    for (int row = gw; row < M; row += NGW) {
        const float rs = __builtin_amdgcn_rsqf(ssq[row] * (1.f / 2048.f) + 1e-6f);
        const f32x4* hr = (const f32x4*)(hin + (size_t)row * D) + lane; const u32x2* yr = (const u32x2*)(Y + (size_t)row * D) + lane;
        f32x4* orow = (f32x4*)(hout + (size_t)row * D) + lane; u32x2* ob = (u32x2*)(hb + (size_t)row * D) + lane;
#pragma unroll
        for (int j = 0; j < 8; ++j) { const f32x4 h = hr[64 * j]; const u32x2 y = yr[64 * j]; f32x4 o;
            o[0] = h[0] + bflo(y.x) * rs * gv[j][0]; o[1] = h[1] + bfhi(y.x) * rs * gv[j][1]; o[2] = h[2] + bflo(y.y) * rs * gv[j][2]; o[3] = h[3] + bfhi(y.y) * rs * gv[j][3];
            orow[64 * j] = o; u32x2 w; w.x = cvt_pk_bf16(o[0], o[1]); w.y = cvt_pk_bf16(o[2], o[3]); ob[64 * j] = w; }
    }
}

__device__ __forceinline__ int crow(int r, int hi) { return (r & 3) + 8 * (r >> 2) + 4 * hi; }
__device__ __forceinline__ void attn_phase(unsigned char* lds, const bf16* Qg, const bf16* Kg, const bf16* Vg, const bf16* GAg, const float* small, const float* fbias, bf16* Z, const int wave_s) {
    int tid_ = my_tid(wave_s); asm volatile("" : "+v"(tid_)); const int tid = tid_, lane = tid & 63, wid = __builtin_amdgcn_readfirstlane(tid >> 6), r32 = lane & 31, hi = lane >> 5;
    float* c2 = (float*)lds;
    float* wtot = (float*)(lds + 8192);
    bf16* Ks = (bf16*)(lds + 8192 + 64);
    bf16* Vt = Ks + 64 * 72;
    for (int bh = blockIdx.x; bh < 256; bh += gridDim.x) {
        const int b = bh >> 4, h = bh & 15; const size_t rowbase = (size_t)b * T;
        __syncthreads();
        { float lf[4]; const float fb = fbias[h]; float run = 0.f;
#pragma unroll
          for (int i = 0; i < 4; ++i) { const float xg = small[(rowbase + 4 * tid + i) * 256 + 128 + h] + fb; const float ls = fminf(xg, 0.f) - log1pf(__expf(-fabsf(xg))); run += ls; lf[i] = run; }
          float sc = run;
#pragma unroll
          for (int o = 1; o < 64; o <<= 1) { const float t = __shfl_up(sc, o); if (lane >= o) sc += t; }
          if (lane == 63) wtot[wid] = sc;
          __syncthreads();
          float off = sc - run;
#pragma unroll
          for (int w = 0; w < 8; ++w) if (w < wid) off += wtot[w];
#pragma unroll
          for (int i = 0; i < 4; ++i) c2[4 * tid + i] = (off + lf[i]) * LOG2E; }
        __syncthreads();
        for (int qb = 0; qb < 8; ++qb) {
            const int q0w = qb * 256 + wid * 32, q = q0w + r32;
            bf16x8 qr[4];
#pragma unroll
            for (int d0 = 0; d0 < 4; ++d0) qr[d0] = *(const bf16x8*)(Qg + (rowbase + q) * 1024 + h * 64 + d0 * 16 + hi * 8);
            const float cq = c2[q];
            f32x16 o0, o1;
#pragma unroll
            for (int r = 0; r < 16; ++r) { o0[r] = 0.f; o1[r] = 0.f; }
            float mrow = -1e30f, l = 0.f;
            const int NT = qb * 4 + 4;
            const int kr = tid >> 3, ch = tid & 7, vr = lane, vc = wid;
            const bf16* kgp = Kg + (rowbase + kr) * 1024 + h * 64 + ch * 8; const bf16* vgp = Vg + (rowbase + vr) * 1024 + h * 64 + vc * 8;
            u32x4 kreg = *(const u32x4*)kgp, vreg = *(const u32x4*)vgp;
            for (int t = 0; t < NT; ++t) {
                asm volatile("s_waitcnt lgkmcnt(0)\n\ts_barrier" ::: "memory");
                { *(u32x4*)(Ks + kr * 72 + ch * 8) = kreg; bf16* vt = Vt + (vc * 8) * 72 + vr;
                  vt[0 * 72] = (bf16)(vreg.x & 0xffffu); vt[1 * 72] = (bf16)(vreg.x >> 16); vt[2 * 72] = (bf16)(vreg.y & 0xffffu); vt[3 * 72] = (bf16)(vreg.y >> 16);
                  vt[4 * 72] = (bf16)(vreg.z & 0xffffu); vt[5 * 72] = (bf16)(vreg.z >> 16); vt[6 * 72] = (bf16)(vreg.w & 0xffffu); vt[7 * 72] = (bf16)(vreg.w >> 16);
                  if (t + 1 < NT) { kreg = *(const u32x4*)(kgp + (size_t)(t + 1) * 64 * 1024); vreg = *(const u32x4*)(vgp + (size_t)(t + 1) * 64 * 1024); } }
                asm volatile("s_waitcnt lgkmcnt(0)\n\ts_barrier" ::: "memory");
                if (t * 64 <= q0w + 31) {
                    f32x16 p0, p1;
#pragma unroll
                    for (int r = 0; r < 16; ++r) { p0[r] = 0.f; p1[r] = 0.f; }
#pragma unroll
                    for (int d0 = 0; d0 < 4; ++d0) { const bf16x8 k0 = *(const bf16x8*)(Ks + r32 * 72 + d0 * 16 + hi * 8), k1 = *(const bf16x8*)(Ks + (32 + r32) * 72 + d0 * 16 + hi * 8);
                        p0 = __builtin_amdgcn_mfma_f32_32x32x16_bf16(k0, qr[d0], p0, 0, 0, 0); p1 = __builtin_amdgcn_mfma_f32_32x32x16_bf16(k1, qr[d0], p1, 0, 0, 0); }
                    const int kvb = t * 64 + 4 * hi;
#pragma unroll
                    for (int g4 = 0; g4 < 4; ++g4) { const f32x4 ca = *(const f32x4*)(c2 + kvb + 8 * g4), cb = *(const f32x4*)(c2 + kvb + 32 + 8 * g4);
#pragma unroll
                        for (int i = 0; i < 4; ++i) { p0[4 * g4 + i] += cq - ca[i]; p1[4 * g4 + i] += cq - cb[i]; } }
                    if (t * 64 + 63 > q0w) {
#pragma unroll
                        for (int r = 0; r < 16; ++r) { const int kv = kvb + (r & 3) + 8 * (r >> 2); if (kv > q) p0[r] = -1e30f; if (kv + 32 > q) p1[r] = -1e30f; } }
                    float mx = fmaxf(p0[0], p1[0]);
#pragma unroll
                    for (int r = 1; r < 16; ++r) mx = fmaxf(mx, fmaxf(p0[r], p1[r]));
                    mx = fmaxf(mx, __shfl_xor(mx, 32));
                    const float mnew = fmaxf(mrow, mx), alpha = __builtin_amdgcn_exp2f(mrow - mnew); mrow = mnew;
                    l *= alpha; float ls = 0.f;
#pragma unroll
                    for (int r = 0; r < 16; ++r) { o0[r] *= alpha; o1[r] *= alpha; p0[r] = __builtin_amdgcn_exp2f(p0[r] - mnew); p1[r] = __builtin_amdgcn_exp2f(p1[r] - mnew); ls += p0[r] + p1[r]; }
                    l += ls;
                    u32x4 pw[4];
#pragma unroll
                    for (int s = 0; s < 2; ++s) { pw[s].x = cvt_pk_bf16(p0[8 * s + 0], p0[8 * s + 1]); pw[s].y = cvt_pk_bf16(p0[8 * s + 2], p0[8 * s + 3]); pw[s].z = cvt_pk_bf16(p0[8 * s + 4], p0[8 * s + 5]); pw[s].w = cvt_pk_bf16(p0[8 * s + 6], p0[8 * s + 7]);
                        pw[2 + s].x = cvt_pk_bf16(p1[8 * s + 0], p1[8 * s + 1]); pw[2 + s].y = cvt_pk_bf16(p1[8 * s + 2], p1[8 * s + 3]); pw[2 + s].z = cvt_pk_bf16(p1[8 * s + 4], p1[8 * s + 5]); pw[2 + s].w = cvt_pk_bf16(p1[8 * s + 6], p1[8 * s + 7]); }
#pragma unroll
                    for (int s = 0; s < 4; ++s) { const bf16x8 pf = __builtin_bit_cast(bf16x8, pw[s]);
                        { const bf16* vp = Vt + r32 * 72 + 16 * s + 4 * hi; const u32x2 lo = *(const u32x2*)vp, hi2 = *(const u32x2*)(vp + 8); u32x4 va; va.x = lo.x; va.y = lo.y; va.z = hi2.x; va.w = hi2.y;
                          o0 = __builtin_amdgcn_mfma_f32_32x32x16_bf16(__builtin_bit_cast(bf16x8, va), pf, o0, 0, 0, 0); }
                        { const bf16* vp = Vt + (32 + r32) * 72 + 16 * s + 4 * hi; const u32x2 lo = *(const u32x2*)vp, hi2 = *(const u32x2*)(vp + 8); u32x4 va; va.x = lo.x; va.y = lo.y; va.z = hi2.x; va.w = hi2.y;
                          o1 = __builtin_amdgcn_mfma_f32_32x32x16_bf16(__builtin_bit_cast(bf16x8, va), pf, o1, 0, 0, 0); } }
                }
            }
            l += __shfl_xor(l, 32); const float inv = 1.f / l;
#pragma unroll
            for (int g4 = 0; g4 < 4; ++g4) {
                { const int d = 8 * g4 + 4 * hi; const u32x2 gg = *(const u32x2*)(GAg + (rowbase + q) * 1024 + h * 64 + d);
                  const float g0 = bflo(gg.x), g1 = bfhi(gg.x), g2 = bflo(gg.y), g3 = bfhi(gg.y); u32x2 w;
                  w.x = cvt_pk_bf16(o0[4 * g4 + 0] * inv * g0 * sigm(g0), o0[4 * g4 + 1] * inv * g1 * sigm(g1)); w.y = cvt_pk_bf16(o0[4 * g4 + 2] * inv * g2 * sigm(g2), o0[4 * g4 + 3] * inv * g3 * sigm(g3));
                  *(u32x2*)(Z + (rowbase + q) * 2048 + h * 64 + d) = w; }
                { const int d = 32 + 8 * g4 + 4 * hi; const u32x2 gg = *(const u32x2*)(GAg + (rowbase + q) * 1024 + h * 64 + d);
                  const float g0 = bflo(gg.x), g1 = bfhi(gg.x), g2 = bflo(gg.y), g3 = bfhi(gg.y); u32x2 w;
                  w.x = cvt_pk_bf16(o1[4 * g4 + 0] * inv * g0 * sigm(g0), o1[4 * g4 + 1] * inv * g1 * sigm(g1)); w.y = cvt_pk_bf16(o1[4 * g4 + 2] * inv * g2 * sigm(g2), o1[4 * g4 + 3] * inv * g3 * sigm(g3));
                  *(u32x2*)(Z + (rowbase + q) * 2048 + h * 64 + d) = w; }
            }
        }
    }
}
__device__ __forceinline__ float exp_fast(float x) { return __builtin_amdgcn_exp2f(1.4426950408889634f * x); }
__device__ __forceinline__ float softplusf_(float z) { return fmaxf(z, 0.f) + 0.6931471805599453f * __builtin_amdgcn_logf(1.0f + exp_fast(-fabsf(z))); }
__device__ __forceinline__ float tanh_fast(float x) { return 1.0f - 2.0f * __builtin_amdgcn_rcpf(1.0f + __builtin_amdgcn_exp2f(2.885390081777927f * x)); }
__device__ __forceinline__ void rwkv_phase(unsigned char* lds, const Ptrs& P, const bf16* Rg, const bf16* Kg, const bf16* Vg, const bf16* GBg, const float* small, bf16* Z, const int wave_s) {
    int tid_ = my_tid(wave_s); asm volatile("" : "+v"(tid_)); const int tid = tid_, lane = tid & 63, wv = __builtin_amdgcn_readfirstlane(tid >> 6);
#define RW_BAR() asm volatile("s_waitcnt lgkmcnt(0)\n\ts_barrier" ::: "memory")
    bf16* W2t = (bf16*)lds;
    bf16* A2t = W2t + 64 * 72;
    float* DL = (float*)lds + 4608;
    float* TW = DL + 4096;
    float* AL = TW + 2176;
    float* Rr = AL + 2176;
    float* Vv = Rr + 10240;
    float* Yb = Vv + 2048;
    float* red = Yb + 2048;
    float* Uu = red + 2048;
    float* CC = Uu + 1024;
    float* Cc = CC + 64;
    const int tt = tid >> 4, c4 = (tid & 15) * 4;
    for (int bh = blockIdx.x; bh < 256; bh += gridDim.x) {
        const int b = bh >> 4, h = bh & 15, hc = h * 64 + c4; const size_t rowbase = (size_t)b * T;
        __syncthreads();
        for (int i = tid; i < 4096; i += 512) { const int k = i >> 6, c = i & 63; W2t[c * 72 + k] = (bf16)(cvt_pk_bf16(P.rwkv_w2[(size_t)k * 1024 + h * 64 + c], 0.f) & 0xffffu); A2t[c * 72 + k] = (bf16)(cvt_pk_bf16(P.rwkv_a2[(size_t)k * 1024 + h * 64 + c], 0.f) & 0xffffu); }
        if (tid < 16) { const int cc = tid * 4, hcc = h * 64 + cc;
            *(f32x4*)(Cc + 0 * 64 + cc) = *(const f32x4*)(P.rwkv_mu + hcc); *(f32x4*)(Cc + 1 * 64 + cc) = *(const f32x4*)(P.rwkv_mu + 1024 + hcc); *(f32x4*)(Cc + 2 * 64 + cc) = *(const f32x4*)(P.rwkv_mu + 2048 + hcc);
            *(f32x4*)(Cc + 3 * 64 + cc) = *(const f32x4*)(P.rwkv_mu + 3072 + cc); *(f32x4*)(Cc + 4 * 64 + cc) = *(const f32x4*)(P.rwkv_mu + 3136 + cc);
            *(f32x4*)(Cc + 5 * 64 + cc) = *(const f32x4*)(P.rwkv_w0 + hcc); *(f32x4*)(Cc + 6 * 64 + cc) = *(const f32x4*)(P.rwkv_a0 + hcc); *(f32x4*)(Cc + 7 * 64 + cc) = *(const f32x4*)(P.rwkv_k_k + hcc);
            *(f32x4*)(Cc + 8 * 64 + cc) = *(const f32x4*)(P.rwkv_k_a + hcc); *(f32x4*)(Cc + 9 * 64 + cc) = *(const f32x4*)(P.rwkv_r_k + hcc); *(f32x4*)(Cc + 10 * 64 + cc) = *(const f32x4*)(P.rwkv_ln_g + hcc);
            *(f32x4*)(Cc + 11 * 64 + cc) = *(const f32x4*)(P.rwkv_ln_b + hcc); }
#define CV(k) (*(const f32x4*)(Cc + (k) * 64 + c4))
        f32x4 Sv[4];
#pragma unroll
        for (int g = 0; g < 4; ++g) Sv[g] = (f32x4){0.f, 0.f, 0.f, 0.f};
        { float* const EX = red; const float* exg = (const float*)(P.ws + WS_CTL + 0x100000) + (size_t)(b * 4) * 3200;
          for (int i = tid; i < 1280; i += 512) { const int q = i / 320, cc = i - q * 320; const int col = (cc < 192) ? ((cc >> 6) * 1024 + h * 64 + (cc & 63)) : (3072 + (cc - 192));
              EX[i] = exg[q * 3200 + col] * __builtin_amdgcn_rsqf(((const float*)(P.ws + WS_CTL))[rowbase + q] * (1.f / 2048.f) + 1e-6f); }
          __syncthreads(); }
        u32x2 n_rc, n_kc, n_vc, n_gg, n_rp = {0u, 0u}, n_kp = {0u, 0u}, n_vp = {0u, 0u}; f32x4 n_wl, n_al, n_wlp = {0.f, 0.f, 0.f, 0.f}, n_alp = {0.f, 0.f, 0.f, 0.f};
#define RW_FETCH(ckk) do { const size_t row_ = rowbase + (ckk) * 32 + tt; \
            n_rc = *(const u32x2*)(Rg + row_ * 1024 + hc); n_kc = *(const u32x2*)(Kg + row_ * 1024 + hc); n_vc = *(const u32x2*)(Vg + row_ * 1024 + hc); \
            n_wl = *(const f32x4*)(small + row_ * 256 + c4); n_al = *(const f32x4*)(small + row_ * 256 + 64 + c4); } while (0)
        RW_FETCH(0); n_gg = *(const u32x2*)(GBg + (rowbase + tt) * 1024 + hc);
#define RW_FETCH_PREV(rowp) do { n_rp = *(const u32x2*)(Rg + (rowp) * 1024 + hc); n_kp = *(const u32x2*)(Kg + (rowp) * 1024 + hc); n_vp = *(const u32x2*)(Vg + (rowp) * 1024 + hc); \
            n_wlp = *(const f32x4*)(small + (rowp) * 256 + c4); n_alp = *(const f32x4*)(small + (rowp) * 256 + 64 + c4); } while (0)
        if (tt > 0) RW_FETCH_PREV(rowbase + tt - 1);
        for (int ck = 0; ck < T / 32; ++ck) {
            const int t = ck * 32 + tt; const size_t row = rowbase + t;
            f32x4 rs, ks, vs;
            { const f32x4 mu_r = CV(0), mu_k = CV(1), mu_v = CV(2), mu_w = CV(3), mu_a = CV(4);
              const u32x2 rc = n_rc, kc = n_kc, vc = n_vc, rp = n_rp, kp = n_kp, vp = n_vp; f32x4 wl = n_wl, al = n_al, wlp = n_wlp, alp = n_alp;
              f32x4 rcf = {bflo(rc.x), bfhi(rc.x), bflo(rc.y), bfhi(rc.y)}, rpf = {bflo(rp.x), bfhi(rp.x), bflo(rp.y), bfhi(rp.y)};
              f32x4 kcf = {bflo(kc.x), bfhi(kc.x), bflo(kc.y), bfhi(kc.y)}, kpf = {bflo(kp.x), bfhi(kp.x), bflo(kp.y), bfhi(kp.y)};
              f32x4 vcf = {bflo(vc.x), bfhi(vc.x), bflo(vc.y), bfhi(vc.y)}, vpf = {bflo(vp.x), bfhi(vp.x), bflo(vp.y), bfhi(vp.y)};
              if (t < 4) { const float* ex = red + t * 320; rcf = *(const f32x4*)(ex + c4); kcf = *(const f32x4*)(ex + 64 + c4); vcf = *(const f32x4*)(ex + 128 + c4); wl = *(const f32x4*)(ex + 192 + c4); al = *(const f32x4*)(ex + 256 + c4);
                  if (t > 0) { const float* ep = ex - 320; rpf = *(const f32x4*)(ep + c4); kpf = *(const f32x4*)(ep + 64 + c4); vpf = *(const f32x4*)(ep + 128 + c4); wlp = *(const f32x4*)(ep + 192 + c4); alp = *(const f32x4*)(ep + 256 + c4); } }
              rs = rcf + (rpf - rcf) * mu_r; ks = kcf + (kpf - kcf) * mu_k; vs = vcf + (vpf - vcf) * mu_v;
              wl = wl + (wlp - wl) * mu_w; al = al + (alp - al) * mu_a;
              f32x4 tw; tw[0] = tanh_fast(wl[0]); tw[1] = tanh_fast(wl[1]); tw[2] = tanh_fast(wl[2]); tw[3] = tanh_fast(wl[3]);
              *(f32x4*)(TW + tt * 68 + c4) = tw; *(f32x4*)(AL + tt * 68 + c4) = al; }
            RW_BAR();
            float bon;
            if (wv < 4) { const int mat = wv >> 1, nt = wv & 1, r32 = lane & 31, hi5 = lane >> 5; const float* X = (mat ? AL : TW) + r32 * 68 + 8 * hi5; const bf16* Wt = (mat ? A2t : W2t) + (nt * 32 + r32) * 72 + 8 * hi5;
                f32x16 acc;
#pragma unroll
                for (int r = 0; r < 16; ++r) acc[r] = 0.f;
#pragma unroll
                for (int ks = 0; ks < 4; ++ks) { const f32x4 xa = *(const f32x4*)(X + 16 * ks), xb = *(const f32x4*)(X + 16 * ks + 4);
                    u32x4 ap; ap.x = cvt_pk_bf16(xa[0], xa[1]); ap.y = cvt_pk_bf16(xa[2], xa[3]); ap.z = cvt_pk_bf16(xb[0], xb[1]); ap.w = cvt_pk_bf16(xb[2], xb[3]);
                    const bf16x8 bp = *(const bf16x8*)(Wt + 16 * ks);
                    acc = __builtin_amdgcn_mfma_f32_32x32x16_bf16(__builtin_bit_cast(bf16x8, ap), bp, acc, 0, 0, 0); }
#pragma unroll
                for (int r = 0; r < 16; ++r) DL[mat * 2048 + ((r & 3) + 8 * (r >> 2) + 4 * hi5) * 64 + nt * 32 + r32] = acc[r]; }
            RW_BAR();
            { const f32x4 w0v = CV(5), a0v = CV(6), kkg = CV(7), kag = CV(8), rkg = CV(9); f32x4 wpre = w0v + *(const f32x4*)(DL + tt * 64 + c4), apre = a0v + *(const f32x4*)(DL + 2048 + tt * 64 + c4);
              f32x4 dec, av, kk, kp, bb; float ss = 0.f, bs = 0.f;
#pragma unroll
              for (int i = 0; i < 4; ++i) { const float wraw = -softplusf_(-wpre[i]) - 0.5f; dec[i] = exp_fast(-exp_fast(wraw)); av[i] = __builtin_amdgcn_rcpf(1.f + exp_fast(-apre[i])); kk[i] = ks[i] * kkg[i]; ss += kk[i] * kk[i]; }
              ss = red16(ss); const float inrm = __builtin_amdgcn_rsqf(fmaxf(ss, 1e-24f));
#pragma unroll
              for (int i = 0; i < 4; ++i) { kk[i] *= inrm; kp[i] = ks[i] * (1.f + (av[i] - 1.f) * kag[i]); bb[i] = kk[i] * av[i]; bs += rs[i] * kp[i] * rkg[i]; }
              bon = red16(bs);
              { float* pp = Rr + (tt >> 1) * 640 + (tt & 1) * 64 + c4;
                *(f32x4*)pp = rs; *(f32x4*)(pp + 128) = dec; *(f32x4*)(pp + 256) = kp; *(f32x4*)(pp + 384) = kk; *(f32x4*)(pp + 512) = bb; *(f32x4*)(Vv + tt * 64 + c4) = vs; } }
            RW_BAR();
            { const int p = tid >> 5, j2 = (tid & 31) * 2; float* pb = Rr + p * 640 + j2; typedef float f32x2v __attribute__((ext_vector_type(2)));
              const f32x2v r0 = *(const f32x2v*)pb, r1 = *(const f32x2v*)(pb + 64), w0 = *(const f32x2v*)(pb + 128), w1 = *(const f32x2v*)(pb + 192), k0 = *(const f32x2v*)(pb + 256), k1 = *(const f32x2v*)(pb + 320),
                            q0 = *(const f32x2v*)(pb + 384), q1 = *(const f32x2v*)(pb + 448), b0 = *(const f32x2v*)(pb + 512), b1 = *(const f32x2v*)(pb + 576);
              const f32x2v w1r1 = w1 * r1, B0 = b0 * w1, K0 = k0 * w1;
              *(f32x2v*)pb = q0; *(f32x2v*)(pb + 64) = w0 * q1; *(f32x2v*)(pb + 128) = w0 * r0; *(f32x2v*)(pb + 192) = w0 * w1r1;
              *(f32x2v*)(pb + 256) = w0 * w1; *(f32x2v*)(pb + 320) = B0; *(f32x2v*)(pb + 384) = K0; *(f32x2v*)(pb + 448) = b1; *(f32x2v*)(pb + 512) = k1;
              float d[8] = { b0.x * q1.x + b0.y * q1.y, k0.x * q1.x + k0.y * q1.y, b0.x * r0.x + b0.y * r0.y, k0.x * r0.x + k0.y * r0.y,
                             B0.x * r1.x + B0.y * r1.y, K0.x * r1.x + K0.y * r1.y, b1.x * r1.x + b1.y * r1.y, k1.x * r1.x + k1.y * r1.y };
              { const bool h16 = (lane & 16) != 0, h8 = (lane & 8) != 0, h4 = (lane & 4) != 0;
#pragma unroll
                for (int e = 0; e < 4; ++e) { const float snd = h16 ? d[e] : d[e + 4], kp_ = h16 ? d[e + 4] : d[e]; d[e] = kp_ + __shfl_xor(snd, 16); }
#pragma unroll
                for (int e = 0; e < 2; ++e) { const float snd = h8 ? d[e] : d[e + 2], kp_ = h8 ? d[e + 2] : d[e]; d[e] = kp_ + __shfl_xor(snd, 8); }
                { const float snd = h4 ? d[0] : d[1], kp_ = h4 ? d[1] : d[0]; d[0] = kp_ + __shfl_xor(snd, 4); }
                d[0] += __shfl_xor(d[0], 2); d[0] += __shfl_xor(d[0], 1);
                if ((lane & 3) == 0) Uu[p * 8 + (h16 ? 4 : 0) + (h8 ? 2 : 0) + (h4 ? 1 : 0)] = d[0]; } }
            RW_BAR();
            if (ck + 1 < T / 32) RW_FETCH(ck + 1);
            const int j0 = 16 * (wv & 3);
#define RW_LD16(dst, base) do { _Pragma("unroll") for (int g_ = 0; g_ < 4; ++g_) dst[g_] = *(const f32x4*)((base) + j0 + 4 * g_); } while (0)
#define RW_DOT16(x) ({ f32x4 a_ = Sv[0] * x[0] + Sv[1] * x[1] + Sv[2] * x[2] + Sv[3] * x[3]; (a_[0] + a_[1]) + (a_[2] + a_[3]); })
#pragma unroll 1
            for (int p = 0; p < 16; ++p) {
                const int par = (p & 1) * 1024; const float* pb = Rr + p * 640; const float* sc = Uu + p * 8;
                if (wv < 4) {
                    { f32x4 d0[4], d1[4], d2[4], d3[4]; RW_LD16(d0, pb); RW_LD16(d1, pb + 64); RW_LD16(d2, pb + 128); RW_LD16(d3, pb + 192);
                      red[par + wv * 64 + lane] = RW_DOT16(d0); red[par + 256 + wv * 64 + lane] = RW_DOT16(d1); red[par + 512 + wv * 64 + lane] = RW_DOT16(d2); red[par + 768 + wv * 64 + lane] = RW_DOT16(d3); }
                    asm volatile("" ::: "memory");
                    f32x4 u0[4], u1[4], u2[4], u3[4], u4[4]; RW_LD16(u0, pb + 256); RW_LD16(u1, pb + 320); RW_LD16(u2, pb + 384); RW_LD16(u3, pb + 448); RW_LD16(u4, pb + 512);
                    const float v0 = Vv[(2 * p) * 64 + lane], v1 = Vv[(2 * p + 1) * 64 + lane], c1 = sc[0], c2 = sc[1];
                    RW_BAR();
                    const float sa0 = (red[par + lane] + red[par + 64 + lane]) + (red[par + 128 + lane] + red[par + 192 + lane]);
                    const float q = (red[par + 256 + lane] + red[par + 320 + lane]) + (red[par + 384 + lane] + red[par + 448 + lane]);
                    const float sa1 = q - sa0 * c1 + v0 * c2;
#pragma unroll
                    for (int g = 0; g < 4; ++g) Sv[g] = Sv[g] * u0[g] - sa0 * u1[g] + v0 * u2[g] - sa1 * u3[g] + v1 * u4[g];
                } else {
                    RW_BAR();
                    if (wv < 6) {
                        const float v0 = Vv[(2 * p) * 64 + lane];
                        const float sa0 = (red[par + lane] + red[par + 64 + lane]) + (red[par + 128 + lane] + red[par + 192 + lane]);
                        if (wv == 4) { const float y0 = (red[par + 512 + lane] + red[par + 576 + lane]) + (red[par + 640 + lane] + red[par + 704 + lane]);
                            Yb[(2 * p) * 64 + lane] = y0 - sa0 * sc[2] + v0 * sc[3]; }
                        else { const float v1 = Vv[(2 * p + 1) * 64 + lane];
                            const float q = (red[par + 256 + lane] + red[par + 320 + lane]) + (red[par + 384 + lane] + red[par + 448 + lane]);
                            const float sa1 = q - sa0 * sc[0] + v0 * sc[1];
                            const float y1 = (red[par + 768 + lane] + red[par + 832 + lane]) + (red[par + 896 + lane] + red[par + 960 + lane]);
                            Yb[(2 * p + 1) * 64 + lane] = y1 - sa0 * sc[4] + v0 * sc[5] - sa1 * sc[6] + v1 * sc[7]; } }
                    else if (p == 0) {
                        const size_t i8 = ((size_t)((blockIdx.x * 2 + (wv - 6)) * 64 + ck)) * 64 + lane;
                        const f32x4 pa = *(const f32x4*)(P.p + i8 * 8), pq = *(const f32x4*)(P.p + i8 * 8 + 4);
                        *(u32x4*)((bf16*)(P.ws + WS_PB) + i8 * 8) = pg8::pack8(pa, pq); } }
            }
            if (ck + 1 < T / 32) RW_FETCH_PREV(row + 31);
            RW_BAR();
#undef RW_LD16
#undef RW_BAR
#undef RW_DOT16
            { const f32x4 lng = CV(10), lnb = CV(11); const f32x4 y4 = *(const f32x4*)(Yb + tt * 64 + c4); const float mean = red16((y4[0] + y4[1]) + (y4[2] + y4[3])) * (1.f / 64.f);
              const f32x4 d = y4 - mean; const float var = red16((d[0] * d[0] + d[1] * d[1]) + (d[2] * d[2] + d[3] * d[3])) * (1.f / 64.f); const float rstd = __builtin_amdgcn_rsqf(var + 64e-5f);
              const u32x2 gg = n_gg; if (ck + 1 < T / 32) n_gg = *(const u32x2*)(GBg + (row + 32) * 1024 + hc);
              const float g0 = bflo(gg.x), g1 = bfhi(gg.x), g2 = bflo(gg.y), g3 = bfhi(gg.y);
              const float z0 = (d[0] * rstd * lng[0] + lnb[0] + bon * vs[0]) * g0 * sigm(g0), z1 = (d[1] * rstd * lng[1] + lnb[1] + bon * vs[1]) * g1 * sigm(g1);
              const float z2 = (d[2] * rstd * lng[2] + lnb[2] + bon * vs[2]) * g2 * sigm(g2), z3 = (d[3] * rstd * lng[3] + lnb[3] + bon * vs[3]) * g3 * sigm(g3);
              u32x2 w; w.x = cvt_pk_bf16(z0, z1); w.y = cvt_pk_bf16(z2, z3); *(u32x2*)(Z + row * 2048 + 1024 + hc) = w; }
        }
    }
}

#undef RW_FETCH
#undef RW_FETCH_PREV
#undef CV
__device__ __forceinline__ void gmlp_phase(unsigned char* lds, const Ptrs& P, const bf16* Ug, const bf16* Vg, const bf16* Gg, const float* vsum, const float* vsq, bf16* Z, const int wave_s) {
    int tid_ = my_tid(wave_s); asm volatile("" : "+v"(tid_)); const int tid = tid_, lane = tid & 63, wid = __builtin_amdgcn_readfirstlane(tid >> 6), r32 = lane & 31, hi = lane >> 5;
    bf16* As = (bf16*)lds;
    bf16* Bt = As + 128 * 136;
    float* Ds = (float*)(lds + 2 * 128 * 136 * 2 + 256);
    int gcur = -1;
    for (int u = blockIdx.x; u < 4096; u += gridDim.x) {
        const int g = u & 15, bn = u >> 4; const size_t row0 = (size_t)bn * 128; const int C0 = g * 128;
        __syncthreads();
        if (g != gcur) { gcur = g; const float* ws_ = P.c_w_s + (size_t)g * 128 * 128;
            for (int i = tid; i < 128 * 128 / 4; i += 512) { const int t = i >> 5, s4 = (i & 31) * 4; f32x4 w = *(const f32x4*)(ws_ + t * 128 + s4);
                u32x2 o; o.x = cvt_pk_bf16(s4 + 0 <= t ? w[0] : 0.f, s4 + 1 <= t ? w[1] : 0.f); o.y = cvt_pk_bf16(s4 + 2 <= t ? w[2] : 0.f, s4 + 3 <= t ? w[3] : 0.f); *(u32x2*)(As + t * 136 + s4) = o; } }
#pragma unroll
        for (int it = 0; it < 4; ++it) { const int i = tid + it * 512, s = i >> 4, c8 = (i & 15) * 8; const size_t row = row0 + s;
            const float mean = vsum[row] * (1.f / 2048.f), var = vsq[row] * (1.f / 2048.f) - mean * mean, rstd = __builtin_amdgcn_rsqf(fmaxf(var, 0.f) + 1e-5f);
            const u32x4 vv = *(const u32x4*)(Vg + row * 2048 + C0 + c8); const f32x4 lg0 = *(const f32x4*)(P.c_ln_g + C0 + c8), lg1 = *(const f32x4*)(P.c_ln_g + C0 + c8 + 4), lb0 = *(const f32x4*)(P.c_ln_b + C0 + c8), lb1 = *(const f32x4*)(P.c_ln_b + C0 + c8 + 4);
            float x[8] = {bflo(vv.x), bfhi(vv.x), bflo(vv.y), bfhi(vv.y), bflo(vv.z), bfhi(vv.z), bflo(vv.w), bfhi(vv.w)};
#pragma unroll
            for (int j = 0; j < 8; ++j) { const float gn = (x[j] - mean) * rstd * (j < 4 ? lg0[j & 3] : lg1[j & 3]) + (j < 4 ? lb0[j & 3] : lb1[j & 3]); const float nb = __shfl_xor(gn, 0); (void)nb;
                Bt[(c8 + j) * 136 + (c8 >> 3) * 8 + s] = (bf16)(cvt_pk_bf16(gn, 0.f) & 0xffffu); } }
        __syncthreads();
        { const int tb = wid >> 1, cb = (wid & 1) * 64; f32x16 d0, d1;
#pragma unroll
          for (int r = 0; r < 16; ++r) { d0[r] = 0.f; d1[r] = 0.f; }
          for (int k = 0; k <= 2 * tb + 1; ++k) {
              const bf16x8 a = *(const bf16x8*)(As + (32 * tb + r32) * 136 + 16 * k + 8 * hi);
              const bf16x8 b0 = *(const bf16x8*)(Bt + (cb + r32) * 136 + ((cb + r32) >> 3) * 8 + 16 * k + 8 * hi), b1 = *(const bf16x8*)(Bt + (cb + 32 + r32) * 136 + ((cb + 32 + r32) >> 3) * 8 + 16 * k + 8 * hi);
              d0 = __builtin_amdgcn_mfma_f32_32x32x16_bf16(a, b0, d0, 0, 0, 0); d1 = __builtin_amdgcn_mfma_f32_32x32x16_bf16(a, b1, d1, 0, 0, 0); }
#pragma unroll
          for (int r = 0; r < 16; ++r) { const int t = 32 * tb + crow(r, hi); Ds[t * 132 + cb + r32] = d0[r]; Ds[t * 132 + cb + 32 + r32] = d1[r]; } }
        __syncthreads();
#pragma unroll
        for (int it = 0; it < 4; ++it) { const int i = tid + it * 512, t = i >> 4, c8 = (i & 15) * 8; const size_t off = (row0 + t) * 2048 + C0 + c8;
            const float bs = P.c_b_s[g * 128 + t]; const u32x4 uu = *(const u32x4*)(Ug + off), gg = *(const u32x4*)(Gg + off);
            const f32x4 da = *(const f32x4*)(Ds + t * 132 + c8), db = *(const f32x4*)(Ds + t * 132 + c8 + 4); u32x4 o;
            o.x = cvt_pk_bf16(bflo(uu.x) * (da[0] + bs) * bflo(gg.x), bfhi(uu.x) * (da[1] + bs) * bfhi(gg.x)); o.y = cvt_pk_bf16(bflo(uu.y) * (da[2] + bs) * bflo(gg.y), bfhi(uu.y) * (da[3] + bs) * bfhi(gg.y));
            o.z = cvt_pk_bf16(bflo(uu.z) * (db[0] + bs) * bflo(gg.z), bfhi(uu.z) * (db[1] + bs) * bfhi(gg.z)); o.w = cvt_pk_bf16(bflo(uu.w) * (db[2] + bs) * bflo(gg.w), bfhi(uu.w) * (db[3] + bs) * bfhi(gg.w));
            *(u32x4*)(Z + off) = o; }
    }
}

__global__ void __launch_bounds__(512, 2) mega_fwd(Ptrs P) {
    extern __shared__ __attribute__((aligned(16))) unsigned char lds[];
    cg::grid_group grid = cg::this_grid();
    const int wave_s = __builtin_amdgcn_readfirstlane((int)threadIdx.x >> 6);
    unsigned char* ws = P.ws;
    float* ctl = (float*)(ws + WS_CTL);
    float *ssq0 = ctl, *ssqA = ctl + M, *ssqB = ctl + 2 * M, *ssqC = ctl + 3 * M, *vsum = ctl + 4 * M, *vsq = ctl + 5 * M;
    bf16* G = (bf16*)(ws + WS_G); const size_t GS = (size_t)M * 1024;
    bf16* HBA = (bf16*)(ws + WS_HBA); bf16* PB = (bf16*)(ws + WS_PB); float* SMALL = (float*)(ws + WS_SMALL); bf16* Zb = (bf16*)(ws + WS_Z);
    bf16* Y0 = G; bf16* PP0 = G + 2 * GS; bf16* HBB = G + 6 * GS;
    bf16* U_u = G; bf16* U_v = G + 2 * GS; bf16* U_g = G + 4 * GS;
    bf16* Y1 = G + 6 * GS; bf16* PP1 = G;
    const int lo = P.ph_lo, hi = P.ph_hi;
    PG8_LAS unsigned char* lds3 = (PG8_LAS unsigned char*)lds;
#define IN(k) (lo <= (k) && (k) < hi)
    unsigned* const gbar = (unsigned*)(ws + WS_CTL + 0x1F0000);
#define SEAM(k) do { if (IN(k) && IN((k) + 1)) { if ((k) == 0) grid.sync(); else { \
        asm volatile("s_waitcnt vmcnt(0) lgkmcnt(0)" ::: "memory"); __syncthreads(); \
        if (my_tid(wave_s) == 0) { __builtin_amdgcn_fence(__ATOMIC_RELEASE, "agent"); asm volatile("s_waitcnt vmcnt(0)" ::: "memory"); \
            __hip_atomic_fetch_add(gbar, 1u, __ATOMIC_RELAXED, __HIP_MEMORY_SCOPE_AGENT); \
            while (__hip_atomic_load(gbar, __ATOMIC_RELAXED, __HIP_MEMORY_SCOPE_AGENT) < 256u * (unsigned)(k)) __builtin_amdgcn_s_sleep(4); \
            __builtin_amdgcn_fence(__ATOMIC_ACQUIRE, "agent"); asm volatile("s_waitcnt vmcnt(0)" ::: "memory"); } \
        __syncthreads(); } } } while (0)
    if (IN(0)) { p0_prologue(P, lds, wave_s); } SEAM(0);
    if (IN(1)) { pg8::Gemm g{HBA, (const bf16*)(ws + WS_WIN0), M, N_IN0, 2048}; pg8::StaticOrder S; S.init(M, N_IN0, gridDim.x, blockIdx.x);
        pg8::EpiIn0 E{G, SMALL, ssq0, 0.125f * LOG2E}; pg8::gemm_phase<pg8::EpiIn0, pg8::StaticOrder, true, true>(lds3, g, S, E, my_tid(wave_s)); } SEAM(1);
    if (IN(2)) { attn_phase(lds, G, G + GS, G + 2 * GS, G + 3 * GS, SMALL, P.fox_f_bias, Zb, wave_s);
        rwkv_phase(lds, P, G + 4 * GS, G + 5 * GS, G + 6 * GS, G + 7 * GS, SMALL, Zb, wave_s); } SEAM(2);
    if (IN(3)) { { pg8::Gemm g{Zb, (const bf16*)(ws + WS_WOUT0), M, 2048, 2048}; pg8::StaticOrder S; S.init(M, 2048, gridDim.x, blockIdx.x);
          pg8::EpiY E{Y0, ssqA}; pg8::gemm_phase<pg8::EpiY, pg8::StaticOrder, true, true>(lds3, g, S, E, my_tid(wave_s)); }
        { pg8::Gemm g{PB, (const bf16*)(ws + WS_WP0), M, 2048, 256}; pg8::StaticOrder S; S.init(M, 2048, gridDim.x, blockIdx.x);
          pg8::EpiBf16<0> E{PP0, 2048, nullptr, 0, 0, 1.f}; pg8::gemm_phase<pg8::EpiBf16<0>, pg8::StaticOrder, true, true>(lds3, g, S, E, my_tid(wave_s)); } } SEAM(3);
    if (IN(4)) { post_norm_phase(P.x, Y0, ssqA, P.norm_post, P.out, HBA, wave_s); } SEAM(4);
    if (IN(5)) { pg8::Gemm g{HBA, (const bf16*)(ws + WS_WG0), M, 2048, 2048}; pg8::StaticOrder S; S.init(M, 2048, gridDim.x, blockIdx.x);
        pg8::EpiGate E{P.out, PP0, HBB, ssqB}; pg8::gemm_phase<pg8::EpiGate, pg8::StaticOrder, true, true>(lds3, g, S, E, my_tid(wave_s)); } SEAM(5);
    if (IN(6)) { pg8::Gemm g{HBB, (const bf16*)(ws + WS_WIN1), M, 6144, 2048}; pg8::StaticOrder S; S.init(M, 6144, gridDim.x, blockIdx.x);
        pg8::EpiC E{U_u, 2 * GS, ssqB, vsum, vsq}; pg8::gemm_phase<pg8::EpiC, pg8::StaticOrder, true, true>(lds3, g, S, E, my_tid(wave_s)); } SEAM(6);
    if (IN(7)) { gmlp_phase(lds, P, U_u, U_v, U_g, vsum, vsq, Zb, wave_s); } SEAM(7);
    if (IN(8)) { { pg8::Gemm g{Zb, (const bf16*)(ws + WS_WOUT1), M, 2048, 2048}; pg8::StaticOrder S; S.init(M, 2048, gridDim.x, blockIdx.x);
          pg8::EpiY E{Y1, ssqC}; pg8::gemm_phase<pg8::EpiY, pg8::StaticOrder, true, true>(lds3, g, S, E, my_tid(wave_s)); }
        { pg8::Gemm g{PB + (size_t)M * 256, (const bf16*)(ws + WS_WP1), M, 2048, 256}; pg8::StaticOrder S; S.init(M, 2048, gridDim.x, blockIdx.x);
          pg8::EpiBf16<0> E{PP1, 2048, nullptr, 0, 0, 1.f}; pg8::gemm_phase<pg8::EpiBf16<0>, pg8::StaticOrder, true, true>(lds3, g, S, E, my_tid(wave_s)); } } SEAM(8);
    if (IN(9)) { post_norm_phase(P.out, Y1, ssqC, P.norm_post + 2048, P.out, HBA, wave_s); } SEAM(9);
    if (IN(10)) { pg8::Gemm g{HBA, (const bf16*)(ws + WS_WG1), M, 2048, 2048}; pg8::StaticOrder S; S.init(M, 2048, gridDim.x, blockIdx.x);
        pg8::EpiGate E{P.out, PP1, nullptr, nullptr}; pg8::gemm_phase<pg8::EpiGate, pg8::StaticOrder, true, true>(lds3, g, S, E, my_tid(wave_s)); }
#undef IN
#undef SEAM
}

#ifndef MK_PER_PHASE
#define MK_PER_PHASE 0
#endif
constexpr int N_PHASES = 11;
extern "C" void kernel_launch(void* const* d_in, const int* in_sizes, int n_in, void* d_out, int out_size, void* d_ws, size_t ws_size, hipStream_t stream) {
    static int grid = 0;
    if (grid == 0) {
        if (n_in != 25 || ws_size < WS_END) { fprintf(stderr, "kernel_launch: need 25 inputs and %zu bytes of workspace (got %d, %zu)\n", (size_t)WS_END, n_in, ws_size); grid = -1; return; }
        int dev = 0, cus = 0, per_cu = 0;
        hipGetDevice(&dev); hipDeviceGetAttribute(&cus, hipDeviceAttributeMultiprocessorCount, dev);
        if (hipFuncSetAttribute((const void*)mega_fwd, hipFuncAttributeMaxDynamicSharedMemorySize, LDS_BYTES) != hipSuccess) { fprintf(stderr, "kernel_launch: hipFuncSetAttribute failed\n"); grid = -1; return; }
        hipOccupancyMaxActiveBlocksPerMultiprocessor(&per_cu, (const void*)mega_fwd, 512, LDS_BYTES);
        (void)hipGetLastError();
        if (per_cu < 1) { fprintf(stderr, "kernel_launch: occupancy query says %d blocks per CU\n", per_cu); per_cu = 1; }
        if (cus < 256) { fprintf(stderr, "kernel_launch: built for a 256-CU device (got %d CUs)\n", cus); grid = -1; return; }
        grid = 256;
    }
    if (grid < 0) return;
    (void)hipMemsetAsync((char*)d_ws + WS_CTL + 0x1F0000, 0, 256, stream);
    Ptrs p{};
    const float** pp = (const float**)&p;
    for (int i = 0; i < 25; ++i) pp[i] = (const float*)d_in[i];
    p.out = (float*)d_out; p.ws = (unsigned char*)d_ws;
#if MK_PER_PHASE
    for (int k = 0; k < N_PHASES; ++k) { p.ph_lo = k; p.ph_hi = k + 1; hipLaunchKernelGGL(mega_fwd, dim3(grid), dim3(512), LDS_BYTES, stream, p); }
#else
    p.ph_lo = 0; p.ph_hi = N_PHASES;
    void* args[] = {&p};
    hipError_t e = hipLaunchCooperativeKernel((const void*)mega_fwd, dim3(grid), dim3(512), args, LDS_BYTES, stream);
    if (e != hipSuccess) fprintf(stderr, "cooperative launch failed: %s (grid %d)\n", hipGetErrorString(e), grid);
#endif
}
```

```cpp
#include <hip/hip_runtime.h>
#include <hip/hip_cooperative_groups.h>
#include <cstdio>
#include <cstdint>
namespace cg = cooperative_groups;
namespace pg8 {
#define PG8_LAS __attribute__((address_space(3)))
typedef unsigned short bf16_t;
typedef short bf16x8 __attribute__((ext_vector_type(8)));
typedef float f32x4 __attribute__((ext_vector_type(4)));
typedef unsigned u32x4 __attribute__((ext_vector_type(4)));
constexpr int BM = 256, BK = 64, HALF = 128, HTB = HALF * BK * 2  , STAGE_BYTES = 8 * HTB, NXCD = 8, WGM = 8;

__host__ __device__ __forceinline__ int lds_byte(int r, int c) { const int st = (r >> 4) * 2 + (c >> 5), rr = r & 15, cc = c & 31, ob = rr * 64 + cc * 2; return st * 1024 + (ob ^ (((ob >> 9) & 1) << 5)); }
__host__ __device__ __forceinline__ void stage_rc(int b, int& R, int& C) { const int st = b / 1024, sb = b % 1024, swz = sb ^ (((sb >> 9) & 1) << 5); R = (st >> 1) * 16 + swz / 64; C = (st & 1) * 32 + (swz % 64) / 2; }
__host__ __device__ __forceinline__ int perm32(int rho) { const int n = rho >> 4, i = rho & 15; return 8 * (i >> 2) + 4 * n + (i & 3); }

struct Unit { int pm, pn; };
struct Gemm { const bf16_t* A; const bf16_t* Bt; int M, N, K; };

struct StaticOrder {
    int nM, nN, nwg, G, c;
    __host__ __device__ void init(int M, int N, int G_, int c_) { nM = M / BM; nN = N / BM; nwg = nM * nN; G = G_; c = c_; }
    __host__ __device__ bool next(int i, Unit& u) const {
        const long L = (long)i * G + c; if (L >= nwg) return false;
        int wgid = (int)L; { const int q = nwg / NXCD, r = nwg % NXCD, xcd = wgid % NXCD, off = wgid / NXCD; wgid = (xcd < r ? xcd * (q + 1) : r * (q + 1) + (xcd - r) * q) + off; }
        const int nig = WGM * nN, gid = wgid / nig, fm = gid * WGM, gsz = (nM - fm) < WGM ? (nM - fm) : WGM;
        u.pm = fm + ((wgid % nig) % gsz); u.pn = (wgid % nig) / gsz; return true;
    }
    __device__ __forceinline__ void a_ready(const Unit&) const {}
    __device__ __forceinline__ void done(const Unit&) const {}
};

__device__ __forceinline__ unsigned cvt_pk_bf16(float lo, float hi) { unsigned r; asm volatile("v_cvt_pk_bf16_f32 %0, %1, %2" : "=v"(r) : "v"(lo), "v"(hi)); return r; }
typedef float f32x2 __attribute__((ext_vector_type(2)));
__device__ __forceinline__ f32x2 gelu_pk(f32x2 v) {
    const f32x2 av = __builtin_elementwise_abs(v), d = av * 0.2316418882f + 1.0f;
    f32x2 t; t.x = __builtin_amdgcn_rcpf(d.x); t.y = __builtin_amdgcn_rcpf(d.y);
    f32x2 q = t * 0.5307027145f + (-0.7265760135f); q = q * t + 0.7107068705f; q = q * t + (-0.142248368f); q = q * t + 0.127414796f; q = q * t;
    const f32x2 s = (v * v) * (-0.72134752044f);
    f32x2 e; e.x = __builtin_amdgcn_exp2f(s.x); e.y = __builtin_amdgcn_exp2f(s.y);
    const f32x2 m = v * (q * e), r = v - m;
    f32x2 o; o.x = v.x < 0.f ? m.x : r.x; o.y = v.y < 0.f ? m.y : r.y; return o;
}
template <int ACT  > struct EpiBf16 {
    static constexpr bool PERM = true, AFTER_DRAIN = false; static_assert(ACT == 0 || ACT == 1, "EpiBf16: ACT is 0 (none) or 1 (gelu_pk)");
    bf16_t* O; int ldc; const float* bias; int split_cols; size_t split_stride; float scale0;
    __device__ __forceinline__ void operator()(const f32x4 (&acc)[2][2][4][2], const Unit& u, int wr, int wc, int fr, int fq) const {
        const int row0 = u.pm * BM + wr * 64 + fr; int colt = u.pn * BM; bf16_t* base = O;
        float sc = 1.f; if (split_cols) { const int t = colt / split_cols; base += (size_t)t * split_stride; colt -= t * split_cols; if (t == 0) sc = scale0; }
        const int col0 = colt + wc * 32 + 8 * fq, bcol0 = u.pn * BM + wc * 32 + 8 * fq;
        f32x4 bv[2][2];
#pragma unroll
        for (int bj = 0; bj < 2; ++bj)
#pragma unroll
            for (int n = 0; n < 2; ++n) bv[bj][n] = bias ? *(const f32x4*)(bias + bcol0 + bj * HALF + 4 * n) : (f32x4){0.f, 0.f, 0.f, 0.f};
#pragma unroll
        for (int ai = 0; ai < 2; ++ai)
#pragma unroll
            for (int m = 0; m < 4; ++m) { bf16_t* rowp = base + (size_t)(row0 + ai * HALF + m * 16) * ldc + col0;
#pragma unroll
                for (int bj = 0; bj < 2; ++bj) { f32x4 v0 = acc[ai][bj][m][0] + bv[bj][0], v1 = acc[ai][bj][m][1] + bv[bj][1];
                    if (ACT == 1) { f32x2 a = gelu_pk((f32x2){v0[0], v0[1]}), b = gelu_pk((f32x2){v0[2], v0[3]}), c = gelu_pk((f32x2){v1[0], v1[1]}), d = gelu_pk((f32x2){v1[2], v1[3]});
                        v0 = (f32x4){a.x, a.y, b.x, b.y}; v1 = (f32x4){c.x, c.y, d.x, d.y}; }
                    v0 = v0 * sc; v1 = v1 * sc; u32x4 w; w.x = cvt_pk_bf16(v0[0], v0[1]); w.y = cvt_pk_bf16(v0[2], v0[3]); w.z = cvt_pk_bf16(v1[0], v1[1]); w.w = cvt_pk_bf16(v1[2], v1[3]);
                    *(u32x4*)(rowp + bj * HALF) = w; } }
    }
};
__device__ __forceinline__ u32x4 pack8(const f32x4 v0, const f32x4 v1) { u32x4 w; w.x = cvt_pk_bf16(v0[0], v0[1]); w.y = cvt_pk_bf16(v0[2], v0[3]); w.z = cvt_pk_bf16(v1[0], v1[1]); w.w = cvt_pk_bf16(v1[2], v1[3]); return w; }
__device__ __forceinline__ float bflo(unsigned u) { return __uint_as_float(u << 16); }
__device__ __forceinline__ float bfhi(unsigned u) { return __uint_as_float(u & 0xffff0000u); }
__device__ __forceinline__ float sigm(float x) { return __builtin_amdgcn_rcpf(1.0f + __builtin_amdgcn_exp2f(-1.4426950408889634f * x)); }
#define PG8_FOR_AI_M _Pragma("unroll") for (int ai = 0; ai < 2; ++ai) _Pragma("unroll") for (int m = 0; m < 4; ++m)
struct EpiIn0 {
    static constexpr bool PERM = true, AFTER_DRAIN = false;
    bf16_t* G; float* small; const float* ssq; float qscale;
    __device__ __forceinline__ void operator()(const f32x4 (&acc)[2][2][4][2], const Unit& u, int wr, int wc, int fr_, int fq_) const {
        int fr = fr_, fq = fq_; asm volatile("" : "+v"(fr), "+v"(fq));
        const int row0 = u.pm * BM + wr * 64 + fr, ct = wc * 32 + 8 * fq;
        float rsv[2][4];
        PG8_FOR_AI_M rsv[ai][m] = __builtin_amdgcn_rsqf(ssq[row0 + ai * HALF + m * 16] * (1.f / 2048.f) + 1e-6f);
        if (u.pn < 32) {
            const int grp = u.pn >> 2; bf16_t* base = G + (size_t)grp * ((size_t)32768 * 1024) + (u.pn & 3) * 256 + ct; const float sc0 = (grp == 0) ? qscale : 1.f;
            PG8_FOR_AI_M { const int row = row0 + ai * HALF + m * 16; const float rs = rsv[ai][m] * sc0; bf16_t* rp = base + (size_t)row * 1024;
#pragma unroll
                for (int bj = 0; bj < 2; ++bj) *(u32x4*)(rp + bj * HALF) = pack8(acc[ai][bj][m][0] * rs, acc[ai][bj][m][1] * rs); }
        } else {
            PG8_FOR_AI_M { const int row = row0 + ai * HALF + m * 16; const float rs = rsv[ai][m]; float* rp = small + (size_t)row * 256 + ct;
#pragma unroll
                for (int bj = 0; bj < 2; ++bj) { *(f32x4*)(rp + bj * HALF) = acc[ai][bj][m][0] * rs; *(f32x4*)(rp + bj * HALF + 4) = acc[ai][bj][m][1] * rs; } }
        }
    }
};
struct EpiY {
    static constexpr bool PERM = true, AFTER_DRAIN = false;
    bf16_t* Y; float* ssq;
    __device__ __forceinline__ void operator()(const f32x4 (&acc)[2][2][4][2], const Unit& u, int wr, int wc, int fr_, int fq_) const {
        int fr = fr_, fq = fq_; asm volatile("" : "+v"(fr), "+v"(fq));
        const int row0 = u.pm * BM + wr * 64 + fr, col0 = u.pn * BM + wc * 32 + 8 * fq;
        PG8_FOR_AI_M { const int row = row0 + ai * HALF + m * 16; float s = 0.f; bf16_t* rp = Y + (size_t)row * 2048 + col0;
#pragma unroll
            for (int bj = 0; bj < 2; ++bj) { const f32x4 v0 = acc[ai][bj][m][0], v1 = acc[ai][bj][m][1];
                s += (v0[0] * v0[0] + v0[1] * v0[1]) + (v0[2] * v0[2] + v0[3] * v0[3]) + (v1[0] * v1[0] + v1[1] * v1[1]) + (v1[2] * v1[2] + v1[3] * v1[3]);
                *(u32x4*)(rp + bj * HALF) = pack8(v0, v1); }
            s += __shfl_xor(s, 16); s += __shfl_xor(s, 32);
            if (fq == 0) __hip_atomic_fetch_add(ssq + row, s, __ATOMIC_RELAXED, __HIP_MEMORY_SCOPE_AGENT); }
    }
};
struct EpiGate {
    static constexpr bool PERM = true, AFTER_DRAIN = false;
    const float* Hin; float* Hout; const bf16_t* Y; const float* ssqY; const float* gpost; const bf16_t* PP; bf16_t* HB; float* ssq;
    __device__ __forceinline__ void operator()(const f32x4 (&acc)[2][2][4][2], const Unit& u, int wr, int wc, int fr_, int fq_) const {
        int fr = fr_, fq = fq_; asm volatile("" : "+v"(fr), "+v"(fq));
        const int row0 = u.pm * BM + wr * 64 + fr, col0 = u.pn * BM + wc * 32 + 8 * fq;
        f32x4 gv[2][2];
#pragma unroll
        for (int bj = 0; bj < 2; ++bj) { gv[bj][0] = *(const f32x4*)(gpost + col0 + bj * HALF); gv[bj][1] = *(const f32x4*)(gpost + col0 + bj * HALF + 4); }
#pragma unroll
        for (int ai = 0; ai < 2; ++ai)
#pragma unroll
            for (int mp = 0; mp < 2; ++mp) {
                f32x4 hh[2][2][2]; u32x4 pq[2][2], yq[2][2]; float rsq[2];
#pragma unroll
                for (int mm = 0; mm < 2; ++mm) { const int row = row0 + ai * HALF + (2 * mp + mm) * 16; rsq[mm] = __builtin_amdgcn_rsqf(ssqY[row] * (1.f / 2048.f) + 1e-6f);
#pragma unroll
                    for (int bj = 0; bj < 2; ++bj) { const size_t off = (size_t)row * 2048 + col0 + bj * HALF;
                        hh[mm][bj][0] = *(const f32x4*)(Hin + off); hh[mm][bj][1] = *(const f32x4*)(Hin + off + 4); pq[mm][bj] = *(const u32x4*)(PP + off); yq[mm][bj] = *(const u32x4*)(Y + off); } }
#pragma unroll
                for (int mm = 0; mm < 2; ++mm) { const int m = 2 * mp + mm; const int row = row0 + ai * HALF + m * 16; float s = 0.f; const float rs = rsq[mm];
#pragma unroll
                    for (int bj = 0; bj < 2; ++bj) { const size_t off = (size_t)row * 2048 + col0 + bj * HALF; float* hp = Hout + off;
                        const u32x4 pp = pq[mm][bj], yy = yq[mm][bj]; const f32x4 g0 = gv[bj][0] * rs, g1 = gv[bj][1] * rs; f32x4 h0 = hh[mm][bj][0], h1 = hh[mm][bj][1];
                        h0[0] += bflo(yy.x) * g0[0]; h0[1] += bfhi(yy.x) * g0[1]; h0[2] += bflo(yy.y) * g0[2]; h0[3] += bfhi(yy.y) * g0[3];
                        h1[0] += bflo(yy.z) * g1[0]; h1[1] += bfhi(yy.z) * g1[1]; h1[2] += bflo(yy.w) * g1[2]; h1[3] += bfhi(yy.w) * g1[3];
                        const f32x4 a0 = acc[ai][bj][m][0], a1 = acc[ai][bj][m][1]; f32x4 o0, o1;
                        o0[0] = h0[0] + bflo(pp.x) * sigm(a0[0]); o0[1] = h0[1] + bfhi(pp.x) * sigm(a0[1]); o0[2] = h0[2] + bflo(pp.y) * sigm(a0[2]); o0[3] = h0[3] + bfhi(pp.y) * sigm(a0[3]);
                        o1[0] = h1[0] + bflo(pp.z) * sigm(a1[0]); o1[1] = h1[1] + bfhi(pp.z) * sigm(a1[1]); o1[2] = h1[2] + bflo(pp.w) * sigm(a1[2]); o1[3] = h1[3] + bfhi(pp.w) * sigm(a1[3]);
                        *(f32x4*)hp = o0; *(f32x4*)(hp + 4) = o1;
                        if (HB) *(u32x4*)(HB + off) = pack8(o0, o1);
                        s += (o0[0] * o0[0] + o0[1] * o0[1]) + (o0[2] * o0[2] + o0[3] * o0[3]) + (o1[0] * o1[0] + o1[1] * o1[1]) + (o1[2] * o1[2] + o1[3] * o1[3]); }
                    if (ssq) { s += __shfl_xor(s, 16); s += __shfl_xor(s, 32); if (fq == 0) __hip_atomic_fetch_add(ssq + row, s, __ATOMIC_RELAXED, __HIP_MEMORY_SCOPE_AGENT); } } }
    }
};
struct EpiC {
    static constexpr bool PERM = true, AFTER_DRAIN = false;
    bf16_t* U0; size_t ustride; const float* ssq; float* vsum; float* vsq;
    __device__ __forceinline__ void operator()(const f32x4 (&acc)[2][2][4][2], const Unit& u, int wr, int wc, int fr_, int fq_) const {
        int fr = fr_, fq = fq_; asm volatile("" : "+v"(fr), "+v"(fq));
        const int seg = u.pn >> 3; bf16_t* base = U0 + (size_t)seg * ustride;
        const int row0 = u.pm * BM + wr * 64 + fr, col0 = (u.pn & 7) * BM + wc * 32 + 8 * fq;
        float rsv[2][4];
        PG8_FOR_AI_M rsv[ai][m] = __builtin_amdgcn_rsqf(ssq[row0 + ai * HALF + m * 16] * (1.f / 2048.f) + 1e-6f);
        PG8_FOR_AI_M { const int row = row0 + ai * HALF + m * 16; const float rs = rsv[ai][m]; float s1 = 0.f, s2 = 0.f; bf16_t* rp = base + (size_t)row * 2048 + col0;
#pragma unroll
            for (int bj = 0; bj < 2; ++bj) { f32x4 v0 = acc[ai][bj][m][0] * rs, v1 = acc[ai][bj][m][1] * rs;
                if (seg < 2) { f32x2 a = gelu_pk((f32x2){v0[0], v0[1]}), b = gelu_pk((f32x2){v0[2], v0[3]}), c = gelu_pk((f32x2){v1[0], v1[1]}), d = gelu_pk((f32x2){v1[2], v1[3]});
                    v0 = (f32x4){a.x, a.y, b.x, b.y}; v1 = (f32x4){c.x, c.y, d.x, d.y}; }
                else {
#pragma unroll
                    for (int i = 0; i < 4; ++i) { v0[i] = v0[i] * sigm(v0[i]); v1[i] = v1[i] * sigm(v1[i]); } }
                *(u32x4*)(rp + bj * HALF) = pack8(v0, v1);
                if (seg == 1) { s1 += (v0[0] + v0[1]) + (v0[2] + v0[3]) + (v1[0] + v1[1]) + (v1[2] + v1[3]);
                    s2 += (v0[0] * v0[0] + v0[1] * v0[1]) + (v0[2] * v0[2] + v0[3] * v0[3]) + (v1[0] * v1[0] + v1[1] * v1[1]) + (v1[2] * v1[2] + v1[3] * v1[3]); } }
            if (seg == 1) { s1 += __shfl_xor(s1, 16); s1 += __shfl_xor(s1, 32); s2 += __shfl_xor(s2, 16); s2 += __shfl_xor(s2, 32);
                if (fq == 0) { __hip_atomic_fetch_add(vsum + row, s1, __ATOMIC_RELAXED, __HIP_MEMORY_SCOPE_AGENT); __hip_atomic_fetch_add(vsq + row, s2, __ATOMIC_RELAXED, __HIP_MEMORY_SCOPE_AGENT); } } }
    }
};
template <class Epi, class Sched, bool ALIGN_EPI = false, bool SP2 = false>
__device__ __forceinline__ void gemm_phase(PG8_LAS unsigned char* lds, const Gemm g, const Sched& S, const Epi& E, const int tid_in) {
    const int tid = tid_in, wid = __builtin_amdgcn_readfirstlane(tid >> 6), lane = tid & 63, wr = wid >> 2, wc = wid & 3, fr = lane & 15, fq = lane >> 4;
    const int K = g.K, nt = K / BK;
    unsigned voffA[2], voffB[2];
#pragma unroll
    for (int i = 0; i < 2; ++i) { int R, C; stage_rc(tid * 16 + i * 8192, R, C); const int Rb = Epi::PERM ? ((R & ~31) + perm32(R & 31)) : R;
        voffA[i] = (unsigned)(R * K + C) * 2u; voffB[i] = (unsigned)(Rb * K + C) * 2u; }
    const size_t kstep = (size_t)(BK * 2);
    const size_t hstep = (size_t)HALF * K * 2;
    const size_t tstep = 2 * hstep;
    const unsigned ldsw = (unsigned)wid * 1024u;
    const int aoff = lds_byte(wr * 64 + fr, fq * 8), boff = lds_byte(wc * 32 + fr, fq * 8);
#define PG8_SA(b, h) (((b) * 2 + (h)) * HTB)
#define PG8_SB(b, h) ((4 + (b) * 2 + (h)) * HTB)
#define PG8_STAGE(bufoff, gbase, voff) do { _Pragma("unroll") for (int _i = 0; _i < 2; ++_i) \
        __builtin_amdgcn_global_load_lds((const unsigned*)((const char*)(gbase) + (voff)[_i]), (PG8_LAS unsigned*)(lds + (bufoff) + ldsw + _i * 8192), 16, 0, 0); } while (0)
#define PG8_LDA(dst, b, h) do { _Pragma("unroll") for (int m = 0; m < 4; ++m) _Pragma("unroll") for (int k = 0; k < 2; ++k) dst[m][k] = *(const PG8_LAS bf16x8*)(lds + PG8_SA(b, h) + aoff + m * 2048 + k * 1024); } while (0)
#define PG8_LDB(dst, b, h) do { _Pragma("unroll") for (int n = 0; n < 2; ++n) _Pragma("unroll") for (int k = 0; k < 2; ++k) dst[n][k] = *(const PG8_LAS bf16x8*)(lds + PG8_SB(b, h) + boff + n * 2048 + k * 1024); } while (0)
#define PG8_MMA(ai, bj, At, Bt) do { __builtin_amdgcn_s_setprio(1); _Pragma("unroll") for (int m = 0; m < 4; ++m) _Pragma("unroll") for (int n = 0; n < 2; ++n) _Pragma("unroll") for (int k = 0; k < 2; ++k) \
        acc[ai][bj][m][n] = __builtin_amdgcn_mfma_f32_16x16x32_bf16(Bt[n][k], At[m][k], acc[ai][bj][m][n], 0, 0, 0); __builtin_amdgcn_s_setprio(0); } while (0)
#define PG8_WAIT_V(n) asm volatile("s_waitcnt vmcnt(" #n ")" ::: "memory")
#define PG8_WAIT_L(n) asm volatile("s_waitcnt lgkmcnt(" #n ")" ::: "memory")
#define PG8_BAR __builtin_amdgcn_s_barrier()
#define PG8_SCHED __builtin_amdgcn_sched_barrier(0)
    Unit cur, nxt; int ui = 0;
    if (!S.next(0, cur)) return;
    f32x4 acc[2][2][4][2];
#pragma unroll
    for (int a = 0; a < 2; ++a)
#pragma unroll
        for (int b = 0; b < 2; ++b)
#pragma unroll
            for (int m = 0; m < 4; ++m)
#pragma unroll
                for (int n = 0; n < 2; ++n) acc[a][b][m][n] = (f32x4){0.f, 0.f, 0.f, 0.f};
    bf16x8 At[4][2], B0[2][2], B1[2][2];
    const char* cA = (const char*)g.A + (size_t)cur.pm * tstep; const char* cB = (const char*)g.Bt + (size_t)cur.pn * tstep;
    S.a_ready(cur);
    if constexpr (SP2) {
        PG8_STAGE(PG8_SB(0, 0), cB, voffB); PG8_STAGE(PG8_SB(0, 1), cB + hstep, voffB); PG8_STAGE(PG8_SA(0, 0), cA, voffA); PG8_STAGE(PG8_SA(0, 1), cA + hstep, voffA);
        if (wr == 1) PG8_BAR;
        PG8_WAIT_V(2); PG8_BAR;
        PG8_STAGE(PG8_SB(1, 0), cB + kstep, voffB); PG8_STAGE(PG8_SA(1, 0), cA + kstep, voffA); PG8_STAGE(PG8_SB(1, 1), cB + hstep + kstep, voffB);
        PG8_WAIT_V(6); PG8_BAR;
    } else {
        PG8_STAGE(PG8_SB(0, 0), cB, voffB); PG8_STAGE(PG8_SA(0, 0), cA, voffA); PG8_STAGE(PG8_SB(0, 1), cB + hstep, voffB); PG8_STAGE(PG8_SA(0, 1), cA + hstep, voffA);
        if (wr == 1) PG8_BAR;
        PG8_WAIT_V(4); PG8_BAR;
        PG8_STAGE(PG8_SB(1, 0), cB + kstep, voffB); PG8_STAGE(PG8_SA(1, 0), cA + kstep, voffA); PG8_STAGE(PG8_SB(1, 1), cB + hstep + kstep, voffB);
        PG8_WAIT_V(6); PG8_BAR;
    }
    for (;;) {
        const bool has_next = S.next(ui + 1, nxt);
        const char* nA = has_next ? (const char*)g.A + (size_t)nxt.pm * tstep : cA; const char* nB = has_next ? (const char*)g.Bt + (size_t)nxt.pn * tstep : cB;
        for (int t = 0; t < nt; t += 2) {
            const bool last = (t == nt - 2);
            const char* a1 = cA + (size_t)(t + 1) * kstep;
            const char* a2 = last ? nA : cA + (size_t)(t + 2) * kstep; const char* b2 = last ? nB : cB + (size_t)(t + 2) * kstep;
            const char* a3 = a2 + kstep; const char* b3 = b2 + kstep;
            if (last && has_next) S.a_ready(nxt);
            if constexpr (SP2) {
            PG8_LDB(B0, 0, 0); PG8_LDB(B1, 0, 1); PG8_SCHED; PG8_LDA(At, 0, 0); PG8_STAGE(PG8_SA(1, 1), a1 + hstep, voffA);
            PG8_WAIT_V(8); PG8_WAIT_L(0); PG8_BAR; PG8_MMA(0, 0, At, B0); PG8_MMA(0, 1, At, B1); PG8_BAR; PG8_SCHED;
            PG8_LDA(At, 0, 1); PG8_STAGE(PG8_SB(0, 0), b2, voffB); PG8_STAGE(PG8_SB(0, 1), b2 + hstep, voffB); PG8_STAGE(PG8_SA(0, 0), a2, voffA);
            PG8_WAIT_V(8); PG8_WAIT_L(0); PG8_BAR; PG8_MMA(1, 0, At, B0); PG8_MMA(1, 1, At, B1); PG8_BAR; PG8_SCHED;
            PG8_LDB(B0, 1, 0); PG8_LDB(B1, 1, 1); PG8_SCHED; PG8_LDA(At, 1, 0); PG8_STAGE(PG8_SA(0, 1), a2 + hstep, voffA);
            PG8_WAIT_V(8); PG8_WAIT_L(0); PG8_BAR; PG8_MMA(0, 0, At, B0); PG8_MMA(0, 1, At, B1); PG8_BAR; PG8_SCHED;
            PG8_LDA(At, 1, 1); PG8_STAGE(PG8_SB(1, 0), b3, voffB); PG8_STAGE(PG8_SB(1, 1), b3 + hstep, voffB); PG8_STAGE(PG8_SA(1, 0), a3, voffA);
            PG8_WAIT_V(8); PG8_WAIT_L(0); PG8_BAR; PG8_MMA(1, 0, At, B0); PG8_MMA(1, 1, At, B1); PG8_BAR; PG8_SCHED;
            } else {
            PG8_LDB(B0, 0, 0); PG8_SCHED; PG8_LDA(At, 0, 0); PG8_STAGE(PG8_SA(1, 1), a1 + hstep, voffA);
            PG8_WAIT_L(8); PG8_BAR; PG8_WAIT_L(0); PG8_MMA(0, 0, At, B0); PG8_BAR; PG8_SCHED;
            PG8_LDB(B1, 0, 1); PG8_STAGE(PG8_SB(0, 0), b2, voffB);
            PG8_BAR; PG8_WAIT_L(0); PG8_MMA(0, 1, At, B1); PG8_BAR;
            PG8_LDA(At, 0, 1); PG8_STAGE(PG8_SA(0, 0), a2, voffA);
            PG8_BAR; PG8_WAIT_L(0); PG8_MMA(1, 0, At, B0); PG8_BAR; PG8_SCHED;
            PG8_STAGE(PG8_SB(0, 1), b2 + hstep, voffB);
            PG8_WAIT_V(6); PG8_BAR; PG8_MMA(1, 1, At, B1); PG8_BAR;
            PG8_LDB(B0, 1, 0); PG8_SCHED; PG8_LDA(At, 1, 0); PG8_STAGE(PG8_SA(0, 1), a2 + hstep, voffA);
            PG8_WAIT_L(8); PG8_BAR; PG8_WAIT_L(0); PG8_MMA(0, 0, At, B0); PG8_BAR; PG8_SCHED;
            PG8_LDB(B1, 1, 1); PG8_STAGE(PG8_SB(1, 0), b3, voffB);
            PG8_BAR; PG8_WAIT_L(0); PG8_MMA(0, 1, At, B1); PG8_BAR;
            PG8_LDA(At, 1, 1); PG8_STAGE(PG8_SA(1, 0), a3, voffA);
            PG8_BAR; PG8_WAIT_L(0); PG8_MMA(1, 0, At, B0); PG8_BAR; PG8_SCHED;
            PG8_STAGE(PG8_SB(1, 1), b3 + hstep, voffB);
            PG8_WAIT_V(6); PG8_BAR; PG8_MMA(1, 1, At, B1); PG8_BAR;
            }
        }
        if constexpr (ALIGN_EPI) { if (wr == 0) PG8_BAR; }
        if constexpr (!Epi::AFTER_DRAIN) { E(acc, cur, wr, wc, fr, fq); S.done(cur); }
        if (!has_next) break;
#pragma unroll
        for (int a = 0; a < 2; ++a)
#pragma unroll
            for (int b = 0; b < 2; ++b)
#pragma unroll
                for (int m = 0; m < 4; ++m)
#pragma unroll
                    for (int n = 0; n < 2; ++n) acc[a][b][m][n] = (f32x4){0.f, 0.f, 0.f, 0.f};
        cur = nxt; cA = nA; cB = nB; ++ui;
        if constexpr (ALIGN_EPI) { if (wr == 1) PG8_BAR; }
    }
    PG8_WAIT_V(0);
    if constexpr (!ALIGN_EPI) { if (wr == 0) PG8_BAR; }
    PG8_BAR;
    if constexpr (Epi::AFTER_DRAIN) { E.fused(acc, cur, wr, wc, fr, fq, lds, wid, lane); S.done(cur); }
#undef PG8_SA
#undef PG8_SB
#undef PG8_STAGE
#undef PG8_LDA
#undef PG8_LDB
#undef PG8_MMA
#undef PG8_WAIT_V
#undef PG8_WAIT_L
#undef PG8_BAR
#undef PG8_SCHED
}
}
constexpr int NB = 16, T = 2048, D = 2048, M = NB * T;
constexpr int N_IN0 = 8448;
constexpr size_t MiB = 1u << 20;
constexpr size_t WS_CTL = 0;
constexpr size_t WS_WIN0 = 2 * MiB, WS_WOUT0 = 35 * MiB, WS_WIN1 = 43 * MiB, WS_WOUT1 = 67 * MiB, WS_WG0 = 75 * MiB, WS_WG1 = 83 * MiB, WS_WP0 = 91 * MiB, WS_WP1 = 92 * MiB;
constexpr size_t WS_HBA = 96 * MiB, WS_PB = 224 * MiB, WS_G = 256 * MiB, WS_SMALL = 768 * MiB, WS_Z = 800 * MiB, WS_END = 928 * MiB;
constexpr int LDS_BYTES = 147456;
constexpr int NWAVES = 8;
typedef unsigned short bf16;
typedef short bf16x8 __attribute__((ext_vector_type(8)));
typedef float f32x4 __attribute__((ext_vector_type(4)));
typedef float f32x16 __attribute__((ext_vector_type(16)));
typedef unsigned u32x4 __attribute__((ext_vector_type(4)));
typedef unsigned u32x2 __attribute__((ext_vector_type(2)));
#define LAS __attribute__((address_space(3)))
#define LDS_WAIT() asm volatile("s_waitcnt lgkmcnt(0)" ::: "memory")
using pg8::cvt_pk_bf16; using pg8::bflo; using pg8::bfhi; using pg8::sigm;
constexpr float LOG2E = 1.4426950408889634f;

__device__ __forceinline__ int my_tid(int wave_s) { return wave_s * 64 + (int)__builtin_amdgcn_mbcnt_hi(~0u, __builtin_amdgcn_mbcnt_lo(~0u, 0u)); }
__device__ __forceinline__ float wave_sum(float v) {
#pragma unroll
    for (int o = 1; o < 64; o <<= 1) v += __shfl_xor(v, o);
    return v;
}
__device__ __forceinline__ float red16(float v) { v += __shfl_xor(v, 1); v += __shfl_xor(v, 2); v += __shfl_xor(v, 4); v += __shfl_xor(v, 8); return v; }

__device__ __forceinline__ void transpose_item(const float* W, int K, int Nsrc, int src_col0, int nvalid, const float* gk, bf16* WT, int dst_row0, float* scr, int kb, int lane) {
    const int k0 = 64 * kb, c = lane & 31;
#pragma unroll 8
    for (int i = 0; i < 32; ++i) { const int kk = 2 * i + (lane >> 5); float v = (c < nvalid) ? W[(size_t)(k0 + kk) * Nsrc + src_col0 + c] : 0.f; if (gk) v *= gk[k0 + kk]; scr[kk * 33 + c] = v; }
    LDS_WAIT();
    const int c8 = lane & 7;
#pragma unroll
    for (int j = 0; j < 4; ++j) { const int n = (lane >> 3) + 8 * j; const float* s = scr + (8 * c8) * 33 + n;
        u32x4 o; o.x = cvt_pk_bf16(s[0 * 33], s[1 * 33]); o.y = cvt_pk_bf16(s[2 * 33], s[3 * 33]); o.z = cvt_pk_bf16(s[4 * 33], s[5 * 33]); o.w = cvt_pk_bf16(s[6 * 33], s[7 * 33]);
        *(u32x4*)(WT + (size_t)(dst_row0 + n) * K + k0 + 8 * c8) = o; }
    LDS_WAIT();
}

struct Ptrs {
    const float *x, *p, *norm_pre, *norm_post, *ab_w_in, *fox_f_bias, *rwkv_mu, *rwkv_w0, *rwkv_w2, *rwkv_a0, *rwkv_a2, *rwkv_k_k, *rwkv_k_a, *rwkv_r_k, *rwkv_ln_g, *rwkv_ln_b,
        *ab_w_out, *c_w_in, *c_ln_g, *c_ln_b, *c_w_s, *c_b_s, *c_w_out, *ple_w_proj, *ple_w_gate;
    float* out; unsigned char* ws; int ph_lo, ph_hi;
};

__device__ __forceinline__ void p0_prologue(const Ptrs& P, unsigned char* lds, const int wave_s) {
    int tid_ = my_tid(wave_s); asm volatile("" : "+v"(tid_)); const int tid = tid_, lane = tid & 63, wave = tid >> 6;
    float* scr = (float*)(lds + wave * 16384);
    const int gw = blockIdx.x * NWAVES + wave, NGW = gridDim.x * NWAVES;
    unsigned char* ws = P.ws;
    if (blockIdx.x < 200) {
        const int c0 = blockIdx.x * 16, q = wave, cq = lane & 3, bb = lane >> 2;
        const float* xr = P.x + (size_t)bb * T * D + q * 256; const float* gq = P.norm_pre + q * 256; const float* Wq = P.ab_w_in + (size_t)(q * 256) * 8336 + 4112 + c0 + 4 * cq;
        f32x4 a0 = {0.f, 0.f, 0.f, 0.f}, a1 = a0, a2 = a0, a3 = a0;
#pragma unroll 2
        for (int k4 = 0; k4 < 64; ++k4) { const f32x4 gv = *(const f32x4*)(gq + 4 * k4);
            const f32x4 x0 = *(const f32x4*)(xr + 4 * k4) * gv, x1 = *(const f32x4*)(xr + D + 4 * k4) * gv, x2 = *(const f32x4*)(xr + 2 * D + 4 * k4) * gv, x3 = *(const f32x4*)(xr + 3 * D + 4 * k4) * gv;
#pragma unroll
            for (int e = 0; e < 4; ++e) { const f32x4 wv_ = *(const f32x4*)(Wq + (size_t)(4 * k4 + e) * 8336);
                a0 += x0[e] * wv_; a1 += x1[e] * wv_; a2 += x2[e] * wv_; a3 += x3[e] * wv_; } }
        { float* part = (float*)lds + (q * 64 + bb * 4) * 16 + 4 * cq;
          *(f32x4*)part = a0; *(f32x4*)(part + 16) = a1; *(f32x4*)(part + 32) = a2; *(f32x4*)(part + 48) = a3; }
        __syncthreads();
        float* EXG = (float*)(ws + WS_CTL + 0x100000);
#pragma unroll
        for (int o = tid * 2; o < tid * 2 + 2; ++o) { const int r2 = o >> 4, cc = o & 15; float v = 0.f;
#pragma unroll
            for (int w = 0; w < 8; ++w) v += ((const float*)lds)[(w * 64 + r2) * 16 + cc];
            EXG[(size_t)r2 * 3200 + c0 + cc] = v; }
        __syncthreads();
    }
    { float* z = (float*)(ws + WS_CTL) + M; for (int i = blockIdx.x * 512 + tid; i < 5 * M; i += gridDim.x * 512) z[i] = 0.f; }
    constexpr int I_IN0 = 32 * (N_IN0 / 32), I_SQ = 32 * 64, I_IN1 = 32 * 192, I_PJ = 4 * 64;
    constexpr int NITEMS = I_IN0 + I_SQ + I_IN1 + I_SQ + 2 * I_SQ + 2 * I_PJ;
    for (int it = gw; it < NITEMS; it += NGW) {
        int r = it;
        if (r < I_IN0) { const int nblk = N_IN0 / 32, kb = r / nblk, db = r % nblk; int src, nv = 32;
            if (db < 256) { const int grp = db >> 5; src = grp * 1024 + (grp >= 3 ? 16 : 0) + (grp == 7 ? 128 : 0) + (db & 31) * 32; }
            else if (db < 258) src = 7184 + (db - 256) * 32; else if (db < 260) src = 7248 + (db - 258) * 32; else if (db == 260) { src = 3072; nv = 16; } else { src = 0; nv = 0; }
            transpose_item(P.ab_w_in, 2048, 8336, src, nv, P.norm_pre, (bf16*)(ws + WS_WIN0), db * 32, scr, kb, lane); continue; } r -= I_IN0;
        if (r < I_SQ) { transpose_item(P.ab_w_out, 2048, 2048, (r % 64) * 32, 32, nullptr, (bf16*)(ws + WS_WOUT0), (r % 64) * 32, scr, r / 64, lane); continue; } r -= I_SQ;
        if (r < I_IN1) { transpose_item(P.c_w_in, 2048, 6144, (r % 192) * 32, 32, P.norm_pre + 2048, (bf16*)(ws + WS_WIN1), (r % 192) * 32, scr, r / 192, lane); continue; } r -= I_IN1;
        if (r < I_SQ) { transpose_item(P.c_w_out, 2048, 2048, (r % 64) * 32, 32, nullptr, (bf16*)(ws + WS_WOUT1), (r % 64) * 32, scr, r / 64, lane); continue; } r -= I_SQ;
        if (r < I_SQ) { transpose_item(P.ple_w_gate, 2048, 2048, (r % 64) * 32, 32, nullptr, (bf16*)(ws + WS_WG0), (r % 64) * 32, scr, r / 64, lane); continue; } r -= I_SQ;
        if (r < I_SQ) { transpose_item(P.ple_w_gate + (size_t)2048 * 2048, 2048, 2048, (r % 64) * 32, 32, nullptr, (bf16*)(ws + WS_WG1), (r % 64) * 32, scr, r / 64, lane); continue; } r -= I_SQ;
        if (r < I_PJ) { transpose_item(P.ple_w_proj, 256, 2048, (r % 64) * 32, 32, nullptr, (bf16*)(ws + WS_WP0), (r % 64) * 32, scr, r / 64, lane); continue; } r -= I_PJ;
        transpose_item(P.ple_w_proj + (size_t)256 * 2048, 256, 2048, (r % 64) * 32, 32, nullptr, (bf16*)(ws + WS_WP1), (r % 64) * 32, scr, r / 64, lane);
    }
    { float* ssq0 = (float*)(ws + WS_CTL); bf16* hb = (bf16*)(ws + WS_HBA);
      for (int row = gw; row < M; row += NGW) { const f32x4* xr = (const f32x4*)(P.x + (size_t)row * D) + lane; f32x4 v[8]; float s = 0.f;
#pragma unroll
          for (int j = 0; j < 8; ++j) { v[j] = xr[64 * j]; s += (v[j][0] * v[j][0] + v[j][1] * v[j][1]) + (v[j][2] * v[j][2] + v[j][3] * v[j][3]); }
          s = wave_sum(s); if (lane == 0) ssq0[row] = s;
          u32x2* o = (u32x2*)(hb + (size_t)row * D) + lane;
#pragma unroll
          for (int j = 0; j < 8; ++j) { u32x2 w; w.x = cvt_pk_bf16(v[j][0], v[j][1]); w.y = cvt_pk_bf16(v[j][2], v[j][3]); o[64 * j] = w; } } }
}

__device__ __forceinline__ void post_norm_phase(const float* hin, const bf16* Y, const float* ssq, const float* g, float* hout, bf16* hb, const int wave_s) {
    int tid_ = my_tid(wave_s); asm volatile("" : "+v"(tid_)); const int tid = tid_, lane = tid & 63, wave = tid >> 6;
    const int gw = blockIdx.x * NWAVES + wave, NGW = gridDim.x * NWAVES;
    f32x4 gv[8];
#pragma unroll
    for (int j = 0; j < 8; ++j) gv[j] = *((const f32x4*)g + lane + 64 * j);
    for (int row = gw; row < M; row += NGW) {
        const float rs = __builtin_amdgcn_rsqf(ssq[row] * (1.f / 2048.f) + 1e-6f);
        const f32x4* hr = (const f32x4*)(hin + (size_t)row * D) + lane; const u32x2* yr = (const u32x2*)(Y + (size_t)row * D) + lane;
        u32x2* ob = (u32x2*)(hb + (size_t)row * D) + lane;
#pragma unroll
        for (int j = 0; j < 8; ++j) { const f32x4 h = hr[64 * j]; const u32x2 y = yr[64 * j]; f32x4 o;
            o[0] = h[0] + bflo(y.x) * rs * gv[j][0]; o[1] = h[1] + bfhi(y.x) * rs * gv[j][1]; o[2] = h[2] + bflo(y.y) * rs * gv[j][2]; o[3] = h[3] + bfhi(y.y) * rs * gv[j][3];
            u32x2 w; w.x = cvt_pk_bf16(o[0], o[1]); w.y = cvt_pk_bf16(o[2], o[3]); ob[64 * j] = w; }
    }
}

__device__ __forceinline__ int crow(int r, int hi) { return (r & 3) + 8 * (r >> 2) + 4 * hi; }
__device__ __forceinline__ void attn_phase(unsigned char* lds, const bf16* Qg, const bf16* Kg, const bf16* Vg, const bf16* GAg, const float* small, const float* fbias, bf16* Z, const int wave_s) {
    int tid_ = my_tid(wave_s); asm volatile("" : "+v"(tid_)); const int tid = tid_, lane = tid & 63, wid = __builtin_amdgcn_readfirstlane(tid >> 6), r32 = lane & 31, hi = lane >> 5;
    float* c2 = (float*)lds;
    float* wtot = (float*)(lds + 8192);
    bf16* Ks = (bf16*)(lds + 8192 + 64);
    bf16* Vt = Ks + 64 * 72;
    for (int bh = blockIdx.x; bh < 256; bh += gridDim.x) {
        const int b = bh >> 4, h = bh & 15; const size_t rowbase = (size_t)b * T;
        __syncthreads();
        { float lf[4]; const float fb = fbias[h]; float run = 0.f;
#pragma unroll
          for (int i = 0; i < 4; ++i) { const float xg = small[(rowbase + 4 * tid + i) * 256 + 128 + h] + fb; const float ls = fminf(xg, 0.f) - log1pf(__expf(-fabsf(xg))); run += ls; lf[i] = run; }
          float sc = run;
#pragma unroll
          for (int o = 1; o < 64; o <<= 1) { const float t = __shfl_up(sc, o); if (lane >= o) sc += t; }
          if (lane == 63) wtot[wid] = sc;
          __syncthreads();
          float off = sc - run;
#pragma unroll
          for (int w = 0; w < 8; ++w) if (w < wid) off += wtot[w];
#pragma unroll
          for (int i = 0; i < 4; ++i) c2[4 * tid + i] = (off + lf[i]) * LOG2E; }
        __syncthreads();
        for (int qb = 0; qb < 8; ++qb) {
            const int q0w = qb * 256 + wid * 32, q = q0w + r32;
            bf16x8 qr[4];
#pragma unroll
            for (int d0 = 0; d0 < 4; ++d0) qr[d0] = *(const bf16x8*)(Qg + (rowbase + q) * 1024 + h * 64 + d0 * 16 + hi * 8);
            const float cq = c2[q];
            f32x16 o0, o1;
#pragma unroll
            for (int r = 0; r < 16; ++r) { o0[r] = 0.f; o1[r] = 0.f; }
            float mrow = -1e30f, l = 0.f;
            const int NT = qb * 4 + 4;
            const int kr = tid >> 3, ch = tid & 7, vr = lane, vc = wid;
            const bf16* kgp = Kg + (rowbase + kr) * 1024 + h * 64 + ch * 8; const bf16* vgp = Vg + (rowbase + vr) * 1024 + h * 64 + vc * 8;
            u32x4 kreg = *(const u32x4*)kgp, vreg = *(const u32x4*)vgp;
            for (int t = 0; t < NT; ++t) {
                asm volatile("s_waitcnt lgkmcnt(0)\n\ts_barrier" ::: "memory");
                { *(u32x4*)(Ks + kr * 72 + ch * 8) = kreg; bf16* vt = Vt + (vc * 8) * 72 + vr;
                  vt[0 * 72] = (bf16)(vreg.x & 0xffffu); vt[1 * 72] = (bf16)(vreg.x >> 16); vt[2 * 72] = (bf16)(vreg.y & 0xffffu); vt[3 * 72] = (bf16)(vreg.y >> 16);
                  vt[4 * 72] = (bf16)(vreg.z & 0xffffu); vt[5 * 72] = (bf16)(vreg.z >> 16); vt[6 * 72] = (bf16)(vreg.w & 0xffffu); vt[7 * 72] = (bf16)(vreg.w >> 16);
                  if (t + 1 < NT) { kreg = *(const u32x4*)(kgp + (size_t)(t + 1) * 64 * 1024); vreg = *(const u32x4*)(vgp + (size_t)(t + 1) * 64 * 1024); } }
                asm volatile("s_waitcnt lgkmcnt(0)\n\ts_barrier" ::: "memory");
                if (t * 64 <= q0w + 31) {
                    f32x16 p0, p1;
#pragma unroll
                    for (int r = 0; r < 16; ++r) { p0[r] = 0.f; p1[r] = 0.f; }
#pragma unroll
                    for (int d0 = 0; d0 < 4; ++d0) { const bf16x8 k0 = *(const bf16x8*)(Ks + r32 * 72 + d0 * 16 + hi * 8), k1 = *(const bf16x8*)(Ks + (32 + r32) * 72 + d0 * 16 + hi * 8);
                        p0 = __builtin_amdgcn_mfma_f32_32x32x16_bf16(k0, qr[d0], p0, 0, 0, 0); p1 = __builtin_amdgcn_mfma_f32_32x32x16_bf16(k1, qr[d0], p1, 0, 0, 0); }
                    const int kvb = t * 64 + 4 * hi;
#pragma unroll
                    for (int g4 = 0; g4 < 4; ++g4) { const f32x4 ca = *(const f32x4*)(c2 + kvb + 8 * g4), cb = *(const f32x4*)(c2 + kvb + 32 + 8 * g4);
#pragma unroll
                        for (int i = 0; i < 4; ++i) { p0[4 * g4 + i] += cq - ca[i]; p1[4 * g4 + i] += cq - cb[i]; } }
                    if (t * 64 + 63 > q0w) {
#pragma unroll
                        for (int r = 0; r < 16; ++r) { const int kv = kvb + (r & 3) + 8 * (r >> 2); if (kv > q) p0[r] = -1e30f; if (kv + 32 > q) p1[r] = -1e30f; } }
                    float mx = fmaxf(p0[0], p1[0]);
#pragma unroll
                    for (int r = 1; r < 16; ++r) mx = fmaxf(mx, fmaxf(p0[r], p1[r]));
                    mx = fmaxf(mx, __shfl_xor(mx, 32));
                    const float mnew = fmaxf(mrow, mx), alpha = __builtin_amdgcn_exp2f(mrow - mnew); mrow = mnew;
                    l *= alpha; float ls = 0.f;
#pragma unroll
                    for (int r = 0; r < 16; ++r) { o0[r] *= alpha; o1[r] *= alpha; p0[r] = __builtin_amdgcn_exp2f(p0[r] - mnew); p1[r] = __builtin_amdgcn_exp2f(p1[r] - mnew); ls += p0[r] + p1[r]; }
                    l += ls;
                    u32x4 pw[4];
#pragma unroll
                    for (int s = 0; s < 2; ++s) { pw[s].x = cvt_pk_bf16(p0[8 * s + 0], p0[8 * s + 1]); pw[s].y = cvt_pk_bf16(p0[8 * s + 2], p0[8 * s + 3]); pw[s].z = cvt_pk_bf16(p0[8 * s + 4], p0[8 * s + 5]); pw[s].w = cvt_pk_bf16(p0[8 * s + 6], p0[8 * s + 7]);
                        pw[2 + s].x = cvt_pk_bf16(p1[8 * s + 0], p1[8 * s + 1]); pw[2 + s].y = cvt_pk_bf16(p1[8 * s + 2], p1[8 * s + 3]); pw[2 + s].z = cvt_pk_bf16(p1[8 * s + 4], p1[8 * s + 5]); pw[2 + s].w = cvt_pk_bf16(p1[8 * s + 6], p1[8 * s + 7]); }
#pragma unroll
                    for (int s = 0; s < 4; ++s) { const bf16x8 pf = __builtin_bit_cast(bf16x8, pw[s]);
                        { const bf16* vp = Vt + r32 * 72 + 16 * s + 4 * hi; const u32x2 lo = *(const u32x2*)vp, hi2 = *(const u32x2*)(vp + 8); u32x4 va; va.x = lo.x; va.y = lo.y; va.z = hi2.x; va.w = hi2.y;
                          o0 = __builtin_amdgcn_mfma_f32_32x32x16_bf16(__builtin_bit_cast(bf16x8, va), pf, o0, 0, 0, 0); }
                        { const bf16* vp = Vt + (32 + r32) * 72 + 16 * s + 4 * hi; const u32x2 lo = *(const u32x2*)vp, hi2 = *(const u32x2*)(vp + 8); u32x4 va; va.x = lo.x; va.y = lo.y; va.z = hi2.x; va.w = hi2.y;
                          o1 = __builtin_amdgcn_mfma_f32_32x32x16_bf16(__builtin_bit_cast(bf16x8, va), pf, o1, 0, 0, 0); } }
                }
            }
            l += __shfl_xor(l, 32); const float inv = 1.f / l;
#pragma unroll
            for (int g4 = 0; g4 < 4; ++g4) {
                { const int d = 8 * g4 + 4 * hi; const u32x2 gg = *(const u32x2*)(GAg + (rowbase + q) * 1024 + h * 64 + d);
                  const float g0 = bflo(gg.x), g1 = bfhi(gg.x), g2 = bflo(gg.y), g3 = bfhi(gg.y); u32x2 w;
                  w.x = cvt_pk_bf16(o0[4 * g4 + 0] * inv * g0 * sigm(g0), o0[4 * g4 + 1] * inv * g1 * sigm(g1)); w.y = cvt_pk_bf16(o0[4 * g4 + 2] * inv * g2 * sigm(g2), o0[4 * g4 + 3] * inv * g3 * sigm(g3));
                  *(u32x2*)(Z + (rowbase + q) * 2048 + h * 64 + d) = w; }
                { const int d = 32 + 8 * g4 + 4 * hi; const u32x2 gg = *(const u32x2*)(GAg + (rowbase + q) * 1024 + h * 64 + d);
                  const float g0 = bflo(gg.x), g1 = bfhi(gg.x), g2 = bflo(gg.y), g3 = bfhi(gg.y); u32x2 w;
                  w.x = cvt_pk_bf16(o1[4 * g4 + 0] * inv * g0 * sigm(g0), o1[4 * g4 + 1] * inv * g1 * sigm(g1)); w.y = cvt_pk_bf16(o1[4 * g4 + 2] * inv * g2 * sigm(g2), o1[4 * g4 + 3] * inv * g3 * sigm(g3));
                  *(u32x2*)(Z + (rowbase + q) * 2048 + h * 64 + d) = w; }
            }
        }
    }
}
__device__ __forceinline__ float exp_fast(float x) { return __builtin_amdgcn_exp2f(1.4426950408889634f * x); }
__device__ __forceinline__ float softplusf_(float z) { return fmaxf(z, 0.f) + 0.6931471805599453f * __builtin_amdgcn_logf(1.0f + exp_fast(-fabsf(z))); }
__device__ __forceinline__ float tanh_fast(float x) { return 1.0f - 2.0f * __builtin_amdgcn_rcpf(1.0f + __builtin_amdgcn_exp2f(2.885390081777927f * x)); }
__device__ __forceinline__ void rwkv_phase(unsigned char* lds, const Ptrs& P, const bf16* Rg, const bf16* Kg, const bf16* Vg, const bf16* GBg, const float* small, bf16* Z, const int wave_s) {
    int tid_ = my_tid(wave_s); asm volatile("" : "+v"(tid_)); const int tid = tid_, lane = tid & 63, wv = __builtin_amdgcn_readfirstlane(tid >> 6);
#define RW_BAR() asm volatile("s_waitcnt lgkmcnt(0)\n\ts_barrier" ::: "memory")
    bf16* W2t = (bf16*)lds;
    bf16* A2t = W2t + 64 * 72;
    float* DL = (float*)lds + 4608;
    float* TW = DL + 4096;
    float* AL = TW + 2176;
    float* Rr = AL + 2176;
    float* Vv = Rr + 10240;
    float* Yb = Vv + 2048;
    float* red = Yb + 2048;
    float* Uu = red + 2048;
    float* CC = Uu + 1024;
    float* Cc = CC + 64;
    const int tt = tid >> 4, c4 = (tid & 15) * 4;
    for (int bh = blockIdx.x; bh < 256; bh += gridDim.x) {
        const int b = bh >> 4, h = bh & 15, hc = h * 64 + c4; const size_t rowbase = (size_t)b * T;
        __syncthreads();
        for (int i = tid; i < 4096; i += 512) { const int k = i >> 6, c = i & 63; W2t[c * 72 + k] = (bf16)(cvt_pk_bf16(P.rwkv_w2[(size_t)k * 1024 + h * 64 + c], 0.f) & 0xffffu); A2t[c * 72 + k] = (bf16)(cvt_pk_bf16(P.rwkv_a2[(size_t)k * 1024 + h * 64 + c], 0.f) & 0xffffu); }
        if (tid < 16) { const int cc = tid * 4, hcc = h * 64 + cc;
            *(f32x4*)(Cc + 0 * 64 + cc) = *(const f32x4*)(P.rwkv_mu + hcc); *(f32x4*)(Cc + 1 * 64 + cc) = *(const f32x4*)(P.rwkv_mu + 1024 + hcc); *(f32x4*)(Cc + 2 * 64 + cc) = *(const f32x4*)(P.rwkv_mu + 2048 + hcc);
            *(f32x4*)(Cc + 3 * 64 + cc) = *(const f32x4*)(P.rwkv_mu + 3072 + cc); *(f32x4*)(Cc + 4 * 64 + cc) = *(const f32x4*)(P.rwkv_mu + 3136 + cc);
            *(f32x4*)(Cc + 5 * 64 + cc) = *(const f32x4*)(P.rwkv_w0 + hcc); *(f32x4*)(Cc + 6 * 64 + cc) = *(const f32x4*)(P.rwkv_a0 + hcc); *(f32x4*)(Cc + 7 * 64 + cc) = *(const f32x4*)(P.rwkv_k_k + hcc);
            *(f32x4*)(Cc + 8 * 64 + cc) = *(const f32x4*)(P.rwkv_k_a + hcc); *(f32x4*)(Cc + 9 * 64 + cc) = *(const f32x4*)(P.rwkv_r_k + hcc); *(f32x4*)(Cc + 10 * 64 + cc) = *(const f32x4*)(P.rwkv_ln_g + hcc);
            *(f32x4*)(Cc + 11 * 64 + cc) = *(const f32x4*)(P.rwkv_ln_b + hcc); }
#define CV(k) (*(const f32x4*)(Cc + (k) * 64 + c4))
        f32x4 Sv[4];
#pragma unroll
        for (int g = 0; g < 4; ++g) Sv[g] = (f32x4){0.f, 0.f, 0.f, 0.f};
        { float* const EX = red; const float* exg = (const float*)(P.ws + WS_CTL + 0x100000) + (size_t)(b * 4) * 3200;
          for (int i = tid; i < 1280; i += 512) { const int q = i / 320, cc = i - q * 320; const int col = (cc < 192) ? ((cc >> 6) * 1024 + h * 64 + (cc & 63)) : (3072 + (cc - 192));
              EX[i] = exg[q * 3200 + col] * __builtin_amdgcn_rsqf(((const float*)(P.ws + WS_CTL))[rowbase + q] * (1.f / 2048.f) + 1e-6f); }
          __syncthreads(); }
        u32x2 n_rc, n_kc, n_vc, n_gg, n_rp = {0u, 0u}, n_kp = {0u, 0u}, n_vp = {0u, 0u}; f32x4 n_wl, n_al, n_wlp = {0.f, 0.f, 0.f, 0.f}, n_alp = {0.f, 0.f, 0.f, 0.f};
#define RW_FETCH(ckk) do { const size_t row_ = rowbase + (ckk) * 32 + tt; \
            n_rc = *(const u32x2*)(Rg + row_ * 1024 + hc); n_kc = *(const u32x2*)(Kg + row_ * 1024 + hc); n_vc = *(const u32x2*)(Vg + row_ * 1024 + hc); \
            n_wl = *(const f32x4*)(small + row_ * 256 + c4); n_al = *(const f32x4*)(small + row_ * 256 + 64 + c4); } while (0)
        RW_FETCH(0); n_gg = *(const u32x2*)(GBg + (rowbase + tt) * 1024 + hc);
#define RW_FETCH_PREV(rowp) do { n_rp = *(const u32x2*)(Rg + (rowp) * 1024 + hc); n_kp = *(const u32x2*)(Kg + (rowp) * 1024 + hc); n_vp = *(const u32x2*)(Vg + (rowp) * 1024 + hc); \
            n_wlp = *(const f32x4*)(small + (rowp) * 256 + c4); n_alp = *(const f32x4*)(small + (rowp) * 256 + 64 + c4); } while (0)
        if (tt > 0) RW_FETCH_PREV(rowbase + tt - 1);
        for (int ck = 0; ck < T / 32; ++ck) {
            const int t = ck * 32 + tt; const size_t row = rowbase + t;
            f32x4 rs, ks, vs;
            { const f32x4 mu_r = CV(0), mu_k = CV(1), mu_v = CV(2), mu_w = CV(3), mu_a = CV(4);
              const u32x2 rc = n_rc, kc = n_kc, vc = n_vc, rp = n_rp, kp = n_kp, vp = n_vp; f32x4 wl = n_wl, al = n_al, wlp = n_wlp, alp = n_alp;
              f32x4 rcf = {bflo(rc.x), bfhi(rc.x), bflo(rc.y), bfhi(rc.y)}, rpf = {bflo(rp.x), bfhi(rp.x), bflo(rp.y), bfhi(rp.y)};
              f32x4 kcf = {bflo(kc.x), bfhi(kc.x), bflo(kc.y), bfhi(kc.y)}, kpf = {bflo(kp.x), bfhi(kp.x), bflo(kp.y), bfhi(kp.y)};
              f32x4 vcf = {bflo(vc.x), bfhi(vc.x), bflo(vc.y), bfhi(vc.y)}, vpf = {bflo(vp.x), bfhi(vp.x), bflo(vp.y), bfhi(vp.y)};
              if (t < 4) { const float* ex = red + t * 320; rcf = *(const f32x4*)(ex + c4); kcf = *(const f32x4*)(ex + 64 + c4); vcf = *(const f32x4*)(ex + 128 + c4); wl = *(const f32x4*)(ex + 192 + c4); al = *(const f32x4*)(ex + 256 + c4);
                  if (t > 0) { const float* ep = ex - 320; rpf = *(const f32x4*)(ep + c4); kpf = *(const f32x4*)(ep + 64 + c4); vpf = *(const f32x4*)(ep + 128 + c4); wlp = *(const f32x4*)(ep + 192 + c4); alp = *(const f32x4*)(ep + 256 + c4); } }
              rs = rcf + (rpf - rcf) * mu_r; ks = kcf + (kpf - kcf) * mu_k; vs = vcf + (vpf - vcf) * mu_v;
              wl = wl + (wlp - wl) * mu_w; al = al + (alp - al) * mu_a;
              f32x4 tw; tw[0] = tanh_fast(wl[0]); tw[1] = tanh_fast(wl[1]); tw[2] = tanh_fast(wl[2]); tw[3] = tanh_fast(wl[3]);
              *(f32x4*)(TW + tt * 68 + c4) = tw; *(f32x4*)(AL + tt * 68 + c4) = al; }
            RW_BAR();
            float bon;
            if (wv < 4) { const int mat = wv >> 1, nt = wv & 1, r32 = lane & 31, hi5 = lane >> 5; const float* X = (mat ? AL : TW) + r32 * 68 + 8 * hi5; const bf16* Wt = (mat ? A2t : W2t) + (nt * 32 + r32) * 72 + 8 * hi5;
                f32x16 acc;
#pragma unroll
                for (int r = 0; r < 16; ++r) acc[r] = 0.f;
#pragma unroll
                for (int ks = 0; ks < 4; ++ks) { const f32x4 xa = *(const f32x4*)(X + 16 * ks), xb = *(const f32x4*)(X + 16 * ks + 4);
                    u32x4 ap; ap.x = cvt_pk_bf16(xa[0], xa[1]); ap.y = cvt_pk_bf16(xa[2], xa[3]); ap.z = cvt_pk_bf16(xb[0], xb[1]); ap.w = cvt_pk_bf16(xb[2], xb[3]);
                    const bf16x8 bp = *(const bf16x8*)(Wt + 16 * ks);
                    acc = __builtin_amdgcn_mfma_f32_32x32x16_bf16(__builtin_bit_cast(bf16x8, ap), bp, acc, 0, 0, 0); }
#pragma unroll
                for (int r = 0; r < 16; ++r) DL[mat * 2048 + ((r & 3) + 8 * (r >> 2) + 4 * hi5) * 64 + nt * 32 + r32] = acc[r]; }
            RW_BAR();
            { const f32x4 w0v = CV(5), a0v = CV(6), kkg = CV(7), kag = CV(8), rkg = CV(9); f32x4 wpre = w0v + *(const f32x4*)(DL + tt * 64 + c4), apre = a0v + *(const f32x4*)(DL + 2048 + tt * 64 + c4);
              f32x4 dec, av, kk, kp, bb; float ss = 0.f, bs = 0.f;
#pragma unroll
              for (int i = 0; i < 4; ++i) { const float wraw = -softplusf_(-wpre[i]) - 0.5f; dec[i] = exp_fast(-exp_fast(wraw)); av[i] = __builtin_amdgcn_rcpf(1.f + exp_fast(-apre[i])); kk[i] = ks[i] * kkg[i]; ss += kk[i] * kk[i]; }
              ss = red16(ss); const float inrm = __builtin_amdgcn_rsqf(fmaxf(ss, 1e-24f));
#pragma unroll
              for (int i = 0; i < 4; ++i) { kk[i] *= inrm; kp[i] = ks[i] * (1.f + (av[i] - 1.f) * kag[i]); bb[i] = kk[i] * av[i]; bs += rs[i] * kp[i] * rkg[i]; }
              bon = red16(bs);
              { float* pp = Rr + (tt >> 1) * 640 + (tt & 1) * 64 + c4;
                *(f32x4*)pp = rs; *(f32x4*)(pp + 128) = dec; *(f32x4*)(pp + 256) = kp; *(f32x4*)(pp + 384) = kk; *(f32x4*)(pp + 512) = bb; *(f32x4*)(Vv + tt * 64 + c4) = vs; } }
            RW_BAR();
            { const int p = tid >> 5, j2 = (tid & 31) * 2; float* pb = Rr + p * 640 + j2; typedef float f32x2v __attribute__((ext_vector_type(2)));
              const f32x2v r0 = *(const f32x2v*)pb, r1 = *(const f32x2v*)(pb + 64), w0 = *(const f32x2v*)(pb + 128), w1 = *(const f32x2v*)(pb + 192), k0 = *(const f32x2v*)(pb + 256), k1 = *(const f32x2v*)(pb + 320),
                            q0 = *(const f32x2v*)(pb + 384), q1 = *(const f32x2v*)(pb + 448), b0 = *(const f32x2v*)(pb + 512), b1 = *(const f32x2v*)(pb + 576);
              const f32x2v w1r1 = w1 * r1, B0 = b0 * w1, K0 = k0 * w1;
              *(f32x2v*)pb = q0; *(f32x2v*)(pb + 64) = w0 * q1; *(f32x2v*)(pb + 128) = w0 * r0; *(f32x2v*)(pb + 192) = w0 * w1r1;
              *(f32x2v*)(pb + 256) = w0 * w1; *(f32x2v*)(pb + 320) = B0; *(f32x2v*)(pb + 384) = K0; *(f32x2v*)(pb + 448) = b1; *(f32x2v*)(pb + 512) = k1;
              float d[8] = { b0.x * q1.x + b0.y * q1.y, k0.x * q1.x + k0.y * q1.y, b0.x * r0.x + b0.y * r0.y, k0.x * r0.x + k0.y * r0.y,
                             B0.x * r1.x + B0.y * r1.y, K0.x * r1.x + K0.y * r1.y, b1.x * r1.x + b1.y * r1.y, k1.x * r1.x + k1.y * r1.y };
              { const bool h16 = (lane & 16) != 0, h8 = (lane & 8) != 0, h4 = (lane & 4) != 0;
#pragma unroll
                for (int e = 0; e < 4; ++e) { const float snd = h16 ? d[e] : d[e + 4], kp_ = h16 ? d[e + 4] : d[e]; d[e] = kp_ + __shfl_xor(snd, 16); }
#pragma unroll
                for (int e = 0; e < 2; ++e) { const float snd = h8 ? d[e] : d[e + 2], kp_ = h8 ? d[e + 2] : d[e]; d[e] = kp_ + __shfl_xor(snd, 8); }
                { const float snd = h4 ? d[0] : d[1], kp_ = h4 ? d[1] : d[0]; d[0] = kp_ + __shfl_xor(snd, 4); }
                d[0] += __shfl_xor(d[0], 2); d[0] += __shfl_xor(d[0], 1);
                if ((lane & 3) == 0) Uu[p * 8 + (h16 ? 4 : 0) + (h8 ? 2 : 0) + (h4 ? 1 : 0)] = d[0]; } }
            RW_BAR();
            if (ck + 1 < T / 32) RW_FETCH(ck + 1);
            const int j0 = 16 * (wv & 3);
#define RW_LD16(dst, base) do { _Pragma("unroll") for (int g_ = 0; g_ < 4; ++g_) dst[g_] = *(const f32x4*)((base) + j0 + 4 * g_); } while (0)
#define RW_DOT16(x) ({ f32x4 a_ = Sv[0] * x[0] + Sv[1] * x[1] + Sv[2] * x[2] + Sv[3] * x[3]; (a_[0] + a_[1]) + (a_[2] + a_[3]); })
#pragma unroll 1
            for (int p = 0; p < 16; ++p) {
                const int par = (p & 1) * 1024; const float* pb = Rr + p * 640; const float* sc = Uu + p * 8;
                if (wv < 4) {
                    { f32x4 d0[4], d1[4], d2[4], d3[4]; RW_LD16(d0, pb); RW_LD16(d1, pb + 64); RW_LD16(d2, pb + 128); RW_LD16(d3, pb + 192);
                      red[par + wv * 64 + lane] = RW_DOT16(d0); red[par + 256 + wv * 64 + lane] = RW_DOT16(d1); red[par + 512 + wv * 64 + lane] = RW_DOT16(d2); red[par + 768 + wv * 64 + lane] = RW_DOT16(d3); }
                    asm volatile("" ::: "memory");
                    f32x4 u0[4], u1[4], u2[4], u3[4], u4[4]; RW_LD16(u0, pb + 256); RW_LD16(u1, pb + 320); RW_LD16(u2, pb + 384); RW_LD16(u3, pb + 448); RW_LD16(u4, pb + 512);
                    const float v0 = Vv[(2 * p) * 64 + lane], v1 = Vv[(2 * p + 1) * 64 + lane], c1 = sc[0], c2 = sc[1];
                    RW_BAR();
                    const float sa0 = (red[par + lane] + red[par + 64 + lane]) + (red[par + 128 + lane] + red[par + 192 + lane]);
                    const float q = (red[par + 256 + lane] + red[par + 320 + lane]) + (red[par + 384 + lane] + red[par + 448 + lane]);
                    const float sa1 = q - sa0 * c1 + v0 * c2;
#pragma unroll
                    for (int g = 0; g < 4; ++g) Sv[g] = Sv[g] * u0[g] - sa0 * u1[g] + v0 * u2[g] - sa1 * u3[g] + v1 * u4[g];
                } else {
                    RW_BAR();
                    if (wv < 6) {
                        const float v0 = Vv[(2 * p) * 64 + lane];
                        const float sa0 = (red[par + lane] + red[par + 64 + lane]) + (red[par + 128 + lane] + red[par + 192 + lane]);
                        if (wv == 4) { const float y0 = (red[par + 512 + lane] + red[par + 576 + lane]) + (red[par + 640 + lane] + red[par + 704 + lane]);
                            Yb[(2 * p) * 64 + lane] = y0 - sa0 * sc[2] + v0 * sc[3]; }
                        else { const float v1 = Vv[(2 * p + 1) * 64 + lane];
                            const float q = (red[par + 256 + lane] + red[par + 320 + lane]) + (red[par + 384 + lane] + red[par + 448 + lane]);
                            const float sa1 = q - sa0 * sc[0] + v0 * sc[1];
                            const float y1 = (red[par + 768 + lane] + red[par + 832 + lane]) + (red[par + 896 + lane] + red[par + 960 + lane]);
                            Yb[(2 * p + 1) * 64 + lane] = y1 - sa0 * sc[4] + v0 * sc[5] - sa1 * sc[6] + v1 * sc[7]; } }
                    else if (p == 0) {
                        const size_t i8 = ((size_t)((blockIdx.x * 2 + (wv - 6)) * 64 + ck)) * 64 + lane;
                        const f32x4 pa = *(const f32x4*)(P.p + i8 * 8), pq = *(const f32x4*)(P.p + i8 * 8 + 4);
                        *(u32x4*)((bf16*)(P.ws + WS_PB) + i8 * 8) = pg8::pack8(pa, pq); } }
            }
            if (ck + 1 < T / 32) RW_FETCH_PREV(row + 31);
            RW_BAR();
#undef RW_LD16
#undef RW_BAR
#undef RW_DOT16
            { const f32x4 lng = CV(10), lnb = CV(11); const f32x4 y4 = *(const f32x4*)(Yb + tt * 64 + c4); const float mean = red16((y4[0] + y4[1]) + (y4[2] + y4[3])) * (1.f / 64.f);
              const f32x4 d = y4 - mean; const float var = red16((d[0] * d[0] + d[1] * d[1]) + (d[2] * d[2] + d[3] * d[3])) * (1.f / 64.f); const float rstd = __builtin_amdgcn_rsqf(var + 64e-5f);
              const u32x2 gg = n_gg; if (ck + 1 < T / 32) n_gg = *(const u32x2*)(GBg + (row + 32) * 1024 + hc);
              const float g0 = bflo(gg.x), g1 = bfhi(gg.x), g2 = bflo(gg.y), g3 = bfhi(gg.y);
              const float z0 = (d[0] * rstd * lng[0] + lnb[0] + bon * vs[0]) * g0 * sigm(g0), z1 = (d[1] * rstd * lng[1] + lnb[1] + bon * vs[1]) * g1 * sigm(g1);
              const float z2 = (d[2] * rstd * lng[2] + lnb[2] + bon * vs[2]) * g2 * sigm(g2), z3 = (d[3] * rstd * lng[3] + lnb[3] + bon * vs[3]) * g3 * sigm(g3);
              u32x2 w; w.x = cvt_pk_bf16(z0, z1); w.y = cvt_pk_bf16(z2, z3); *(u32x2*)(Z + row * 2048 + 1024 + hc) = w; }
        }
    }
}

#undef RW_FETCH
#undef RW_FETCH_PREV
#undef CV
__device__ __forceinline__ void gmlp_phase(unsigned char* lds, const Ptrs& P, const bf16* Ug, const bf16* Vg, const bf16* Gg, const float* vsum, const float* vsq, bf16* Z, const int wave_s) {
    int tid_ = my_tid(wave_s); asm volatile("" : "+v"(tid_)); const int tid = tid_, lane = tid & 63, wid = __builtin_amdgcn_readfirstlane(tid >> 6), r32 = lane & 31, hi = lane >> 5;
    bf16* As = (bf16*)lds;
    bf16* Bt = As + 128 * 136;
    float* Ds = (float*)(lds + 2 * 128 * 136 * 2 + 256);
    int gcur = -1;
    for (int u = blockIdx.x; u < 4096; u += gridDim.x) {
        const int g = u & 15, bn = u >> 4; const size_t row0 = (size_t)bn * 128; const int C0 = g * 128;
        __syncthreads();
        if (g != gcur) { gcur = g; const float* ws_ = P.c_w_s + (size_t)g * 128 * 128;
            for (int i = tid; i < 128 * 128 / 4; i += 512) { const int t = i >> 5, s4 = (i & 31) * 4; f32x4 w = *(const f32x4*)(ws_ + t * 128 + s4);
                u32x2 o; o.x = cvt_pk_bf16(s4 + 0 <= t ? w[0] : 0.f, s4 + 1 <= t ? w[1] : 0.f); o.y = cvt_pk_bf16(s4 + 2 <= t ? w[2] : 0.f, s4 + 3 <= t ? w[3] : 0.f); *(u32x2*)(As + t * 136 + s4) = o; } }
#pragma unroll
        for (int it = 0; it < 4; ++it) { const int i = tid + it * 512, s = i >> 4, c8 = (i & 15) * 8; const size_t row = row0 + s;
            const float mean = vsum[row] * (1.f / 2048.f), var = vsq[row] * (1.f / 2048.f) - mean * mean, rstd = __builtin_amdgcn_rsqf(fmaxf(var, 0.f) + 1e-5f);
            const u32x4 vv = *(const u32x4*)(Vg + row * 2048 + C0 + c8); const f32x4 lg0 = *(const f32x4*)(P.c_ln_g + C0 + c8), lg1 = *(const f32x4*)(P.c_ln_g + C0 + c8 + 4), lb0 = *(const f32x4*)(P.c_ln_b + C0 + c8), lb1 = *(const f32x4*)(P.c_ln_b + C0 + c8 + 4);
            float x[8] = {bflo(vv.x), bfhi(vv.x), bflo(vv.y), bfhi(vv.y), bflo(vv.z), bfhi(vv.z), bflo(vv.w), bfhi(vv.w)};
#pragma unroll
            for (int j = 0; j < 8; ++j) { const float gn = (x[j] - mean) * rstd * (j < 4 ? lg0[j & 3] : lg1[j & 3]) + (j < 4 ? lb0[j & 3] : lb1[j & 3]); const float nb = __shfl_xor(gn, 0); (void)nb;
                Bt[(c8 + j) * 136 + (c8 >> 3) * 8 + s] = (bf16)(cvt_pk_bf16(gn, 0.f) & 0xffffu); } }
        __syncthreads();
        { const int tb = wid >> 1, cb = (wid & 1) * 64; f32x16 d0, d1;
#pragma unroll
          for (int r = 0; r < 16; ++r) { d0[r] = 0.f; d1[r] = 0.f; }
          for (int k = 0; k <= 2 * tb + 1; ++k) {
              const bf16x8 a = *(const bf16x8*)(As + (32 * tb + r32) * 136 + 16 * k + 8 * hi);
              const bf16x8 b0 = *(const bf16x8*)(Bt + (cb + r32) * 136 + ((cb + r32) >> 3) * 8 + 16 * k + 8 * hi), b1 = *(const bf16x8*)(Bt + (cb + 32 + r32) * 136 + ((cb + 32 + r32) >> 3) * 8 + 16 * k + 8 * hi);
              d0 = __builtin_amdgcn_mfma_f32_32x32x16_bf16(a, b0, d0, 0, 0, 0); d1 = __builtin_amdgcn_mfma_f32_32x32x16_bf16(a, b1, d1, 0, 0, 0); }
#pragma unroll
          for (int r = 0; r < 16; ++r) { const int t = 32 * tb + crow(r, hi); Ds[t * 132 + cb + r32] = d0[r]; Ds[t * 132 + cb + 32 + r32] = d1[r]; } }
        __syncthreads();
#pragma unroll
        for (int it = 0; it < 4; ++it) { const int i = tid + it * 512, t = i >> 4, c8 = (i & 15) * 8; const size_t off = (row0 + t) * 2048 + C0 + c8;
            const float bs = P.c_b_s[g * 128 + t]; const u32x4 uu = *(const u32x4*)(Ug + off), gg = *(const u32x4*)(Gg + off);
            const f32x4 da = *(const f32x4*)(Ds + t * 132 + c8), db = *(const f32x4*)(Ds + t * 132 + c8 + 4); u32x4 o;
            o.x = cvt_pk_bf16(bflo(uu.x) * (da[0] + bs) * bflo(gg.x), bfhi(uu.x) * (da[1] + bs) * bfhi(gg.x)); o.y = cvt_pk_bf16(bflo(uu.y) * (da[2] + bs) * bflo(gg.y), bfhi(uu.y) * (da[3] + bs) * bfhi(gg.y));
            o.z = cvt_pk_bf16(bflo(uu.z) * (db[0] + bs) * bflo(gg.z), bfhi(uu.z) * (db[1] + bs) * bfhi(gg.z)); o.w = cvt_pk_bf16(bflo(uu.w) * (db[2] + bs) * bflo(gg.w), bfhi(uu.w) * (db[3] + bs) * bfhi(gg.w));
            *(u32x4*)(Z + off) = o; }
    }
}

__global__ void __launch_bounds__(512, 2) mega_fwd(Ptrs P) {
    extern __shared__ __attribute__((aligned(16))) unsigned char lds[];
    cg::grid_group grid = cg::this_grid();
    const int wave_s = __builtin_amdgcn_readfirstlane((int)threadIdx.x >> 6);
    unsigned char* ws = P.ws;
    float* ctl = (float*)(ws + WS_CTL);
    float *ssq0 = ctl, *ssqA = ctl + M, *ssqB = ctl + 2 * M, *ssqC = ctl + 3 * M, *vsum = ctl + 4 * M, *vsq = ctl + 5 * M;
    bf16* G = (bf16*)(ws + WS_G); const size_t GS = (size_t)M * 1024;
    bf16* HBA = (bf16*)(ws + WS_HBA); bf16* PB = (bf16*)(ws + WS_PB); float* SMALL = (float*)(ws + WS_SMALL); bf16* Zb = (bf16*)(ws + WS_Z);
    bf16* Y0 = G; bf16* PP0 = G + 2 * GS; bf16* HBB = G + 6 * GS;
    bf16* U_u = G; bf16* U_v = G + 2 * GS; bf16* U_g = G + 4 * GS;
    bf16* Y1 = G + 6 * GS; bf16* PP1 = G;
    const int lo = P.ph_lo, hi = P.ph_hi;
    PG8_LAS unsigned char* lds3 = (PG8_LAS unsigned char*)lds;
#define IN(k) (lo <= (k) && (k) < hi)
    unsigned* const gbar = (unsigned*)(ws + WS_CTL + 0x1F0000);
#define SEAM(k) do { if (IN(k) && IN((k) + 1)) { if ((k) == 0) grid.sync(); else { \
        asm volatile("s_waitcnt vmcnt(0) lgkmcnt(0)" ::: "memory"); __syncthreads(); \
        if (my_tid(wave_s) == 0) { __builtin_amdgcn_fence(__ATOMIC_RELEASE, "agent"); asm volatile("s_waitcnt vmcnt(0)" ::: "memory"); \
            __hip_atomic_fetch_add(gbar, 1u, __ATOMIC_RELAXED, __HIP_MEMORY_SCOPE_AGENT); \
            while (__hip_atomic_load(gbar, __ATOMIC_RELAXED, __HIP_MEMORY_SCOPE_AGENT) < 256u * (unsigned)(k)) __builtin_amdgcn_s_sleep(4); \
            __builtin_amdgcn_fence(__ATOMIC_ACQUIRE, "agent"); asm volatile("s_waitcnt vmcnt(0)" ::: "memory"); } \
        __syncthreads(); } } } while (0)
    if (IN(0)) { p0_prologue(P, lds, wave_s); } SEAM(0);
    if (IN(1)) { pg8::Gemm g{HBA, (const bf16*)(ws + WS_WIN0), M, N_IN0, 2048}; pg8::StaticOrder S; S.init(M, N_IN0, gridDim.x, blockIdx.x);
        pg8::EpiIn0 E{G, SMALL, ssq0, 0.125f * LOG2E}; pg8::gemm_phase<pg8::EpiIn0, pg8::StaticOrder, true, true>(lds3, g, S, E, my_tid(wave_s)); } SEAM(1);
    if (IN(2)) { attn_phase(lds, G, G + GS, G + 2 * GS, G + 3 * GS, SMALL, P.fox_f_bias, Zb, wave_s);
        rwkv_phase(lds, P, G + 4 * GS, G + 5 * GS, G + 6 * GS, G + 7 * GS, SMALL, Zb, wave_s); } SEAM(2);
    if (IN(3)) { { pg8::Gemm g{Zb, (const bf16*)(ws + WS_WOUT0), M, 2048, 2048}; pg8::StaticOrder S; S.init(M, 2048, gridDim.x, blockIdx.x);
          pg8::EpiY E{Y0, ssqA}; pg8::gemm_phase<pg8::EpiY, pg8::StaticOrder, true, true>(lds3, g, S, E, my_tid(wave_s)); }
        { pg8::Gemm g{PB, (const bf16*)(ws + WS_WP0), M, 2048, 256}; pg8::StaticOrder S; S.init(M, 2048, gridDim.x, blockIdx.x);
          pg8::EpiBf16<0> E{PP0, 2048, nullptr, 0, 0, 1.f}; pg8::gemm_phase<pg8::EpiBf16<0>, pg8::StaticOrder, true, true>(lds3, g, S, E, my_tid(wave_s)); } } SEAM(3);
    if (IN(4)) { post_norm_phase(P.x, Y0, ssqA, P.norm_post, P.out, HBA, wave_s); } SEAM(4);
    if (IN(5)) { pg8::Gemm g{HBA, (const bf16*)(ws + WS_WG0), M, 2048, 2048}; pg8::StaticOrder S; S.init(M, 2048, gridDim.x, blockIdx.x);
        pg8::EpiGate E{P.x, P.out, Y0, ssqA, P.norm_post, PP0, HBB, ssqB}; pg8::gemm_phase<pg8::EpiGate, pg8::StaticOrder, true, true>(lds3, g, S, E, my_tid(wave_s)); } SEAM(5);
    if (IN(6)) { pg8::Gemm g{HBB, (const bf16*)(ws + WS_WIN1), M, 6144, 2048}; pg8::StaticOrder S; S.init(M, 6144, gridDim.x, blockIdx.x);
        pg8::EpiC E{U_u, 2 * GS, ssqB, vsum, vsq}; pg8::gemm_phase<pg8::EpiC, pg8::StaticOrder, true, true>(lds3, g, S, E, my_tid(wave_s)); } SEAM(6);
    if (IN(7)) { gmlp_phase(lds, P, U_u, U_v, U_g, vsum, vsq, Zb, wave_s); } SEAM(7);
    if (IN(8)) { { pg8::Gemm g{Zb, (const bf16*)(ws + WS_WOUT1), M, 2048, 2048}; pg8::StaticOrder S; S.init(M, 2048, gridDim.x, blockIdx.x);
          pg8::EpiY E{Y1, ssqC}; pg8::gemm_phase<pg8::EpiY, pg8::StaticOrder, true, true>(lds3, g, S, E, my_tid(wave_s)); }
        { pg8::Gemm g{PB + (size_t)M * 256, (const bf16*)(ws + WS_WP1), M, 2048, 256}; pg8::StaticOrder S; S.init(M, 2048, gridDim.x, blockIdx.x);
          pg8::EpiBf16<0> E{PP1, 2048, nullptr, 0, 0, 1.f}; pg8::gemm_phase<pg8::EpiBf16<0>, pg8::StaticOrder, true, true>(lds3, g, S, E, my_tid(wave_s)); } } SEAM(8);
    if (IN(9)) { post_norm_phase(P.out, Y1, ssqC, P.norm_post + 2048, P.out, HBA, wave_s); } SEAM(9);
    if (IN(10)) { pg8::Gemm g{HBA, (const bf16*)(ws + WS_WG1), M, 2048, 2048}; pg8::StaticOrder S; S.init(M, 2048, gridDim.x, blockIdx.x);
        pg8::EpiGate E{P.out, P.out, Y1, ssqC, P.norm_post + 2048, PP1, nullptr, nullptr}; pg8::gemm_phase<pg8::EpiGate, pg8::StaticOrder, true, true>(lds3, g, S, E, my_tid(wave_s)); }
#undef IN
#undef SEAM
}

#ifndef MK_PER_PHASE
#define MK_PER_PHASE 0
#endif
constexpr int N_PHASES = 11;
extern "C" void kernel_launch(void* const* d_in, const int* in_sizes, int n_in, void* d_out, int out_size, void* d_ws, size_t ws_size, hipStream_t stream) {
    static int grid = 0;
    if (grid == 0) {
        if (n_in != 25 || ws_size < WS_END) { fprintf(stderr, "kernel_launch: need 25 inputs and %zu bytes of workspace (got %d, %zu)\n", (size_t)WS_END, n_in, ws_size); grid = -1; return; }
        int dev = 0, cus = 0, per_cu = 0;
        hipGetDevice(&dev); hipDeviceGetAttribute(&cus, hipDeviceAttributeMultiprocessorCount, dev);
        if (hipFuncSetAttribute((const void*)mega_fwd, hipFuncAttributeMaxDynamicSharedMemorySize, LDS_BYTES) != hipSuccess) { fprintf(stderr, "kernel_launch: hipFuncSetAttribute failed\n"); grid = -1; return; }
        hipOccupancyMaxActiveBlocksPerMultiprocessor(&per_cu, (const void*)mega_fwd, 512, LDS_BYTES);
        (void)hipGetLastError();
        if (per_cu < 1) { fprintf(stderr, "kernel_launch: occupancy query says %d blocks per CU\n", per_cu); per_cu = 1; }
        if (cus < 256) { fprintf(stderr, "kernel_launch: built for a 256-CU device (got %d CUs)\n", cus); grid = -1; return; }
        grid = 256;
    }
    if (grid < 0) return;
    (void)hipMemsetAsync((char*)d_ws + WS_CTL + 0x1F0000, 0, 256, stream);
    Ptrs p{};
    const float** pp = (const float**)&p;
    for (int i = 0; i < 25; ++i) pp[i] = (const float*)d_in[i];
    p.out = (float*)d_out; p.ws = (unsigned char*)d_ws;
#if MK_PER_PHASE
    for (int k = 0; k < N_PHASES; ++k) { p.ph_lo = k; p.ph_hi = k + 1; hipLaunchKernelGGL(mega_fwd, dim3(grid), dim3(512), LDS_BYTES, stream, p); }
#else
    p.ph_lo = 0; p.ph_hi = N_PHASES;
    void* args[] = {&p};
    hipError_t e = hipLaunchCooperativeKernel((const void*)mega_fwd, dim3(grid), dim3(512), args, LDS_BYTES, stream);
    if (e != hipSuccess) fprintf(stderr, "cooperative launch failed: %s (grid %d)\n", hipGetErrorString(e), grid);
#endif
}
```

```cpp
#include <hip/hip_runtime.h>
#include <hip/hip_cooperative_groups.h>
#include <cstdio>
#include <cstdint>
namespace cg = cooperative_groups;
namespace pg8 {
#define PG8_LAS __attribute__((address_space(3)))
typedef unsigned short bf16_t;
typedef short bf16x8 __attribute__((ext_vector_type(8)));
typedef float f32x4 __attribute__((ext_vector_type(4)));
typedef unsigned u32x4 __attribute__((ext_vector_type(4)));
constexpr int BM = 256, BK = 64, HALF = 128, HTB = HALF * BK * 2  , STAGE_BYTES = 8 * HTB, NXCD = 8, WGM = 8;

__host__ __device__ __forceinline__ int lds_byte(int r, int c) { const int st = (r >> 4) * 2 + (c >> 5), rr = r & 15, cc = c & 31, ob = rr * 64 + cc * 2; return st * 1024 + (ob ^ (((ob >> 9) & 1) << 5)); }
__host__ __device__ __forceinline__ void stage_rc(int b, int& R, int& C) { const int st = b / 1024, sb = b % 1024, swz = sb ^ (((sb >> 9) & 1) << 5); R = (st >> 1) * 16 + swz / 64; C = (st & 1) * 32 + (swz % 64) / 2; }
__host__ __device__ __forceinline__ int perm32(int rho) { const int n = rho >> 4, i = rho & 15; return 8 * (i >> 2) + 4 * n + (i & 3); }

struct Unit { int pm, pn; };
struct Gemm { const bf16_t* A; const bf16_t* Bt; int M, N, K; };

struct StaticOrder {
    int nM, nN, nwg, G, c;
    __host__ __device__ void init(int M, int N, int G_, int c_) { nM = M / BM; nN = N / BM; nwg = nM * nN; G = G_; c = c_; }
    __host__ __device__ bool next(int i, Unit& u) const {
        const long L = (long)i * G + c; if (L >= nwg) return false;
        int wgid = (int)L; { const int q = nwg / NXCD, r = nwg % NXCD, xcd = wgid % NXCD, off = wgid / NXCD; wgid = (xcd < r ? xcd * (q + 1) : r * (q + 1) + (xcd - r) * q) + off; }
        const int nig = WGM * nN, gid = wgid / nig, fm = gid * WGM, gsz = (nM - fm) < WGM ? (nM - fm) : WGM;
        u.pm = fm + ((wgid % nig) % gsz); u.pn = (wgid % nig) / gsz; return true;
    }
    __device__ __forceinline__ void a_ready(const Unit&) const {}
    __device__ __forceinline__ void done(const Unit&) const {}
};

__device__ __forceinline__ unsigned cvt_pk_bf16(float lo, float hi) { unsigned r; asm volatile("v_cvt_pk_bf16_f32 %0, %1, %2" : "=v"(r) : "v"(lo), "v"(hi)); return r; }
typedef float f32x2 __attribute__((ext_vector_type(2)));
__device__ __forceinline__ f32x2 gelu_pk(f32x2 v) {
    const f32x2 av = __builtin_elementwise_abs(v), d = av * 0.2316418882f + 1.0f;
    f32x2 t; t.x = __builtin_amdgcn_rcpf(d.x); t.y = __builtin_amdgcn_rcpf(d.y);
    f32x2 q = t * 0.5307027145f + (-0.7265760135f); q = q * t + 0.7107068705f; q = q * t + (-0.142248368f); q = q * t + 0.127414796f; q = q * t;
    const f32x2 s = (v * v) * (-0.72134752044f);
    f32x2 e; e.x = __builtin_amdgcn_exp2f(s.x); e.y = __builtin_amdgcn_exp2f(s.y);
    const f32x2 m = v * (q * e), r = v - m;
    f32x2 o; o.x = v.x < 0.f ? m.x : r.x; o.y = v.y < 0.f ? m.y : r.y; return o;
}
template <int ACT  > struct EpiBf16 {
    static constexpr bool PERM = true, AFTER_DRAIN = false; static_assert(ACT == 0 || ACT == 1, "EpiBf16: ACT is 0 (none) or 1 (gelu_pk)");
    bf16_t* O; int ldc; const float* bias; int split_cols; size_t split_stride; float scale0;
    __device__ __forceinline__ void operator()(const f32x4 (&acc)[2][2][4][2], const Unit& u, int wr, int wc, int fr, int fq) const {
        const int row0 = u.pm * BM + wr * 64 + fr; int colt = u.pn * BM; bf16_t* base = O;
        float sc = 1.f; if (split_cols) { const int t = colt / split_cols; base += (size_t)t * split_stride; colt -= t * split_cols; if (t == 0) sc = scale0; }
        const int col0 = colt + wc * 32 + 8 * fq, bcol0 = u.pn * BM + wc * 32 + 8 * fq;
        f32x4 bv[2][2];
#pragma unroll
        for (int bj = 0; bj < 2; ++bj)
#pragma unroll
            for (int n = 0; n < 2; ++n) bv[bj][n] = bias ? *(const f32x4*)(bias + bcol0 + bj * HALF + 4 * n) : (f32x4){0.f, 0.f, 0.f, 0.f};
#pragma unroll
        for (int ai = 0; ai < 2; ++ai)
#pragma unroll
            for (int m = 0; m < 4; ++m) { bf16_t* rowp = base + (size_t)(row0 + ai * HALF + m * 16) * ldc + col0;
#pragma unroll
                for (int bj = 0; bj < 2; ++bj) { f32x4 v0 = acc[ai][bj][m][0] + bv[bj][0], v1 = acc[ai][bj][m][1] + bv[bj][1];
                    if (ACT == 1) { f32x2 a = gelu_pk((f32x2){v0[0], v0[1]}), b = gelu_pk((f32x2){v0[2], v0[3]}), c = gelu_pk((f32x2){v1[0], v1[1]}), d = gelu_pk((f32x2){v1[2], v1[3]});
                        v0 = (f32x4){a.x, a.y, b.x, b.y}; v1 = (f32x4){c.x, c.y, d.x, d.y}; }
                    v0 = v0 * sc; v1 = v1 * sc; u32x4 w; w.x = cvt_pk_bf16(v0[0], v0[1]); w.y = cvt_pk_bf16(v0[2], v0[3]); w.z = cvt_pk_bf16(v1[0], v1[1]); w.w = cvt_pk_bf16(v1[2], v1[3]);
                    *(u32x4*)(rowp + bj * HALF) = w; } }
    }
};
__device__ __forceinline__ u32x4 pack8(const f32x4 v0, const f32x4 v1) { u32x4 w; w.x = cvt_pk_bf16(v0[0], v0[1]); w.y = cvt_pk_bf16(v0[2], v0[3]); w.z = cvt_pk_bf16(v1[0], v1[1]); w.w = cvt_pk_bf16(v1[2], v1[3]); return w; }
__device__ __forceinline__ float bflo(unsigned u) { return __uint_as_float(u << 16); }
__device__ __forceinline__ float bfhi(unsigned u) { return __uint_as_float(u & 0xffff0000u); }
__device__ __forceinline__ float sigm(float x) { return __builtin_amdgcn_rcpf(1.0f + __builtin_amdgcn_exp2f(-1.4426950408889634f * x)); }
#define PG8_FOR_AI_M _Pragma("unroll") for (int ai = 0; ai < 2; ++ai) _Pragma("unroll") for (int m = 0; m < 4; ++m)
struct EpiIn0 {
    static constexpr bool PERM = true, AFTER_DRAIN = false;
    bf16_t* G; float* small; const float* ssq; float qscale;
    __device__ __forceinline__ void operator()(const f32x4 (&acc)[2][2][4][2], const Unit& u, int wr, int wc, int fr_, int fq_) const {
        int fr = fr_, fq = fq_; asm volatile("" : "+v"(fr), "+v"(fq));
        const int row0 = u.pm * BM + wr * 64 + fr, ct = wc * 32 + 8 * fq;
        float rsv[2][4];
        PG8_FOR_AI_M rsv[ai][m] = __builtin_amdgcn_rsqf(ssq[row0 + ai * HALF + m * 16] * (1.f / 2048.f) + 1e-6f);
        if (u.pn < 32) {
            const int grp = u.pn >> 2; bf16_t* base = G + (size_t)grp * ((size_t)32768 * 1024) + (u.pn & 3) * 256 + ct; const float sc0 = (grp == 0) ? qscale : 1.f;
            PG8_FOR_AI_M { const int row = row0 + ai * HALF + m * 16; const float rs = rsv[ai][m] * sc0; bf16_t* rp = base + (size_t)row * 1024;
#pragma unroll
                for (int bj = 0; bj < 2; ++bj) *(u32x4*)(rp + bj * HALF) = pack8(acc[ai][bj][m][0] * rs, acc[ai][bj][m][1] * rs); }
        } else {
            PG8_FOR_AI_M { const int row = row0 + ai * HALF + m * 16; const float rs = rsv[ai][m]; float* rp = small + (size_t)row * 256 + ct;
#pragma unroll
                for (int bj = 0; bj < 2; ++bj) { *(f32x4*)(rp + bj * HALF) = acc[ai][bj][m][0] * rs; *(f32x4*)(rp + bj * HALF + 4) = acc[ai][bj][m][1] * rs; } }
        }
    }
};
struct EpiY {
    static constexpr bool PERM = true, AFTER_DRAIN = false;
    bf16_t* Y; float* ssq;
    __device__ __forceinline__ void operator()(const f32x4 (&acc)[2][2][4][2], const Unit& u, int wr, int wc, int fr_, int fq_) const {
        int fr = fr_, fq = fq_; asm volatile("" : "+v"(fr), "+v"(fq));
        const int row0 = u.pm * BM + wr * 64 + fr, col0 = u.pn * BM + wc * 32 + 8 * fq;
        PG8_FOR_AI_M { const int row = row0 + ai * HALF + m * 16; float s = 0.f; bf16_t* rp = Y + (size_t)row * 2048 + col0;
#pragma unroll
            for (int bj = 0; bj < 2; ++bj) { const f32x4 v0 = acc[ai][bj][m][0], v1 = acc[ai][bj][m][1];
                s += (v0[0] * v0[0] + v0[1] * v0[1]) + (v0[2] * v0[2] + v0[3] * v0[3]) + (v1[0] * v1[0] + v1[1] * v1[1]) + (v1[2] * v1[2] + v1[3] * v1[3]);
                *(u32x4*)(rp + bj * HALF) = pack8(v0, v1); }
            s += __shfl_xor(s, 16); s += __shfl_xor(s, 32);
            if (fq == 0) __hip_atomic_fetch_add(ssq + row, s, __ATOMIC_RELAXED, __HIP_MEMORY_SCOPE_AGENT); }
    }
};
struct EpiGate {
    static constexpr bool PERM = true, AFTER_DRAIN = false;
    const float* Hin; float* Hout; const bf16_t* Y; const float* ssqY; const float* gpost; const bf16_t* PP; bf16_t* HB; float* ssq;
    __device__ __forceinline__ void operator()(const f32x4 (&acc)[2][2][4][2], const Unit& u, int wr, int wc, int fr_, int fq_) const {
        int fr = fr_, fq = fq_; asm volatile("" : "+v"(fr), "+v"(fq));
        const int row0 = u.pm * BM + wr * 64 + fr, col0 = u.pn * BM + wc * 32 + 8 * fq;
        f32x4 gv[2][2];
#pragma unroll
        for (int bj = 0; bj < 2; ++bj) { gv[bj][0] = *(const f32x4*)(gpost + col0 + bj * HALF); gv[bj][1] = *(const f32x4*)(gpost + col0 + bj * HALF + 4); }
#pragma unroll
        for (int ai = 0; ai < 2; ++ai)
#pragma unroll
            for (int mp = 0; mp < 2; ++mp) {
                f32x4 hh[2][2][2]; u32x4 pq[2][2], yq[2][2]; float rsq[2];
#pragma unroll
                for (int mm = 0; mm < 2; ++mm) { const int row = row0 + ai * HALF + (2 * mp + mm) * 16; rsq[mm] = __builtin_amdgcn_rsqf(ssqY[row] * (1.f / 2048.f) + 1e-6f);
#pragma unroll
                    for (int bj = 0; bj < 2; ++bj) { const size_t off = (size_t)row * 2048 + col0 + bj * HALF;
                        hh[mm][bj][0] = *(const f32x4*)(Hin + off); hh[mm][bj][1] = *(const f32x4*)(Hin + off + 4); pq[mm][bj] = *(const u32x4*)(PP + off); yq[mm][bj] = *(const u32x4*)(Y + off); } }
#pragma unroll
                for (int mm = 0; mm < 2; ++mm) { const int m = 2 * mp + mm; const int row = row0 + ai * HALF + m * 16; float s = 0.f; const float rs = rsq[mm];
#pragma unroll
                    for (int bj = 0; bj < 2; ++bj) { const size_t off = (size_t)row * 2048 + col0 + bj * HALF; float* hp = Hout + off;
                        const u32x4 pp = pq[mm][bj], yy = yq[mm][bj]; const f32x4 g0 = gv[bj][0] * rs, g1 = gv[bj][1] * rs; f32x4 h0 = hh[mm][bj][0], h1 = hh[mm][bj][1];
                        h0[0] += bflo(yy.x) * g0[0]; h0[1] += bfhi(yy.x) * g0[1]; h0[2] += bflo(yy.y) * g0[2]; h0[3] += bfhi(yy.y) * g0[3];
                        h1[0] += bflo(yy.z) * g1[0]; h1[1] += bfhi(yy.z) * g1[1]; h1[2] += bflo(yy.w) * g1[2]; h1[3] += bfhi(yy.w) * g1[3];
                        const f32x4 a0 = acc[ai][bj][m][0], a1 = acc[ai][bj][m][1]; f32x4 o0, o1;
                        o0[0] = h0[0] + bflo(pp.x) * sigm(a0[0]); o0[1] = h0[1] + bfhi(pp.x) * sigm(a0[1]); o0[2] = h0[2] + bflo(pp.y) * sigm(a0[2]); o0[3] = h0[3] + bfhi(pp.y) * sigm(a0[3]);
                        o1[0] = h1[0] + bflo(pp.z) * sigm(a1[0]); o1[1] = h1[1] + bfhi(pp.z) * sigm(a1[1]); o1[2] = h1[2] + bflo(pp.w) * sigm(a1[2]); o1[3] = h1[3] + bfhi(pp.w) * sigm(a1[3]);
                        *(f32x4*)hp = o0; *(f32x4*)(hp + 4) = o1;
                        if (HB) *(u32x4*)(HB + off) = pack8(o0, o1);
                        s += (o0[0] * o0[0] + o0[1] * o0[1]) + (o0[2] * o0[2] + o0[3] * o0[3]) + (o1[0] * o1[0] + o1[1] * o1[1]) + (o1[2] * o1[2] + o1[3] * o1[3]); }
                    if (ssq) { s += __shfl_xor(s, 16); s += __shfl_xor(s, 32); if (fq == 0) __hip_atomic_fetch_add(ssq + row, s, __ATOMIC_RELAXED, __HIP_MEMORY_SCOPE_AGENT); } } }
    }
};
struct EpiC {
    static constexpr bool PERM = true, AFTER_DRAIN = false;
    bf16_t* U0; size_t ustride; const float* ssq; float* vsum; float* vsq;
    __device__ __forceinline__ void operator()(const f32x4 (&acc)[2][2][4][2], const Unit& u, int wr, int wc, int fr_, int fq_) const {
        int fr = fr_, fq = fq_; asm volatile("" : "+v"(fr), "+v"(fq));
        const int seg = u.pn >> 3; bf16_t* base = U0 + (size_t)seg * ustride;
        const int row0 = u.pm * BM + wr * 64 + fr, col0 = (u.pn & 7) * BM + wc * 32 + 8 * fq;
        float rsv[2][4];
        PG8_FOR_AI_M rsv[ai][m] = __builtin_amdgcn_rsqf(ssq[row0 + ai * HALF + m * 16] * (1.f / 2048.f) + 1e-6f);
        PG8_FOR_AI_M { const int row = row0 + ai * HALF + m * 16; const float rs = rsv[ai][m]; float s1 = 0.f, s2 = 0.f; bf16_t* rp = base + (size_t)row * 2048 + col0;
#pragma unroll
            for (int bj = 0; bj < 2; ++bj) { f32x4 v0 = acc[ai][bj][m][0] * rs, v1 = acc[ai][bj][m][1] * rs;
                if (seg < 2) { f32x2 a = gelu_pk((f32x2){v0[0], v0[1]}), b = gelu_pk((f32x2){v0[2], v0[3]}), c = gelu_pk((f32x2){v1[0], v1[1]}), d = gelu_pk((f32x2){v1[2], v1[3]});
                    v0 = (f32x4){a.x, a.y, b.x, b.y}; v1 = (f32x4){c.x, c.y, d.x, d.y}; }
                else {
#pragma unroll
                    for (int i = 0; i < 4; ++i) { v0[i] = v0[i] * sigm(v0[i]); v1[i] = v1[i] * sigm(v1[i]); } }
                *(u32x4*)(rp + bj * HALF) = pack8(v0, v1);
                if (seg == 1) { s1 += (v0[0] + v0[1]) + (v0[2] + v0[3]) + (v1[0] + v1[1]) + (v1[2] + v1[3]);
                    s2 += (v0[0] * v0[0] + v0[1] * v0[1]) + (v0[2] * v0[2] + v0[3] * v0[3]) + (v1[0] * v1[0] + v1[1] * v1[1]) + (v1[2] * v1[2] + v1[3] * v1[3]); } }
            if (seg == 1) { s1 += __shfl_xor(s1, 16); s1 += __shfl_xor(s1, 32); s2 += __shfl_xor(s2, 16); s2 += __shfl_xor(s2, 32);
                if (fq == 0) { __hip_atomic_fetch_add(vsum + row, s1, __ATOMIC_RELAXED, __HIP_MEMORY_SCOPE_AGENT); __hip_atomic_fetch_add(vsq + row, s2, __ATOMIC_RELAXED, __HIP_MEMORY_SCOPE_AGENT); } } }
    }
};
template <class Epi, class Sched, bool ALIGN_EPI = false, bool SP2 = false>
__device__ __forceinline__ void gemm_phase(PG8_LAS unsigned char* lds, const Gemm g, const Sched& S, const Epi& E, const int tid_in) {
    const int tid = tid_in, wid = __builtin_amdgcn_readfirstlane(tid >> 6), lane = tid & 63, wr = wid >> 2, wc = wid & 3, fr = lane & 15, fq = lane >> 4;
    const int K = g.K, nt = K / BK;
    unsigned voffA[2], voffB[2];
#pragma unroll
    for (int i = 0; i < 2; ++i) { int R, C; stage_rc(tid * 16 + i * 8192, R, C); const int Rb = Epi::PERM ? ((R & ~31) + perm32(R & 31)) : R;
        voffA[i] = (unsigned)(R * K + C) * 2u; voffB[i] = (unsigned)(Rb * K + C) * 2u; }
    const size_t kstep = (size_t)(BK * 2);
    const size_t hstep = (size_t)HALF * K * 2;
    const size_t tstep = 2 * hstep;
    const unsigned ldsw = (unsigned)wid * 1024u;
    const int aoff = lds_byte(wr * 64 + fr, fq * 8), boff = lds_byte(wc * 32 + fr, fq * 8);
#define PG8_SA(b, h) (((b) * 2 + (h)) * HTB)
#define PG8_SB(b, h) ((4 + (b) * 2 + (h)) * HTB)
#define PG8_STAGE(bufoff, gbase, voff) do { _Pragma("unroll") for (int _i = 0; _i < 2; ++_i) \
        __builtin_amdgcn_global_load_lds((const unsigned*)((const char*)(gbase) + (voff)[_i]), (PG8_LAS unsigned*)(lds + (bufoff) + ldsw + _i * 8192), 16, 0, 0); } while (0)
#define PG8_LDA(dst, b, h) do { _Pragma("unroll") for (int m = 0; m < 4; ++m) _Pragma("unroll") for (int k = 0; k < 2; ++k) dst[m][k] = *(const PG8_LAS bf16x8*)(lds + PG8_SA(b, h) + aoff + m * 2048 + k * 1024); } while (0)
#define PG8_LDB(dst, b, h) do { _Pragma("unroll") for (int n = 0; n < 2; ++n) _Pragma("unroll") for (int k = 0; k < 2; ++k) dst[n][k] = *(const PG8_LAS bf16x8*)(lds + PG8_SB(b, h) + boff + n * 2048 + k * 1024); } while (0)
#define PG8_MMA(ai, bj, At, Bt) do { __builtin_amdgcn_s_setprio(1); _Pragma("unroll") for (int m = 0; m < 4; ++m) _Pragma("unroll") for (int n = 0; n < 2; ++n) _Pragma("unroll") for (int k = 0; k < 2; ++k) \
        acc[ai][bj][m][n] = __builtin_amdgcn_mfma_f32_16x16x32_bf16(Bt[n][k], At[m][k], acc[ai][bj][m][n], 0, 0, 0); __builtin_amdgcn_s_setprio(0); } while (0)
#define PG8_WAIT_V(n) asm volatile("s_waitcnt vmcnt(" #n ")" ::: "memory")
#define PG8_WAIT_L(n) asm volatile("s_waitcnt lgkmcnt(" #n ")" ::: "memory")
#define PG8_BAR __builtin_amdgcn_s_barrier()
#define PG8_SCHED __builtin_amdgcn_sched_barrier(0)
    Unit cur, nxt; int ui = 0;
    if (!S.next(0, cur)) return;
    f32x4 acc[2][2][4][2];
#pragma unroll
    for (int a = 0; a < 2; ++a)
#pragma unroll
        for (int b = 0; b < 2; ++b)
#pragma unroll
            for (int m = 0; m < 4; ++m)
#pragma unroll
                for (int n = 0; n < 2; ++n) acc[a][b][m][n] = (f32x4){0.f, 0.f, 0.f, 0.f};
    bf16x8 At[4][2], B0[2][2], B1[2][2];
    const char* cA = (const char*)g.A + (size_t)cur.pm * tstep; const char* cB = (const char*)g.Bt + (size_t)cur.pn * tstep;
    S.a_ready(cur);
    if constexpr (SP2) {
        PG8_STAGE(PG8_SB(0, 0), cB, voffB); PG8_STAGE(PG8_SB(0, 1), cB + hstep, voffB); PG8_STAGE(PG8_SA(0, 0), cA, voffA); PG8_STAGE(PG8_SA(0, 1), cA + hstep, voffA);
        if (wr == 1) PG8_BAR;
        PG8_WAIT_V(2); PG8_BAR;
        PG8_STAGE(PG8_SB(1, 0), cB + kstep, voffB); PG8_STAGE(PG8_SA(1, 0), cA + kstep, voffA); PG8_STAGE(PG8_SB(1, 1), cB + hstep + kstep, voffB);
        PG8_WAIT_V(6); PG8_BAR;
    } else {
        PG8_STAGE(PG8_SB(0, 0), cB, voffB); PG8_STAGE(PG8_SA(0, 0), cA, voffA); PG8_STAGE(PG8_SB(0, 1), cB + hstep, voffB); PG8_STAGE(PG8_SA(0, 1), cA + hstep, voffA);
        if (wr == 1) PG8_BAR;
        PG8_WAIT_V(4); PG8_BAR;
        PG8_STAGE(PG8_SB(1, 0), cB + kstep, voffB); PG8_STAGE(PG8_SA(1, 0), cA + kstep, voffA); PG8_STAGE(PG8_SB(1, 1), cB + hstep + kstep, voffB);
        PG8_WAIT_V(6); PG8_BAR;
    }
    for (;;) {
        const bool has_next = S.next(ui + 1, nxt);
        const char* nA = has_next ? (const char*)g.A + (size_t)nxt.pm * tstep : cA; const char* nB = has_next ? (const char*)g.Bt + (size_t)nxt.pn * tstep : cB;
        for (int t = 0; t < nt; t += 2) {
            const bool last = (t == nt - 2);
            const char* a1 = cA + (size_t)(t + 1) * kstep;
            const char* a2 = last ? nA : cA + (size_t)(t + 2) * kstep; const char* b2 = last ? nB : cB + (size_t)(t + 2) * kstep;
            const char* a3 = a2 + kstep; const char* b3 = b2 + kstep;
            if (last && has_next) S.a_ready(nxt);
            if constexpr (SP2) {
            PG8_LDB(B0, 0, 0); PG8_LDB(B1, 0, 1); PG8_SCHED; PG8_LDA(At, 0, 0); PG8_STAGE(PG8_SA(1, 1), a1 + hstep, voffA);
            PG8_WAIT_V(8); PG8_WAIT_L(0); PG8_BAR; PG8_MMA(0, 0, At, B0); PG8_MMA(0, 1, At, B1); PG8_BAR; PG8_SCHED;
            PG8_LDA(At, 0, 1); PG8_STAGE(PG8_SB(0, 0), b2, voffB); PG8_STAGE(PG8_SB(0, 1), b2 + hstep, voffB); PG8_STAGE(PG8_SA(0, 0), a2, voffA);
            PG8_WAIT_V(8); PG8_WAIT_L(0); PG8_BAR; PG8_MMA(1, 0, At, B0); PG8_MMA(1, 1, At, B1); PG8_BAR; PG8_SCHED;
            PG8_LDB(B0, 1, 0); PG8_LDB(B1, 1, 1); PG8_SCHED; PG8_LDA(At, 1, 0); PG8_STAGE(PG8_SA(0, 1), a2 + hstep, voffA);
            PG8_WAIT_V(8); PG8_WAIT_L(0); PG8_BAR; PG8_MMA(0, 0, At, B0); PG8_MMA(0, 1, At, B1); PG8_BAR; PG8_SCHED;
            PG8_LDA(At, 1, 1); PG8_STAGE(PG8_SB(1, 0), b3, voffB); PG8_STAGE(PG8_SB(1, 1), b3 + hstep, voffB); PG8_STAGE(PG8_SA(1, 0), a3, voffA);
            PG8_WAIT_V(8); PG8_WAIT_L(0); PG8_BAR; PG8_MMA(1, 0, At, B0); PG8_MMA(1, 1, At, B1); PG8_BAR; PG8_SCHED;
            } else {
            PG8_LDB(B0, 0, 0); PG8_SCHED; PG8_LDA(At, 0, 0); PG8_STAGE(PG8_SA(1, 1), a1 + hstep, voffA);
            PG8_WAIT_L(8); PG8_BAR; PG8_WAIT_L(0); PG8_MMA(0, 0, At, B0); PG8_BAR; PG8_SCHED;
            PG8_LDB(B1, 0, 1); PG8_STAGE(PG8_SB(0, 0), b2, voffB);
            PG8_BAR; PG8_WAIT_L(0); PG8_MMA(0, 1, At, B1); PG8_BAR;
            PG8_LDA(At, 0, 1); PG8_STAGE(PG8_SA(0, 0), a2, voffA);
            PG8_BAR; PG8_WAIT_L(0); PG8_MMA(1, 0, At, B0); PG8_BAR; PG8_SCHED;
            PG8_STAGE(PG8_SB(0, 1), b2 + hstep, voffB);
            PG8_WAIT_V(6); PG8_BAR; PG8_MMA(1, 1, At, B1); PG8_BAR;
            PG8_LDB(B0, 1, 0); PG8_SCHED; PG8_LDA(At, 1, 0); PG8_STAGE(PG8_SA(0, 1), a2 + hstep, voffA);
            PG8_WAIT_L(8); PG8_BAR; PG8_WAIT_L(0); PG8_MMA(0, 0, At, B0); PG8_BAR; PG8_SCHED;
            PG8_LDB(B1, 1, 1); PG8_STAGE(PG8_SB(1, 0), b3, voffB);
            PG8_BAR; PG8_WAIT_L(0); PG8_MMA(0, 1, At, B1); PG8_BAR;
            PG8_LDA(At, 1, 1); PG8_STAGE(PG8_SA(1, 0), a3, voffA);
            PG8_BAR; PG8_WAIT_L(0); PG8_MMA(1, 0, At, B0); PG8_BAR; PG8_SCHED;
            PG8_STAGE(PG8_SB(1, 1), b3 + hstep, voffB);
            PG8_WAIT_V(6); PG8_BAR; PG8_MMA(1, 1, At, B1); PG8_BAR;
            }
        }
        if constexpr (ALIGN_EPI) { if (wr == 0) PG8_BAR; }
        if constexpr (!Epi::AFTER_DRAIN) { E(acc, cur, wr, wc, fr, fq); S.done(cur); }
        if (!has_next) break;
#pragma unroll
        for (int a = 0; a < 2; ++a)
#pragma unroll
            for (int b = 0; b < 2; ++b)
#pragma unroll
                for (int m = 0; m < 4; ++m)
#pragma unroll
                    for (int n = 0; n < 2; ++n) acc[a][b][m][n] = (f32x4){0.f, 0.f, 0.f, 0.f};
        cur = nxt; cA = nA; cB = nB; ++ui;
        if constexpr (ALIGN_EPI) { if (wr == 1) PG8_BAR; }
    }
    PG8_WAIT_V(0);
    if constexpr (!ALIGN_EPI) { if (wr == 0) PG8_BAR; }
    PG8_BAR;
    if constexpr (Epi::AFTER_DRAIN) { E.fused(acc, cur, wr, wc, fr, fq, lds, wid, lane); S.done(cur); }
#undef PG8_SA
#undef PG8_SB
#undef PG8_STAGE
#undef PG8_LDA
#undef PG8_LDB
#undef PG8_MMA
#undef PG8_WAIT_V
#undef PG8_WAIT_L
#undef PG8_BAR
#undef PG8_SCHED
}
}
constexpr int NB = 16, T = 2048, D = 2048, M = NB * T;
constexpr int N_IN0 = 8448;
constexpr size_t MiB = 1u << 20;
constexpr size_t WS_CTL = 0;
constexpr size_t WS_WIN0 = 2 * MiB, WS_WOUT0 = 35 * MiB, WS_WIN1 = 43 * MiB, WS_WOUT1 = 67 * MiB, WS_WG0 = 75 * MiB, WS_WG1 = 83 * MiB, WS_WP0 = 91 * MiB, WS_WP1 = 92 * MiB;
constexpr size_t WS_HBA = 96 * MiB, WS_PB = 224 * MiB, WS_G = 256 * MiB, WS_SMALL = 768 * MiB, WS_Z = 800 * MiB, WS_END = 928 * MiB;
constexpr int LDS_BYTES = 147456;
constexpr int NWAVES = 8;
typedef unsigned short bf16;
typedef short bf16x8 __attribute__((ext_vector_type(8)));
typedef float f32x4 __attribute__((ext_vector_type(4)));
typedef float f32x16 __attribute__((ext_vector_type(16)));
typedef unsigned u32x4 __attribute__((ext_vector_type(4)));
typedef unsigned u32x2 __attribute__((ext_vector_type(2)));
#define LAS __attribute__((address_space(3)))
#define LDS_WAIT() asm volatile("s_waitcnt lgkmcnt(0)" ::: "memory")
using pg8::cvt_pk_bf16; using pg8::bflo; using pg8::bfhi; using pg8::sigm;
constexpr float LOG2E = 1.4426950408889634f;

__device__ __forceinline__ int my_tid(int wave_s) { return wave_s * 64 + (int)__builtin_amdgcn_mbcnt_hi(~0u, __builtin_amdgcn_mbcnt_lo(~0u, 0u)); }
__device__ __forceinline__ float wave_sum(float v) {
#pragma unroll
    for (int o = 1; o < 64; o <<= 1) v += __shfl_xor(v, o);
    return v;
}
__device__ __forceinline__ float red16(float v) { v += __shfl_xor(v, 1); v += __shfl_xor(v, 2); v += __shfl_xor(v, 4); v += __shfl_xor(v, 8); return v; }

__device__ __forceinline__ void transpose_item(const float* W, int K, int Nsrc, int src_col0, int nvalid, const float* gk, bf16* WT, int dst_row0, float* scr, int kb, int lane) {
    const int k0 = 64 * kb, c = lane & 31;
#pragma unroll 8
    for (int i = 0; i < 32; ++i) { const int kk = 2 * i + (lane >> 5); float v = (c < nvalid) ? W[(size_t)(k0 + kk) * Nsrc + src_col0 + c] : 0.f; if (gk) v *= gk[k0 + kk]; scr[kk * 33 + c] = v; }
    LDS_WAIT();
    const int c8 = lane & 7;
#pragma unroll
    for (int j = 0; j < 4; ++j) { const int n = (lane >> 3) + 8 * j; const float* s = scr + (8 * c8) * 33 + n;
        u32x4 o; o.x = cvt_pk_bf16(s[0 * 33], s[1 * 33]); o.y = cvt_pk_bf16(s[2 * 33], s[3 * 33]); o.z = cvt_pk_bf16(s[4 * 33], s[5 * 33]); o.w = cvt_pk_bf16(s[6 * 33], s[7 * 33]);
        *(u32x4*)(WT + (size_t)(dst_row0 + n) * K + k0 + 8 * c8) = o; }
    LDS_WAIT();
}

struct Ptrs {
    const float *x, *p, *norm_pre, *norm_post, *ab_w_in, *fox_f_bias, *rwkv_mu, *rwkv_w0, *rwkv_w2, *rwkv_a0, *rwkv_a2, *rwkv_k_k, *rwkv_k_a, *rwkv_r_k, *rwkv_ln_g, *rwkv_ln_b,
        *ab_w_out, *c_w_in, *c_ln_g, *c_ln_b, *c_w_s, *c_b_s, *c_w_out, *ple_w_proj, *ple_w_gate;
    float* out; unsigned char* ws; int ph_lo, ph_hi;
};

__device__ __forceinline__ void p0_prologue(const Ptrs& P, unsigned char* lds, const int wave_s) {
    int tid_ = my_tid(wave_s); asm volatile("" : "+v"(tid_)); const int tid = tid_, lane = tid & 63, wave = tid >> 6;
    float* scr = (float*)(lds + wave * 16384);
    const int gw = blockIdx.x * NWAVES + wave, NGW = gridDim.x * NWAVES;
    unsigned char* ws = P.ws;
    if (blockIdx.x < 200) {
        const int c0 = blockIdx.x * 16, q = wave, cq = lane & 3, bb = lane >> 2;
        const float* xr = P.x + (size_t)bb * T * D + q * 256; const float* gq = P.norm_pre + q * 256; const float* Wq = P.ab_w_in + (size_t)(q * 256) * 8336 + 4112 + c0 + 4 * cq;
        f32x4 a0 = {0.f, 0.f, 0.f, 0.f}, a1 = a0, a2 = a0, a3 = a0;
#pragma unroll 2
        for (int k4 = 0; k4 < 64; ++k4) { const f32x4 gv = *(const f32x4*)(gq + 4 * k4);
            const f32x4 x0 = *(const f32x4*)(xr + 4 * k4) * gv, x1 = *(const f32x4*)(xr + D + 4 * k4) * gv, x2 = *(const f32x4*)(xr + 2 * D + 4 * k4) * gv, x3 = *(const f32x4*)(xr + 3 * D + 4 * k4) * gv;
#pragma unroll
            for (int e = 0; e < 4; ++e) { const f32x4 wv_ = *(const f32x4*)(Wq + (size_t)(4 * k4 + e) * 8336);
                a0 += x0[e] * wv_; a1 += x1[e] * wv_; a2 += x2[e] * wv_; a3 += x3[e] * wv_; } }
        { float* part = (float*)lds + (q * 64 + bb * 4) * 16 + 4 * cq;
          *(f32x4*)part = a0; *(f32x4*)(part + 16) = a1; *(f32x4*)(part + 32) = a2; *(f32x4*)(part + 48) = a3; }
        __syncthreads();
        float* EXG = (float*)(ws + WS_CTL + 0x100000);
#pragma unroll
        for (int o = tid * 2; o < tid * 2 + 2; ++o) { const int r2 = o >> 4, cc = o & 15; float v = 0.f;
#pragma unroll
            for (int w = 0; w < 8; ++w) v += ((const float*)lds)[(w * 64 + r2) * 16 + cc];
            EXG[(size_t)r2 * 3200 + c0 + cc] = v; }
        __syncthreads();
    }
    { float* z = (float*)(ws + WS_CTL) + M; for (int i = blockIdx.x * 512 + tid; i < 5 * M; i += gridDim.x * 512) z[i] = 0.f; }
    constexpr int I_IN0 = 32 * (N_IN0 / 32), I_SQ = 32 * 64, I_IN1 = 32 * 192, I_PJ = 4 * 64;
    constexpr int NITEMS = I_IN0 + I_SQ + I_IN1 + I_SQ + 2 * I_SQ + 2 * I_PJ;
    for (int it = gw; it < NITEMS; it += NGW) {
        int r = it;
        if (r < I_IN0) { const int nblk = N_IN0 / 32, kb = r / nblk, db = r % nblk; int src, nv = 32;
            if (db < 256) { const int grp = db >> 5; src = grp * 1024 + (grp >= 3 ? 16 : 0) + (grp == 7 ? 128 : 0) + (db & 31) * 32; }
            else if (db < 258) src = 7184 + (db - 256) * 32; else if (db < 260) src = 7248 + (db - 258) * 32; else if (db == 260) { src = 3072; nv = 16; } else { src = 0; nv = 0; }
            transpose_item(P.ab_w_in, 2048, 8336, src, nv, P.norm_pre, (bf16*)(ws + WS_WIN0), db * 32, scr, kb, lane); continue; } r -= I_IN0;
        if (r < I_SQ) { transpose_item(P.ab_w_out, 2048, 2048, (r % 64) * 32, 32, nullptr, (bf16*)(ws + WS_WOUT0), (r % 64) * 32, scr, r / 64, lane); continue; } r -= I_SQ;
        if (r < I_IN1) { transpose_item(P.c_w_in, 2048, 6144, (r % 192) * 32, 32, P.norm_pre + 2048, (bf16*)(ws + WS_WIN1), (r % 192) * 32, scr, r / 192, lane); continue; } r -= I_IN1;
        if (r < I_SQ) { transpose_item(P.c_w_out, 2048, 2048, (r % 64) * 32, 32, nullptr, (bf16*)(ws + WS_WOUT1), (r % 64) * 32, scr, r / 64, lane); continue; } r -= I_SQ;
        if (r < I_SQ) { transpose_item(P.ple_w_gate, 2048, 2048, (r % 64) * 32, 32, nullptr, (bf16*)(ws + WS_WG0), (r % 64) * 32, scr, r / 64, lane); continue; } r -= I_SQ;
        if (r < I_SQ) { transpose_item(P.ple_w_gate + (size_t)2048 * 2048, 2048, 2048, (r % 64) * 32, 32, nullptr, (bf16*)(ws + WS_WG1), (r % 64) * 32, scr, r / 64, lane); continue; } r -= I_SQ;
        if (r < I_PJ) { transpose_item(P.ple_w_proj, 256, 2048, (r % 64) * 32, 32, nullptr, (bf16*)(ws + WS_WP0), (r % 64) * 32, scr, r / 64, lane); continue; } r -= I_PJ;
        transpose_item(P.ple_w_proj + (size_t)256 * 2048, 256, 2048, (r % 64) * 32, 32, nullptr, (bf16*)(ws + WS_WP1), (r % 64) * 32, scr, r / 64, lane);
    }
    { float* ssq0 = (float*)(ws + WS_CTL); bf16* hb = (bf16*)(ws + WS_HBA);
      for (int row = gw; row < M; row += NGW) { const f32x4* xr = (const f32x4*)(P.x + (size_t)row * D) + lane; f32x4 v[8]; float s = 0.f;
#pragma unroll
          for (int j = 0; j < 8; ++j) { v[j] = xr[64 * j]; s += (v[j][0] * v[j][0] + v[j][1] * v[j][1]) + (v[j][2] * v[j][2] + v[j][3] * v[j][3]); }
          s = wave_sum(s); if (lane == 0) ssq0[row] = s;
          u32x2* o = (u32x2*)(hb + (size_t)row * D) + lane;
#pragma unroll
          for (int j = 0; j < 8; ++j) { u32x2 w; w.x = cvt_pk_bf16(v[j][0], v[j][1]); w.y = cvt_pk_bf16(v[j][2], v[j][3]); o[64 * j] = w; } } }
}

template <bool HIN_BF16> __device__ __forceinline__ void post_norm_phase(const float* hin, const bf16* Y, const float* ssq, const float* g, float* hout, bf16* hb, const int wave_s) {
    int tid_ = my_tid(wave_s); asm volatile("" : "+v"(tid_)); const int tid = tid_, lane = tid & 63, wave = tid >> 6;
    const int gw = blockIdx.x * NWAVES + wave, NGW = gridDim.x * NWAVES;
    f32x4 gv[8];
#pragma unroll
    for (int j = 0; j < 8; ++j) gv[j] = *((const f32x4*)g + lane + 64 * j);
    for (int row = gw; row < M; row += NGW) {
        const float rs = __builtin_amdgcn_rsqf(ssq[row] * (1.f / 2048.f) + 1e-6f);
        const f32x4* hr = (const f32x4*)(hin + (size_t)row * D) + lane; const u32x2* yr = (const u32x2*)(Y + (size_t)row * D) + lane;
        u32x2* ob = (u32x2*)(hb + (size_t)row * D) + lane;
#pragma unroll
        for (int j = 0; j < 8; ++j) { f32x4 h; if (HIN_BF16) { const u32x2 hx = ob[64 * j]; h = (f32x4){bflo(hx.x), bfhi(hx.x), bflo(hx.y), bfhi(hx.y)}; } else h = hr[64 * j];
            const u32x2 y = yr[64 * j]; f32x4 o;
            o[0] = h[0] + bflo(y.x) * rs * gv[j][0]; o[1] = h[1] + bfhi(y.x) * rs * gv[j][1]; o[2] = h[2] + bflo(y.y) * rs * gv[j][2]; o[3] = h[3] + bfhi(y.y) * rs * gv[j][3];
            u32x2 w; w.x = cvt_pk_bf16(o[0], o[1]); w.y = cvt_pk_bf16(o[2], o[3]); ob[64 * j] = w; }
    }
}

__device__ __forceinline__ int crow(int r, int hi) { return (r & 3) + 8 * (r >> 2) + 4 * hi; }
__device__ __forceinline__ void attn_phase(unsigned char* lds, const bf16* Qg, const bf16* Kg, const bf16* Vg, const bf16* GAg, const float* small, const float* fbias, bf16* Z, const int wave_s) {
    int tid_ = my_tid(wave_s); asm volatile("" : "+v"(tid_)); const int tid = tid_, lane = tid & 63, wid = __builtin_amdgcn_readfirstlane(tid >> 6), r32 = lane & 31, hi = lane >> 5;
    float* c2 = (float*)lds;
    float* wtot = (float*)(lds + 8192);
    bf16* Ks = (bf16*)(lds + 8192 + 64);
    bf16* Vt = Ks + 64 * 72;
    for (int bh = blockIdx.x; bh < 256; bh += gridDim.x) {
        const int b = bh >> 4, h = bh & 15; const size_t rowbase = (size_t)b * T;
        __syncthreads();
        { float lf[4]; const float fb = fbias[h]; float run = 0.f;
#pragma unroll
          for (int i = 0; i < 4; ++i) { const float xg = small[(rowbase + 4 * tid + i) * 256 + 128 + h] + fb; const float ls = fminf(xg, 0.f) - log1pf(__expf(-fabsf(xg))); run += ls; lf[i] = run; }
          float sc = run;
#pragma unroll
          for (int o = 1; o < 64; o <<= 1) { const float t = __shfl_up(sc, o); if (lane >= o) sc += t; }
          if (lane == 63) wtot[wid] = sc;
          __syncthreads();
          float off = sc - run;
#pragma unroll
          for (int w = 0; w < 8; ++w) if (w < wid) off += wtot[w];
#pragma unroll
          for (int i = 0; i < 4; ++i) c2[4 * tid + i] = (off + lf[i]) * LOG2E; }
        __syncthreads();
        for (int qb = 0; qb < 8; ++qb) {
            const int q0w = qb * 256 + wid * 32, q = q0w + r32;
            bf16x8 qr[4];
#pragma unroll
            for (int d0 = 0; d0 < 4; ++d0) qr[d0] = *(const bf16x8*)(Qg + (rowbase + q) * 1024 + h * 64 + d0 * 16 + hi * 8);
            const float cq = c2[q];
            f32x16 o0, o1;
#pragma unroll
            for (int r = 0; r < 16; ++r) { o0[r] = 0.f; o1[r] = 0.f; }
            float mrow = -1e30f, l = 0.f;
            const int NT = qb * 4 + 4;
            const int kr = tid >> 3, ch = tid & 7, vr = lane, vc = wid;
            const bf16* kgp = Kg + (rowbase + kr) * 1024 + h * 64 + ch * 8; const bf16* vgp = Vg + (rowbase + vr) * 1024 + h * 64 + vc * 8;
            u32x4 kreg = *(const u32x4*)kgp, vreg = *(const u32x4*)vgp;
            for (int t = 0; t < NT; ++t) {
                asm volatile("s_waitcnt lgkmcnt(0)\n\ts_barrier" ::: "memory");
                { *(u32x4*)(Ks + kr * 72 + ch * 8) = kreg; bf16* vt = Vt + (vc * 8) * 72 + vr;
                  vt[0 * 72] = (bf16)(vreg.x & 0xffffu); vt[1 * 72] = (bf16)(vreg.x >> 16); vt[2 * 72] = (bf16)(vreg.y & 0xffffu); vt[3 * 72] = (bf16)(vreg.y >> 16);
                  vt[4 * 72] = (bf16)(vreg.z & 0xffffu); vt[5 * 72] = (bf16)(vreg.z >> 16); vt[6 * 72] = (bf16)(vreg.w & 0xffffu); vt[7 * 72] = (bf16)(vreg.w >> 16);
                  if (t + 1 < NT) { kreg = *(const u32x4*)(kgp + (size_t)(t + 1) * 64 * 1024); vreg = *(const u32x4*)(vgp + (size_t)(t + 1) * 64 * 1024); } }
                asm volatile("s_waitcnt lgkmcnt(0)\n\ts_barrier" ::: "memory");
                if (t * 64 <= q0w + 31) {
                    f32x16 p0, p1;
#pragma unroll
                    for (int r = 0; r < 16; ++r) { p0[r] = 0.f; p1[r] = 0.f; }
#pragma unroll
                    for (int d0 = 0; d0 < 4; ++d0) { const bf16x8 k0 = *(const bf16x8*)(Ks + r32 * 72 + d0 * 16 + hi * 8), k1 = *(const bf16x8*)(Ks + (32 + r32) * 72 + d0 * 16 + hi * 8);
                        p0 = __builtin_amdgcn_mfma_f32_32x32x16_bf16(k0, qr[d0], p0, 0, 0, 0); p1 = __builtin_amdgcn_mfma_f32_32x32x16_bf16(k1, qr[d0], p1, 0, 0, 0); }
                    const int kvb = t * 64 + 4 * hi;
#pragma unroll
                    for (int g4 = 0; g4 < 4; ++g4) { const f32x4 ca = *(const f32x4*)(c2 + kvb + 8 * g4), cb = *(const f32x4*)(c2 + kvb + 32 + 8 * g4);
#pragma unroll
                        for (int i = 0; i < 4; ++i) { p0[4 * g4 + i] += cq - ca[i]; p1[4 * g4 + i] += cq - cb[i]; } }
                    if (t * 64 + 63 > q0w) {
#pragma unroll
                        for (int r = 0; r < 16; ++r) { const int kv = kvb + (r & 3) + 8 * (r >> 2); if (kv > q) p0[r] = -1e30f; if (kv + 32 > q) p1[r] = -1e30f; } }
                    float mx = fmaxf(p0[0], p1[0]);
#pragma unroll
                    for (int r = 1; r < 16; ++r) mx = fmaxf(mx, fmaxf(p0[r], p1[r]));
                    mx = fmaxf(mx, __shfl_xor(mx, 32));
                    const float mnew = fmaxf(mrow, mx), alpha = __builtin_amdgcn_exp2f(mrow - mnew); mrow = mnew;
                    l *= alpha; float ls = 0.f;
#pragma unroll
                    for (int r = 0; r < 16; ++r) { o0[r] *= alpha; o1[r] *= alpha; p0[r] = __builtin_amdgcn_exp2f(p0[r] - mnew); p1[r] = __builtin_amdgcn_exp2f(p1[r] - mnew); ls += p0[r] + p1[r]; }
                    l += ls;
                    u32x4 pw[4];
#pragma unroll
                    for (int s = 0; s < 2; ++s) { pw[s].x = cvt_pk_bf16(p0[8 * s + 0], p0[8 * s + 1]); pw[s].y = cvt_pk_bf16(p0[8 * s + 2], p0[8 * s + 3]); pw[s].z = cvt_pk_bf16(p0[8 * s + 4], p0[8 * s + 5]); pw[s].w = cvt_pk_bf16(p0[8 * s + 6], p0[8 * s + 7]);
                        pw[2 + s].x = cvt_pk_bf16(p1[8 * s + 0], p1[8 * s + 1]); pw[2 + s].y = cvt_pk_bf16(p1[8 * s + 2], p1[8 * s + 3]); pw[2 + s].z = cvt_pk_bf16(p1[8 * s + 4], p1[8 * s + 5]); pw[2 + s].w = cvt_pk_bf16(p1[8 * s + 6], p1[8 * s + 7]); }
#pragma unroll
                    for (int s = 0; s < 4; ++s) { const bf16x8 pf = __builtin_bit_cast(bf16x8, pw[s]);
                        { const bf16* vp = Vt + r32 * 72 + 16 * s + 4 * hi; const u32x2 lo = *(const u32x2*)vp, hi2 = *(const u32x2*)(vp + 8); u32x4 va; va.x = lo.x; va.y = lo.y; va.z = hi2.x; va.w = hi2.y;
                          o0 = __builtin_amdgcn_mfma_f32_32x32x16_bf16(__builtin_bit_cast(bf16x8, va), pf, o0, 0, 0, 0); }
                        { const bf16* vp = Vt + (32 + r32) * 72 + 16 * s + 4 * hi; const u32x2 lo = *(const u32x2*)vp, hi2 = *(const u32x2*)(vp + 8); u32x4 va; va.x = lo.x; va.y = lo.y; va.z = hi2.x; va.w = hi2.y;
                          o1 = __builtin_amdgcn_mfma_f32_32x32x16_bf16(__builtin_bit_cast(bf16x8, va), pf, o1, 0, 0, 0); } }
                }
            }
            l += __shfl_xor(l, 32); const float inv = 1.f / l;
#pragma unroll
            for (int g4 = 0; g4 < 4; ++g4) {
                { const int d = 8 * g4 + 4 * hi; const u32x2 gg = *(const u32x2*)(GAg + (rowbase + q) * 1024 + h * 64 + d);
                  const float g0 = bflo(gg.x), g1 = bfhi(gg.x), g2 = bflo(gg.y), g3 = bfhi(gg.y); u32x2 w;
                  w.x = cvt_pk_bf16(o0[4 * g4 + 0] * inv * g0 * sigm(g0), o0[4 * g4 + 1] * inv * g1 * sigm(g1)); w.y = cvt_pk_bf16(o0[4 * g4 + 2] * inv * g2 * sigm(g2), o0[4 * g4 + 3] * inv * g3 * sigm(g3));
                  *(u32x2*)(Z + (rowbase + q) * 2048 + h * 64 + d) = w; }
                { const int d = 32 + 8 * g4 + 4 * hi; const u32x2 gg = *(const u32x2*)(GAg + (rowbase + q) * 1024 + h * 64 + d);
                  const float g0 = bflo(gg.x), g1 = bfhi(gg.x), g2 = bflo(gg.y), g3 = bfhi(gg.y); u32x2 w;
                  w.x = cvt_pk_bf16(o1[4 * g4 + 0] * inv * g0 * sigm(g0), o1[4 * g4 + 1] * inv * g1 * sigm(g1)); w.y = cvt_pk_bf16(o1[4 * g4 + 2] * inv * g2 * sigm(g2), o1[4 * g4 + 3] * inv * g3 * sigm(g3));
                  *(u32x2*)(Z + (rowbase + q) * 2048 + h * 64 + d) = w; }
            }
        }
    }
}
__device__ __forceinline__ float exp_fast(float x) { return __builtin_amdgcn_exp2f(1.4426950408889634f * x); }
__device__ __forceinline__ float softplusf_(float z) { return fmaxf(z, 0.f) + 0.6931471805599453f * __builtin_amdgcn_logf(1.0f + exp_fast(-fabsf(z))); }
__device__ __forceinline__ float tanh_fast(float x) { return 1.0f - 2.0f * __builtin_amdgcn_rcpf(1.0f + __builtin_amdgcn_exp2f(2.885390081777927f * x)); }
__device__ __forceinline__ void rwkv_phase(unsigned char* lds, const Ptrs& P, const bf16* Rg, const bf16* Kg, const bf16* Vg, const bf16* GBg, const float* small, bf16* Z, const int wave_s) {
    int tid_ = my_tid(wave_s); asm volatile("" : "+v"(tid_)); const int tid = tid_, lane = tid & 63, wv = __builtin_amdgcn_readfirstlane(tid >> 6);
#define RW_BAR() asm volatile("s_waitcnt lgkmcnt(0)\n\ts_barrier" ::: "memory")
    bf16* W2t = (bf16*)lds;
    bf16* A2t = W2t + 64 * 72;
    float* DL = (float*)lds + 4608;
    float* TW = DL + 4096;
    float* AL = TW + 2176;
    float* Rr = AL + 2176;
    float* Vv = Rr + 10240;
    float* Yb = Vv + 2048;
    float* red = Yb + 2048;
    float* Uu = red + 2048;
    float* CC = Uu + 1024;
    float* Cc = CC + 64;
    const int tt = tid >> 4, c4 = (tid & 15) * 4;
    for (int bh = blockIdx.x; bh < 256; bh += gridDim.x) {
        const int b = bh >> 4, h = bh & 15, hc = h * 64 + c4; const size_t rowbase = (size_t)b * T;
        __syncthreads();
        for (int i = tid; i < 4096; i += 512) { const int k = i >> 6, c = i & 63; W2t[c * 72 + k] = (bf16)(cvt_pk_bf16(P.rwkv_w2[(size_t)k * 1024 + h * 64 + c], 0.f) & 0xffffu); A2t[c * 72 + k] = (bf16)(cvt_pk_bf16(P.rwkv_a2[(size_t)k * 1024 + h * 64 + c], 0.f) & 0xffffu); }
        if (tid < 16) { const int cc = tid * 4, hcc = h * 64 + cc;
            *(f32x4*)(Cc + 0 * 64 + cc) = *(const f32x4*)(P.rwkv_mu + hcc); *(f32x4*)(Cc + 1 * 64 + cc) = *(const f32x4*)(P.rwkv_mu + 1024 + hcc); *(f32x4*)(Cc + 2 * 64 + cc) = *(const f32x4*)(P.rwkv_mu + 2048 + hcc);
            *(f32x4*)(Cc + 3 * 64 + cc) = *(const f32x4*)(P.rwkv_mu + 3072 + cc); *(f32x4*)(Cc + 4 * 64 + cc) = *(const f32x4*)(P.rwkv_mu + 3136 + cc);
            *(f32x4*)(Cc + 5 * 64 + cc) = *(const f32x4*)(P.rwkv_w0 + hcc); *(f32x4*)(Cc + 6 * 64 + cc) = *(const f32x4*)(P.rwkv_a0 + hcc); *(f32x4*)(Cc + 7 * 64 + cc) = *(const f32x4*)(P.rwkv_k_k + hcc);
            *(f32x4*)(Cc + 8 * 64 + cc) = *(const f32x4*)(P.rwkv_k_a + hcc); *(f32x4*)(Cc + 9 * 64 + cc) = *(const f32x4*)(P.rwkv_r_k + hcc); *(f32x4*)(Cc + 10 * 64 + cc) = *(const f32x4*)(P.rwkv_ln_g + hcc);
            *(f32x4*)(Cc + 11 * 64 + cc) = *(const f32x4*)(P.rwkv_ln_b + hcc); }
#define CV(k) (*(const f32x4*)(Cc + (k) * 64 + c4))
        f32x4 Sv[4];
#pragma unroll
        for (int g = 0; g < 4; ++g) Sv[g] = (f32x4){0.f, 0.f, 0.f, 0.f};
        { float* const EX = red; const float* exg = (const float*)(P.ws + WS_CTL + 0x100000) + (size_t)(b * 4) * 3200;
          for (int i = tid; i < 1280; i += 512) { const int q = i / 320, cc = i - q * 320; const int col = (cc < 192) ? ((cc >> 6) * 1024 + h * 64 + (cc & 63)) : (3072 + (cc - 192));
              EX[i] = exg[q * 3200 + col] * __builtin_amdgcn_rsqf(((const float*)(P.ws + WS_CTL))[rowbase + q] * (1.f / 2048.f) + 1e-6f); }
          __syncthreads(); }
        u32x2 n_rc, n_kc, n_vc, n_gg, n_rp = {0u, 0u}, n_kp = {0u, 0u}, n_vp = {0u, 0u}; f32x4 n_wl, n_al, n_wlp = {0.f, 0.f, 0.f, 0.f}, n_alp = {0.f, 0.f, 0.f, 0.f};
#define RW_FETCH(ckk) do { const size_t row_ = rowbase + (ckk) * 32 + tt; \
            n_rc = *(const u32x2*)(Rg + row_ * 1024 + hc); n_kc = *(const u32x2*)(Kg + row_ * 1024 + hc); n_vc = *(const u32x2*)(Vg + row_ * 1024 + hc); \
            n_wl = *(const f32x4*)(small + row_ * 256 + c4); n_al = *(const f32x4*)(small + row_ * 256 + 64 + c4); } while (0)
        RW_FETCH(0); n_gg = *(const u32x2*)(GBg + (rowbase + tt) * 1024 + hc);
#define RW_FETCH_PREV(rowp) do { n_rp = *(const u32x2*)(Rg + (rowp) * 1024 + hc); n_kp = *(const u32x2*)(Kg + (rowp) * 1024 + hc); n_vp = *(const u32x2*)(Vg + (rowp) * 1024 + hc); \
            n_wlp = *(const f32x4*)(small + (rowp) * 256 + c4); n_alp = *(const f32x4*)(small + (rowp) * 256 + 64 + c4); } while (0)
        if (tt > 0) RW_FETCH_PREV(rowbase + tt - 1);
        for (int ck = 0; ck < T / 32; ++ck) {
            const int t = ck * 32 + tt; const size_t row = rowbase + t;
            f32x4 rs, ks, vs;
            { const f32x4 mu_r = CV(0), mu_k = CV(1), mu_v = CV(2), mu_w = CV(3), mu_a = CV(4);
              const u32x2 rc = n_rc, kc = n_kc, vc = n_vc, rp = n_rp, kp = n_kp, vp = n_vp; f32x4 wl = n_wl, al = n_al, wlp = n_wlp, alp = n_alp;
              f32x4 rcf = {bflo(rc.x), bfhi(rc.x), bflo(rc.y), bfhi(rc.y)}, rpf = {bflo(rp.x), bfhi(rp.x), bflo(rp.y), bfhi(rp.y)};
              f32x4 kcf = {bflo(kc.x), bfhi(kc.x), bflo(kc.y), bfhi(kc.y)}, kpf = {bflo(kp.x), bfhi(kp.x), bflo(kp.y), bfhi(kp.y)};
              f32x4 vcf = {bflo(vc.x), bfhi(vc.x), bflo(vc.y), bfhi(vc.y)}, vpf = {bflo(vp.x), bfhi(vp.x), bflo(vp.y), bfhi(vp.y)};
              if (t < 4) { const float* ex = red + t * 320; rcf = *(const f32x4*)(ex + c4); kcf = *(const f32x4*)(ex + 64 + c4); vcf = *(const f32x4*)(ex + 128 + c4); wl = *(const f32x4*)(ex + 192 + c4); al = *(const f32x4*)(ex + 256 + c4);
                  if (t > 0) { const float* ep = ex - 320; rpf = *(const f32x4*)(ep + c4); kpf = *(const f32x4*)(ep + 64 + c4); vpf = *(const f32x4*)(ep + 128 + c4); wlp = *(const f32x4*)(ep + 192 + c4); alp = *(const f32x4*)(ep + 256 + c4); } }
              rs = rcf + (rpf - rcf) * mu_r; ks = kcf + (kpf - kcf) * mu_k; vs = vcf + (vpf - vcf) * mu_v;
              wl = wl + (wlp - wl) * mu_w; al = al + (alp - al) * mu_a;
              f32x4 tw; tw[0] = tanh_fast(wl[0]); tw[1] = tanh_fast(wl[1]); tw[2] = tanh_fast(wl[2]); tw[3] = tanh_fast(wl[3]);
              *(f32x4*)(TW + tt * 68 + c4) = tw; *(f32x4*)(AL + tt * 68 + c4) = al; }
            RW_BAR();
            float bon;
            if (wv < 4) { const int mat = wv >> 1, nt = wv & 1, r32 = lane & 31, hi5 = lane >> 5; const float* X = (mat ? AL : TW) + r32 * 68 + 8 * hi5; const bf16* Wt = (mat ? A2t : W2t) + (nt * 32 + r32) * 72 + 8 * hi5;
                f32x16 acc;
#pragma unroll
                for (int r = 0; r < 16; ++r) acc[r] = 0.f;
#pragma unroll
                for (int ks = 0; ks < 4; ++ks) { const f32x4 xa = *(const f32x4*)(X + 16 * ks), xb = *(const f32x4*)(X + 16 * ks + 4);
                    u32x4 ap; ap.x = cvt_pk_bf16(xa[0], xa[1]); ap.y = cvt_pk_bf16(xa[2], xa[3]); ap.z = cvt_pk_bf16(xb[0], xb[1]); ap.w = cvt_pk_bf16(xb[2], xb[3]);
                    const bf16x8 bp = *(const bf16x8*)(Wt + 16 * ks);
                    acc = __builtin_amdgcn_mfma_f32_32x32x16_bf16(__builtin_bit_cast(bf16x8, ap), bp, acc, 0, 0, 0); }
#pragma unroll
                for (int r = 0; r < 16; ++r) DL[mat * 2048 + ((r & 3) + 8 * (r >> 2) + 4 * hi5) * 64 + nt * 32 + r32] = acc[r]; }
            RW_BAR();
            { const f32x4 w0v = CV(5), a0v = CV(6), kkg = CV(7), kag = CV(8), rkg = CV(9); f32x4 wpre = w0v + *(const f32x4*)(DL + tt * 64 + c4), apre = a0v + *(const f32x4*)(DL + 2048 + tt * 64 + c4);
              f32x4 dec, av, kk, kp, bb; float ss = 0.f, bs = 0.f;
#pragma unroll
              for (int i = 0; i < 4; ++i) { const float wraw = -softplusf_(-wpre[i]) - 0.5f; dec[i] = exp_fast(-exp_fast(wraw)); av[i] = __builtin_amdgcn_rcpf(1.f + exp_fast(-apre[i])); kk[i] = ks[i] * kkg[i]; ss += kk[i] * kk[i]; }
              ss = red16(ss); const float inrm = __builtin_amdgcn_rsqf(fmaxf(ss, 1e-24f));
#pragma unroll
              for (int i = 0; i < 4; ++i) { kk[i] *= inrm; kp[i] = ks[i] * (1.f + (av[i] - 1.f) * kag[i]); bb[i] = kk[i] * av[i]; bs += rs[i] * kp[i] * rkg[i]; }
              bon = red16(bs);
              { float* pp = Rr + (tt >> 1) * 640 + (tt & 1) * 64 + c4;
                *(f32x4*)pp = rs; *(f32x4*)(pp + 128) = dec; *(f32x4*)(pp + 256) = kp; *(f32x4*)(pp + 384) = kk; *(f32x4*)(pp + 512) = bb; *(f32x4*)(Vv + tt * 64 + c4) = vs; } }
            RW_BAR();
            { const int p = tid >> 5, j2 = (tid & 31) * 2; float* pb = Rr + p * 640 + j2; typedef float f32x2v __attribute__((ext_vector_type(2)));
              const f32x2v r0 = *(const f32x2v*)pb, r1 = *(const f32x2v*)(pb + 64), w0 = *(const f32x2v*)(pb + 128), w1 = *(const f32x2v*)(pb + 192), k0 = *(const f32x2v*)(pb + 256), k1 = *(const f32x2v*)(pb + 320),
                            q0 = *(const f32x2v*)(pb + 384), q1 = *(const f32x2v*)(pb + 448), b0 = *(const f32x2v*)(pb + 512), b1 = *(const f32x2v*)(pb + 576);
              const f32x2v w1r1 = w1 * r1, B0 = b0 * w1, K0 = k0 * w1;
              *(f32x2v*)pb = q0; *(f32x2v*)(pb + 64) = w0 * q1; *(f32x2v*)(pb + 128) = w0 * r0; *(f32x2v*)(pb + 192) = w0 * w1r1;
              *(f32x2v*)(pb + 256) = w0 * w1; *(f32x2v*)(pb + 320) = B0; *(f32x2v*)(pb + 384) = K0; *(f32x2v*)(pb + 448) = b1; *(f32x2v*)(pb + 512) = k1;
              float d[8] = { b0.x * q1.x + b0.y * q1.y, k0.x * q1.x + k0.y * q1.y, b0.x * r0.x + b0.y * r0.y, k0.x * r0.x + k0.y * r0.y,
                             B0.x * r1.x + B0.y * r1.y, K0.x * r1.x + K0.y * r1.y, b1.x * r1.x + b1.y * r1.y, k1.x * r1.x + k1.y * r1.y };
              { const bool h16 = (lane & 16) != 0, h8 = (lane & 8) != 0, h4 = (lane & 4) != 0;
#pragma unroll
                for (int e = 0; e < 4; ++e) { const float snd = h16 ? d[e] : d[e + 4], kp_ = h16 ? d[e + 4] : d[e]; d[e] = kp_ + __shfl_xor(snd, 16); }
#pragma unroll
                for (int e = 0; e < 2; ++e) { const float snd = h8 ? d[e] : d[e + 2], kp_ = h8 ? d[e + 2] : d[e]; d[e] = kp_ + __shfl_xor(snd, 8); }
                { const float snd = h4 ? d[0] : d[1], kp_ = h4 ? d[1] : d[0]; d[0] = kp_ + __shfl_xor(snd, 4); }
                d[0] += __shfl_xor(d[0], 2); d[0] += __shfl_xor(d[0], 1);
                if ((lane & 3) == 0) Uu[p * 8 + (h16 ? 4 : 0) + (h8 ? 2 : 0) + (h4 ? 1 : 0)] = d[0]; } }
            RW_BAR();
            if (ck + 1 < T / 32) RW_FETCH(ck + 1);
            const int j0 = 16 * (wv & 3);
#define RW_LD16(dst, base) do { _Pragma("unroll") for (int g_ = 0; g_ < 4; ++g_) dst[g_] = *(const f32x4*)((base) + j0 + 4 * g_); } while (0)
#define RW_DOT16(x) ({ f32x4 a_ = Sv[0] * x[0] + Sv[1] * x[1] + Sv[2] * x[2] + Sv[3] * x[3]; (a_[0] + a_[1]) + (a_[2] + a_[3]); })
#pragma unroll 1
            for (int p = 0; p < 16; ++p) {
                const int par = (p & 1) * 1024; const float* pb = Rr + p * 640; const float* sc = Uu + p * 8;
                if (wv < 4) {
                    { f32x4 d0[4], d1[4], d2[4], d3[4]; RW_LD16(d0, pb); RW_LD16(d1, pb + 64); RW_LD16(d2, pb + 128); RW_LD16(d3, pb + 192);
                      red[par + wv * 64 + lane] = RW_DOT16(d0); red[par + 256 + wv * 64 + lane] = RW_DOT16(d1); red[par + 512 + wv * 64 + lane] = RW_DOT16(d2); red[par + 768 + wv * 64 + lane] = RW_DOT16(d3); }
                    asm volatile("" ::: "memory");
                    f32x4 u0[4], u1[4], u2[4], u3[4], u4[4]; RW_LD16(u0, pb + 256); RW_LD16(u1, pb + 320); RW_LD16(u2, pb + 384); RW_LD16(u3, pb + 448); RW_LD16(u4, pb + 512);
                    const float v0 = Vv[(2 * p) * 64 + lane], v1 = Vv[(2 * p + 1) * 64 + lane], c1 = sc[0], c2 = sc[1];
                    RW_BAR();
                    const float sa0 = (red[par + lane] + red[par + 64 + lane]) + (red[par + 128 + lane] + red[par + 192 + lane]);
                    const float q = (red[par + 256 + lane] + red[par + 320 + lane]) + (red[par + 384 + lane] + red[par + 448 + lane]);
                    const float sa1 = q - sa0 * c1 + v0 * c2;
#pragma unroll
                    for (int g = 0; g < 4; ++g) Sv[g] = Sv[g] * u0[g] - sa0 * u1[g] + v0 * u2[g] - sa1 * u3[g] + v1 * u4[g];
                } else {
                    RW_BAR();
                    if (wv < 6) {
                        const float v0 = Vv[(2 * p) * 64 + lane];
                        const float sa0 = (red[par + lane] + red[par + 64 + lane]) + (red[par + 128 + lane] + red[par + 192 + lane]);
                        if (wv == 4) { const float y0 = (red[par + 512 + lane] + red[par + 576 + lane]) + (red[par + 640 + lane] + red[par + 704 + lane]);
                            Yb[(2 * p) * 64 + lane] = y0 - sa0 * sc[2] + v0 * sc[3]; }
                        else { const float v1 = Vv[(2 * p + 1) * 64 + lane];
                            const float q = (red[par + 256 + lane] + red[par + 320 + lane]) + (red[par + 384 + lane] + red[par + 448 + lane]);
                            const float sa1 = q - sa0 * sc[0] + v0 * sc[1];
                            const float y1 = (red[par + 768 + lane] + red[par + 832 + lane]) + (red[par + 896 + lane] + red[par + 960 + lane]);
                            Yb[(2 * p + 1) * 64 + lane] = y1 - sa0 * sc[4] + v0 * sc[5] - sa1 * sc[6] + v1 * sc[7]; } }
                    else if (p == 0) {
                        const size_t i8 = ((size_t)((blockIdx.x * 2 + (wv - 6)) * 64 + ck)) * 64 + lane;
                        const f32x4 pa = *(const f32x4*)(P.p + i8 * 8), pq = *(const f32x4*)(P.p + i8 * 8 + 4);
                        *(u32x4*)((bf16*)(P.ws + WS_PB) + i8 * 8) = pg8::pack8(pa, pq); } }
            }
            if (ck + 1 < T / 32) RW_FETCH_PREV(row + 31);
            RW_BAR();
#undef RW_LD16
#undef RW_BAR
#undef RW_DOT16
            { const f32x4 lng = CV(10), lnb = CV(11); const f32x4 y4 = *(const f32x4*)(Yb + tt * 64 + c4); const float mean = red16((y4[0] + y4[1]) + (y4[2] + y4[3])) * (1.f / 64.f);
              const f32x4 d = y4 - mean; const float var = red16((d[0] * d[0] + d[1] * d[1]) + (d[2] * d[2] + d[3] * d[3])) * (1.f / 64.f); const float rstd = __builtin_amdgcn_rsqf(var + 64e-5f);
              const u32x2 gg = n_gg; if (ck + 1 < T / 32) n_gg = *(const u32x2*)(GBg + (row + 32) * 1024 + hc);
              const float g0 = bflo(gg.x), g1 = bfhi(gg.x), g2 = bflo(gg.y), g3 = bfhi(gg.y);
              const float z0 = (d[0] * rstd * lng[0] + lnb[0] + bon * vs[0]) * g0 * sigm(g0), z1 = (d[1] * rstd * lng[1] + lnb[1] + bon * vs[1]) * g1 * sigm(g1);
              const float z2 = (d[2] * rstd * lng[2] + lnb[2] + bon * vs[2]) * g2 * sigm(g2), z3 = (d[3] * rstd * lng[3] + lnb[3] + bon * vs[3]) * g3 * sigm(g3);
              u32x2 w; w.x = cvt_pk_bf16(z0, z1); w.y = cvt_pk_bf16(z2, z3); *(u32x2*)(Z + row * 2048 + 1024 + hc) = w; }
        }
    }
}

#undef RW_FETCH
#undef RW_FETCH_PREV
#undef CV
__device__ __forceinline__ void gmlp_phase(unsigned char* lds, const Ptrs& P, const bf16* Ug, const bf16* Vg, const bf16* Gg, const float* vsum, const float* vsq, bf16* Z, const int wave_s) {
    int tid_ = my_tid(wave_s); asm volatile("" : "+v"(tid_)); const int tid = tid_, lane = tid & 63, wid = __builtin_amdgcn_readfirstlane(tid >> 6), r32 = lane & 31, hi = lane >> 5;
    bf16* As = (bf16*)lds;
    bf16* Bt = As + 128 * 136;
    float* Ds = (float*)(lds + 2 * 128 * 136 * 2 + 256);
    int gcur = -1;
    for (int u = blockIdx.x; u < 4096; u += gridDim.x) {
        const int g = u & 15, bn = u >> 4; const size_t row0 = (size_t)bn * 128; const int C0 = g * 128;
        __syncthreads();
        if (g != gcur) { gcur = g; const float* ws_ = P.c_w_s + (size_t)g * 128 * 128;
            for (int i = tid; i < 128 * 128 / 4; i += 512) { const int t = i >> 5, s4 = (i & 31) * 4; f32x4 w = *(const f32x4*)(ws_ + t * 128 + s4);
                u32x2 o; o.x = cvt_pk_bf16(s4 + 0 <= t ? w[0] : 0.f, s4 + 1 <= t ? w[1] : 0.f); o.y = cvt_pk_bf16(s4 + 2 <= t ? w[2] : 0.f, s4 + 3 <= t ? w[3] : 0.f); *(u32x2*)(As + t * 136 + s4) = o; } }
#pragma unroll
        for (int it = 0; it < 4; ++it) { const int i = tid + it * 512, s = i >> 4, c8 = (i & 15) * 8; const size_t row = row0 + s;
            const float mean = vsum[row] * (1.f / 2048.f), var = vsq[row] * (1.f / 2048.f) - mean * mean, rstd = __builtin_amdgcn_rsqf(fmaxf(var, 0.f) + 1e-5f);
            const u32x4 vv = *(const u32x4*)(Vg + row * 2048 + C0 + c8); const f32x4 lg0 = *(const f32x4*)(P.c_ln_g + C0 + c8), lg1 = *(const f32x4*)(P.c_ln_g + C0 + c8 + 4), lb0 = *(const f32x4*)(P.c_ln_b + C0 + c8), lb1 = *(const f32x4*)(P.c_ln_b + C0 + c8 + 4);
            float x[8] = {bflo(vv.x), bfhi(vv.x), bflo(vv.y), bfhi(vv.y), bflo(vv.z), bfhi(vv.z), bflo(vv.w), bfhi(vv.w)};
#pragma unroll
            for (int j = 0; j < 8; ++j) { const float gn = (x[j] - mean) * rstd * (j < 4 ? lg0[j & 3] : lg1[j & 3]) + (j < 4 ? lb0[j & 3] : lb1[j & 3]); const float nb = __shfl_xor(gn, 0); (void)nb;
                Bt[(c8 + j) * 136 + (c8 >> 3) * 8 + s] = (bf16)(cvt_pk_bf16(gn, 0.f) & 0xffffu); } }
        __syncthreads();
        { const int tb = wid >> 1, cb = (wid & 1) * 64; f32x16 d0, d1;
#pragma unroll
          for (int r = 0; r < 16; ++r) { d0[r] = 0.f; d1[r] = 0.f; }
          for (int k = 0; k <= 2 * tb + 1; ++k) {
              const bf16x8 a = *(const bf16x8*)(As + (32 * tb + r32) * 136 + 16 * k + 8 * hi);
              const bf16x8 b0 = *(const bf16x8*)(Bt + (cb + r32) * 136 + ((cb + r32) >> 3) * 8 + 16 * k + 8 * hi), b1 = *(const bf16x8*)(Bt + (cb + 32 + r32) * 136 + ((cb + 32 + r32) >> 3) * 8 + 16 * k + 8 * hi);
              d0 = __builtin_amdgcn_mfma_f32_32x32x16_bf16(a, b0, d0, 0, 0, 0); d1 = __builtin_amdgcn_mfma_f32_32x32x16_bf16(a, b1, d1, 0, 0, 0); }
#pragma unroll
          for (int r = 0; r < 16; ++r) { const int t = 32 * tb + crow(r, hi); Ds[t * 132 + cb + r32] = d0[r]; Ds[t * 132 + cb + 32 + r32] = d1[r]; } }
        __syncthreads();
#pragma unroll
        for (int it = 0; it < 4; ++it) { const int i = tid + it * 512, t = i >> 4, c8 = (i & 15) * 8; const size_t off = (row0 + t) * 2048 + C0 + c8;
            const float bs = P.c_b_s[g * 128 + t]; const u32x4 uu = *(const u32x4*)(Ug + off), gg = *(const u32x4*)(Gg + off);
            const f32x4 da = *(const f32x4*)(Ds + t * 132 + c8), db = *(const f32x4*)(Ds + t * 132 + c8 + 4); u32x4 o;
            o.x = cvt_pk_bf16(bflo(uu.x) * (da[0] + bs) * bflo(gg.x), bfhi(uu.x) * (da[1] + bs) * bfhi(gg.x)); o.y = cvt_pk_bf16(bflo(uu.y) * (da[2] + bs) * bflo(gg.y), bfhi(uu.y) * (da[3] + bs) * bfhi(gg.y));
            o.z = cvt_pk_bf16(bflo(uu.z) * (db[0] + bs) * bflo(gg.z), bfhi(uu.z) * (db[1] + bs) * bfhi(gg.z)); o.w = cvt_pk_bf16(bflo(uu.w) * (db[2] + bs) * bflo(gg.w), bfhi(uu.w) * (db[3] + bs) * bfhi(gg.w));
            *(u32x4*)(Z + off) = o; }
    }
}

__global__ void __launch_bounds__(512, 2) mega_fwd(Ptrs P) {
    extern __shared__ __attribute__((aligned(16))) unsigned char lds[];
    cg::grid_group grid = cg::this_grid();
    const int wave_s = __builtin_amdgcn_readfirstlane((int)threadIdx.x >> 6);
    unsigned char* ws = P.ws;
    float* ctl = (float*)(ws + WS_CTL);
    float *ssq0 = ctl, *ssqA = ctl + M, *ssqB = ctl + 2 * M, *ssqC = ctl + 3 * M, *vsum = ctl + 4 * M, *vsq = ctl + 5 * M;
    bf16* G = (bf16*)(ws + WS_G); const size_t GS = (size_t)M * 1024;
    bf16* HBA = (bf16*)(ws + WS_HBA); bf16* PB = (bf16*)(ws + WS_PB); float* SMALL = (float*)(ws + WS_SMALL); bf16* Zb = (bf16*)(ws + WS_Z);
    bf16* Y0 = G; bf16* PP0 = G + 2 * GS; bf16* HBB = G + 6 * GS;
    bf16* U_u = G; bf16* U_v = G + 2 * GS; bf16* U_g = G + 4 * GS;
    bf16* Y1 = G + 6 * GS; bf16* PP1 = G;
    const int lo = P.ph_lo, hi = P.ph_hi;
    PG8_LAS unsigned char* lds3 = (PG8_LAS unsigned char*)lds;
#define IN(k) (lo <= (k) && (k) < hi)
    unsigned* const gbar = (unsigned*)(ws + WS_CTL + 0x1F0000);
#define SEAM(k) do { if (IN(k) && IN((k) + 1)) { if ((k) == 0) grid.sync(); else { \
        asm volatile("s_waitcnt vmcnt(0) lgkmcnt(0)" ::: "memory"); __syncthreads(); \
        if (my_tid(wave_s) == 0) { __builtin_amdgcn_fence(__ATOMIC_RELEASE, "agent"); asm volatile("s_waitcnt vmcnt(0)" ::: "memory"); \
            __hip_atomic_fetch_add(gbar, 1u, __ATOMIC_RELAXED, __HIP_MEMORY_SCOPE_AGENT); \
            while (__hip_atomic_load(gbar, __ATOMIC_RELAXED, __HIP_MEMORY_SCOPE_AGENT) < 256u * (unsigned)(k)) __builtin_amdgcn_s_sleep(4); \
            __builtin_amdgcn_fence(__ATOMIC_ACQUIRE, "agent"); asm volatile("s_waitcnt vmcnt(0)" ::: "memory"); } \
        __syncthreads(); } } } while (0)
    if (IN(0)) { p0_prologue(P, lds, wave_s); } SEAM(0);
    if (IN(1)) { pg8::Gemm g{HBA, (const bf16*)(ws + WS_WIN0), M, N_IN0, 2048}; pg8::StaticOrder S; S.init(M, N_IN0, gridDim.x, blockIdx.x);
        pg8::EpiIn0 E{G, SMALL, ssq0, 0.125f * LOG2E}; pg8::gemm_phase<pg8::EpiIn0, pg8::StaticOrder, true, true>(lds3, g, S, E, my_tid(wave_s)); } SEAM(1);
    if (IN(2)) { attn_phase(lds, G, G + GS, G + 2 * GS, G + 3 * GS, SMALL, P.fox_f_bias, Zb, wave_s);
        rwkv_phase(lds, P, G + 4 * GS, G + 5 * GS, G + 6 * GS, G + 7 * GS, SMALL, Zb, wave_s); } SEAM(2);
    if (IN(3)) { { pg8::Gemm g{Zb, (const bf16*)(ws + WS_WOUT0), M, 2048, 2048}; pg8::StaticOrder S; S.init(M, 2048, gridDim.x, blockIdx.x);
          pg8::EpiY E{Y0, ssqA}; pg8::gemm_phase<pg8::EpiY, pg8::StaticOrder, true, true>(lds3, g, S, E, my_tid(wave_s)); }
        { pg8::Gemm g{PB, (const bf16*)(ws + WS_WP0), M, 2048, 256}; pg8::StaticOrder S; S.init(M, 2048, gridDim.x, blockIdx.x);
          pg8::EpiBf16<0> E{PP0, 2048, nullptr, 0, 0, 1.f}; pg8::gemm_phase<pg8::EpiBf16<0>, pg8::StaticOrder, true, true>(lds3, g, S, E, my_tid(wave_s)); } } SEAM(3);
    if (IN(4)) { post_norm_phase<true>(P.x, Y0, ssqA, P.norm_post, P.out, HBA, wave_s); } SEAM(4);
    if (IN(5)) { pg8::Gemm g{HBA, (const bf16*)(ws + WS_WG0), M, 2048, 2048}; pg8::StaticOrder S; S.init(M, 2048, gridDim.x, blockIdx.x);
        pg8::EpiGate E{P.x, P.out, Y0, ssqA, P.norm_post, PP0, HBB, ssqB}; pg8::gemm_phase<pg8::EpiGate, pg8::StaticOrder, true, true>(lds3, g, S, E, my_tid(wave_s)); } SEAM(5);
    if (IN(6)) { pg8::Gemm g{HBB, (const bf16*)(ws + WS_WIN1), M, 6144, 2048}; pg8::StaticOrder S; S.init(M, 6144, gridDim.x, blockIdx.x);
        pg8::EpiC E{U_u, 2 * GS, ssqB, vsum, vsq}; pg8::gemm_phase<pg8::EpiC, pg8::StaticOrder, true, true>(lds3, g, S, E, my_tid(wave_s)); } SEAM(6);
    if (IN(7)) { gmlp_phase(lds, P, U_u, U_v, U_g, vsum, vsq, Zb, wave_s); } SEAM(7);
    if (IN(8)) { { pg8::Gemm g{Zb, (const bf16*)(ws + WS_WOUT1), M, 2048, 2048}; pg8::StaticOrder S; S.init(M, 2048, gridDim.x, blockIdx.x);
          pg8::EpiY E{Y1, ssqC}; pg8::gemm_phase<pg8::EpiY, pg8::StaticOrder, true, true>(lds3, g, S, E, my_tid(wave_s)); }
        { pg8::Gemm g{PB + (size_t)M * 256, (const bf16*)(ws + WS_WP1), M, 2048, 256}; pg8::StaticOrder S; S.init(M, 2048, gridDim.x, blockIdx.x);
          pg8::EpiBf16<0> E{PP1, 2048, nullptr, 0, 0, 1.f}; pg8::gemm_phase<pg8::EpiBf16<0>, pg8::StaticOrder, true, true>(lds3, g, S, E, my_tid(wave_s)); } } SEAM(8);
    if (IN(9)) { post_norm_phase<false>(P.out, Y1, ssqC, P.norm_post + 2048, P.out, HBA, wave_s); } SEAM(9);
    if (IN(10)) { pg8::Gemm g{HBA, (const bf16*)(ws + WS_WG1), M, 2048, 2048}; pg8::StaticOrder S; S.init(M, 2048, gridDim.x, blockIdx.x);
        pg8::EpiGate E{P.out, P.out, Y1, ssqC, P.norm_post + 2048, PP1, nullptr, nullptr}; pg8::gemm_phase<pg8::EpiGate, pg8::StaticOrder, true, true>(lds3, g, S, E, my_tid(wave_s)); }
#undef IN
#undef SEAM
}

#ifndef MK_PER_PHASE
#define MK_PER_PHASE 0
#endif
constexpr int N_PHASES = 11;
extern "C" void kernel_launch(void* const* d_in, const int* in_sizes, int n_in, void* d_out, int out_size, void* d_ws, size_t ws_size, hipStream_t stream) {
    static int grid = 0;
    if (grid == 0) {
        if (n_in != 25 || ws_size < WS_END) { fprintf(stderr, "kernel_launch: need 25 inputs and %zu bytes of workspace (got %d, %zu)\n", (size_t)WS_END, n_in, ws_size); grid = -1; return; }
        int dev = 0, cus = 0, per_cu = 0;
        hipGetDevice(&dev); hipDeviceGetAttribute(&cus, hipDeviceAttributeMultiprocessorCount, dev);
        if (hipFuncSetAttribute((const void*)mega_fwd, hipFuncAttributeMaxDynamicSharedMemorySize, LDS_BYTES) != hipSuccess) { fprintf(stderr, "kernel_launch: hipFuncSetAttribute failed\n"); grid = -1; return; }
        hipOccupancyMaxActiveBlocksPerMultiprocessor(&per_cu, (const void*)mega_fwd, 512, LDS_BYTES);
        (void)hipGetLastError();
        if (per_cu < 1) { fprintf(stderr, "kernel_launch: occupancy query says %d blocks per CU\n", per_cu); per_cu = 1; }
        if (cus < 256) { fprintf(stderr, "kernel_launch: built for a 256-CU device (got %d CUs)\n", cus); grid = -1; return; }
        grid = 256;
    }
    if (grid < 0) return;
    (void)hipMemsetAsync((char*)d_ws + WS_CTL + 0x1F0000, 0, 256, stream);
    Ptrs p{};
    const float** pp = (const float**)&p;
    for (int i = 0; i < 25; ++i) pp[i] = (const float*)d_in[i];
    p.out = (float*)d_out; p.ws = (unsigned char*)d_ws;
#if MK_PER_PHASE
    for (int k = 0; k < N_PHASES; ++k) { p.ph_lo = k; p.ph_hi = k + 1; hipLaunchKernelGGL(mega_fwd, dim3(grid), dim3(512), LDS_BYTES, stream, p); }
#else
    p.ph_lo = 0; p.ph_hi = N_PHASES;
    void* args[] = {&p};
    hipError_t e = hipLaunchCooperativeKernel((const void*)mega_fwd, dim3(grid), dim3(512), args, LDS_BYTES, stream);
    if (e != hipSuccess) fprintf(stderr, "cooperative launch failed: %s (grid %d)\n", hipGetErrorString(e), grid);
#endif
}
```

```cpp
#include <hip/hip_runtime.h>
#include <hip/hip_cooperative_groups.h>
#include <cstdio>
#include <cstdint>
namespace cg = cooperative_groups;
namespace pg8 {
#define PG8_LAS __attribute__((address_space(3)))
typedef unsigned short bf16_t;
typedef short bf16x8 __attribute__((ext_vector_type(8)));
typedef float f32x4 __attribute__((ext_vector_type(4)));
typedef unsigned u32x4 __attribute__((ext_vector_type(4)));
constexpr int BM = 256, BK = 64, HALF = 128, HTB = HALF * BK * 2  , STAGE_BYTES = 8 * HTB, NXCD = 8, WGM = 8;

__host__ __device__ __forceinline__ int lds_byte(int r, int c) { const int st = (r >> 4) * 2 + (c >> 5), rr = r & 15, cc = c & 31, ob = rr * 64 + cc * 2; return st * 1024 + (ob ^ (((ob >> 9) & 1) << 5)); }
__host__ __device__ __forceinline__ void stage_rc(int b, int& R, int& C) { const int st = b / 1024, sb = b % 1024, swz = sb ^ (((sb >> 9) & 1) << 5); R = (st >> 1) * 16 + swz / 64; C = (st & 1) * 32 + (swz % 64) / 2; }
__host__ __device__ __forceinline__ int perm32(int rho) { const int n = rho >> 4, i = rho & 15; return 8 * (i >> 2) + 4 * n + (i & 3); }

struct Unit { int pm, pn; };
struct Gemm { const bf16_t* A; const bf16_t* Bt; int M, N, K; };

struct StaticOrder {
    int nM, nN, nwg, G, c;
    __host__ __device__ void init(int M, int N, int G_, int c_) { nM = M / BM; nN = N / BM; nwg = nM * nN; G = G_; c = c_; }
    __host__ __device__ bool next(int i, Unit& u) const {
        const long L = (long)i * G + c; if (L >= nwg) return false;
        int wgid = (int)L; { const int q = nwg / NXCD, r = nwg % NXCD, xcd = wgid % NXCD, off = wgid / NXCD; wgid = (xcd < r ? xcd * (q + 1) : r * (q + 1) + (xcd - r) * q) + off; }
        const int nig = WGM * nN, gid = wgid / nig, fm = gid * WGM, gsz = (nM - fm) < WGM ? (nM - fm) : WGM;
        u.pm = fm + ((wgid % nig) % gsz); u.pn = (wgid % nig) / gsz; return true;
    }
    __device__ __forceinline__ void a_ready(const Unit&) const {}
    __device__ __forceinline__ void done(const Unit&) const {}
};

__device__ __forceinline__ unsigned cvt_pk_bf16(float lo, float hi) { unsigned r; asm volatile("v_cvt_pk_bf16_f32 %0, %1, %2" : "=v"(r) : "v"(lo), "v"(hi)); return r; }
typedef float f32x2 __attribute__((ext_vector_type(2)));
__device__ __forceinline__ f32x2 gelu_pk(f32x2 v) {
    const f32x2 av = __builtin_elementwise_abs(v), d = av * 0.2316418882f + 1.0f;
    f32x2 t; t.x = __builtin_amdgcn_rcpf(d.x); t.y = __builtin_amdgcn_rcpf(d.y);
    f32x2 q = t * 0.5307027145f + (-0.7265760135f); q = q * t + 0.7107068705f; q = q * t + (-0.142248368f); q = q * t + 0.127414796f; q = q * t;
    const f32x2 s = (v * v) * (-0.72134752044f);
    f32x2 e; e.x = __builtin_amdgcn_exp2f(s.x); e.y = __builtin_amdgcn_exp2f(s.y);
    const f32x2 m = v * (q * e), r = v - m;
    f32x2 o; o.x = v.x < 0.f ? m.x : r.x; o.y = v.y < 0.f ? m.y : r.y; return o;
}
template <int ACT  > struct EpiBf16 {
    static constexpr bool PERM = true, AFTER_DRAIN = false; static_assert(ACT == 0 || ACT == 1, "EpiBf16: ACT is 0 (none) or 1 (gelu_pk)");
    bf16_t* O; int ldc; const float* bias; int split_cols; size_t split_stride; float scale0;
    __device__ __forceinline__ void operator()(const f32x4 (&acc)[2][2][4][2], const Unit& u, int wr, int wc, int fr, int fq) const {
        const int row0 = u.pm * BM + wr * 64 + fr; int colt = u.pn * BM; bf16_t* base = O;
        float sc = 1.f; if (split_cols) { const int t = colt / split_cols; base += (size_t)t * split_stride; colt -= t * split_cols; if (t == 0) sc = scale0; }
        const int col0 = colt + wc * 32 + 8 * fq, bcol0 = u.pn * BM + wc * 32 + 8 * fq;
        f32x4 bv[2][2];
#pragma unroll
        for (int bj = 0; bj < 2; ++bj)
#pragma unroll
            for (int n = 0; n < 2; ++n) bv[bj][n] = bias ? *(const f32x4*)(bias + bcol0 + bj * HALF + 4 * n) : (f32x4){0.f, 0.f, 0.f, 0.f};
#pragma unroll
        for (int ai = 0; ai < 2; ++ai)
#pragma unroll
            for (int m = 0; m < 4; ++m) { bf16_t* rowp = base + (size_t)(row0 + ai * HALF + m * 16) * ldc + col0;
#pragma unroll
                for (int bj = 0; bj < 2; ++bj) { f32x4 v0 = acc[ai][bj][m][0] + bv[bj][0], v1 = acc[ai][bj][m][1] + bv[bj][1];
                    if (ACT == 1) { f32x2 a = gelu_pk((f32x2){v0[0], v0[1]}), b = gelu_pk((f32x2){v0[2], v0[3]}), c = gelu_pk((f32x2){v1[0], v1[1]}), d = gelu_pk((f32x2){v1[2], v1[3]});
                        v0 = (f32x4){a.x, a.y, b.x, b.y}; v1 = (f32x4){c.x, c.y, d.x, d.y}; }
                    v0 = v0 * sc; v1 = v1 * sc; u32x4 w; w.x = cvt_pk_bf16(v0[0], v0[1]); w.y = cvt_pk_bf16(v0[2], v0[3]); w.z = cvt_pk_bf16(v1[0], v1[1]); w.w = cvt_pk_bf16(v1[2], v1[3]);
                    *(u32x4*)(rowp + bj * HALF) = w; } }
    }
};
__device__ __forceinline__ u32x4 pack8(const f32x4 v0, const f32x4 v1) { u32x4 w; w.x = cvt_pk_bf16(v0[0], v0[1]); w.y = cvt_pk_bf16(v0[2], v0[3]); w.z = cvt_pk_bf16(v1[0], v1[1]); w.w = cvt_pk_bf16(v1[2], v1[3]); return w; }
__device__ __forceinline__ float bflo(unsigned u) { return __uint_as_float(u << 16); }
__device__ __forceinline__ float bfhi(unsigned u) { return __uint_as_float(u & 0xffff0000u); }
__device__ __forceinline__ float sigm(float x) { return __builtin_amdgcn_rcpf(1.0f + __builtin_amdgcn_exp2f(-1.4426950408889634f * x)); }
#define PG8_FOR_AI_M _Pragma("unroll") for (int ai = 0; ai < 2; ++ai) _Pragma("unroll") for (int m = 0; m < 4; ++m)
struct EpiIn0 {
    static constexpr bool PERM = true, AFTER_DRAIN = false;
    bf16_t* G; float* small; const float* ssq; float qscale;
    __device__ __forceinline__ void operator()(const f32x4 (&acc)[2][2][4][2], const Unit& u, int wr, int wc, int fr_, int fq_) const {
        int fr = fr_, fq = fq_; asm volatile("" : "+v"(fr), "+v"(fq));
        const int row0 = u.pm * BM + wr * 64 + fr, ct = wc * 32 + 8 * fq;
        float rsv[2][4];
        PG8_FOR_AI_M rsv[ai][m] = __builtin_amdgcn_rsqf(ssq[row0 + ai * HALF + m * 16] * (1.f / 2048.f) + 1e-6f);
        if (u.pn < 32) {
            const int grp = u.pn >> 2; bf16_t* base = G + (size_t)grp * ((size_t)32768 * 1024) + (u.pn & 3) * 256 + ct; const float sc0 = (grp == 0) ? qscale : 1.f;
            PG8_FOR_AI_M { const int row = row0 + ai * HALF + m * 16; const float rs = rsv[ai][m] * sc0; bf16_t* rp = base + (size_t)row * 1024;
#pragma unroll
                for (int bj = 0; bj < 2; ++bj) *(u32x4*)(rp + bj * HALF) = pack8(acc[ai][bj][m][0] * rs, acc[ai][bj][m][1] * rs); }
        } else {
            PG8_FOR_AI_M { const int row = row0 + ai * HALF + m * 16; const float rs = rsv[ai][m]; float* rp = small + (size_t)row * 256 + ct;
#pragma unroll
                for (int bj = 0; bj < 2; ++bj) { *(f32x4*)(rp + bj * HALF) = acc[ai][bj][m][0] * rs; *(f32x4*)(rp + bj * HALF + 4) = acc[ai][bj][m][1] * rs; } }
        }
    }
};
struct EpiY {
    static constexpr bool PERM = true, AFTER_DRAIN = false;
    bf16_t* Y; float* ssq;
    __device__ __forceinline__ void operator()(const f32x4 (&acc)[2][2][4][2], const Unit& u, int wr, int wc, int fr_, int fq_) const {
        int fr = fr_, fq = fq_; asm volatile("" : "+v"(fr), "+v"(fq));
        const int row0 = u.pm * BM + wr * 64 + fr, col0 = u.pn * BM + wc * 32 + 8 * fq;
        PG8_FOR_AI_M { const int row = row0 + ai * HALF + m * 16; float s = 0.f; bf16_t* rp = Y + (size_t)row * 2048 + col0;
#pragma unroll
            for (int bj = 0; bj < 2; ++bj) { const f32x4 v0 = acc[ai][bj][m][0], v1 = acc[ai][bj][m][1];
                s += (v0[0] * v0[0] + v0[1] * v0[1]) + (v0[2] * v0[2] + v0[3] * v0[3]) + (v1[0] * v1[0] + v1[1] * v1[1]) + (v1[2] * v1[2] + v1[3] * v1[3]);
                *(u32x4*)(rp + bj * HALF) = pack8(v0, v1); }
            s += __shfl_xor(s, 16); s += __shfl_xor(s, 32);
            if (fq == 0) __hip_atomic_fetch_add(ssq + row, s, __ATOMIC_RELAXED, __HIP_MEMORY_SCOPE_AGENT); }
    }
};
struct EpiGate {
    static constexpr bool PERM = true, AFTER_DRAIN = false;
    const float* Hin; float* Hout; const bf16_t* Y; const float* ssqY; const float* gpost; const bf16_t* PP; bf16_t* HB; float* ssq;
    __device__ __forceinline__ void operator()(const f32x4 (&acc)[2][2][4][2], const Unit& u, int wr, int wc, int fr_, int fq_) const {
        int fr = fr_, fq = fq_; asm volatile("" : "+v"(fr), "+v"(fq));
        const int row0 = u.pm * BM + wr * 64 + fr, col0 = u.pn * BM + wc * 32 + 8 * fq;
        f32x4 gv[2][2];
#pragma unroll
        for (int bj = 0; bj < 2; ++bj) { gv[bj][0] = *(const f32x4*)(gpost + col0 + bj * HALF); gv[bj][1] = *(const f32x4*)(gpost + col0 + bj * HALF + 4); }
#pragma unroll
        for (int ai = 0; ai < 2; ++ai)
#pragma unroll
            for (int mp = 0; mp < 2; ++mp) {
                f32x4 hh[2][2][2]; u32x4 pq[2][2], yq[2][2]; float rsq[2];
#pragma unroll
                for (int mm = 0; mm < 2; ++mm) { const int row = row0 + ai * HALF + (2 * mp + mm) * 16; rsq[mm] = __builtin_amdgcn_rsqf(ssqY[row] * (1.f / 2048.f) + 1e-6f);
#pragma unroll
                    for (int bj = 0; bj < 2; ++bj) { const size_t off = (size_t)row * 2048 + col0 + bj * HALF;
                        hh[mm][bj][0] = *(const f32x4*)(Hin + off); hh[mm][bj][1] = *(const f32x4*)(Hin + off + 4); pq[mm][bj] = *(const u32x4*)(PP + off); yq[mm][bj] = *(const u32x4*)(Y + off); } }
#pragma unroll
                for (int mm = 0; mm < 2; ++mm) { const int m = 2 * mp + mm; const int row = row0 + ai * HALF + m * 16; float s = 0.f; const float rs = rsq[mm];
#pragma unroll
                    for (int bj = 0; bj < 2; ++bj) { const size_t off = (size_t)row * 2048 + col0 + bj * HALF; float* hp = Hout + off;
                        const u32x4 pp = pq[mm][bj], yy = yq[mm][bj]; const f32x4 g0 = gv[bj][0] * rs, g1 = gv[bj][1] * rs; f32x4 h0 = hh[mm][bj][0], h1 = hh[mm][bj][1];
                        h0[0] += bflo(yy.x) * g0[0]; h0[1] += bfhi(yy.x) * g0[1]; h0[2] += bflo(yy.y) * g0[2]; h0[3] += bfhi(yy.y) * g0[3];
                        h1[0] += bflo(yy.z) * g1[0]; h1[1] += bfhi(yy.z) * g1[1]; h1[2] += bflo(yy.w) * g1[2]; h1[3] += bfhi(yy.w) * g1[3];
                        const f32x4 a0 = acc[ai][bj][m][0], a1 = acc[ai][bj][m][1]; f32x4 o0, o1;
                        o0[0] = h0[0] + bflo(pp.x) * sigm(a0[0]); o0[1] = h0[1] + bfhi(pp.x) * sigm(a0[1]); o0[2] = h0[2] + bflo(pp.y) * sigm(a0[2]); o0[3] = h0[3] + bfhi(pp.y) * sigm(a0[3]);
                        o1[0] = h1[0] + bflo(pp.z) * sigm(a1[0]); o1[1] = h1[1] + bfhi(pp.z) * sigm(a1[1]); o1[2] = h1[2] + bflo(pp.w) * sigm(a1[2]); o1[3] = h1[3] + bfhi(pp.w) * sigm(a1[3]);
                        *(f32x4*)hp = o0; *(f32x4*)(hp + 4) = o1;
                        if (HB) *(u32x4*)(HB + off) = pack8(o0, o1);
                        s += (o0[0] * o0[0] + o0[1] * o0[1]) + (o0[2] * o0[2] + o0[3] * o0[3]) + (o1[0] * o1[0] + o1[1] * o1[1]) + (o1[2] * o1[2] + o1[3] * o1[3]); }
                    if (ssq) { s += __shfl_xor(s, 16); s += __shfl_xor(s, 32); if (fq == 0) __hip_atomic_fetch_add(ssq + row, s, __ATOMIC_RELAXED, __HIP_MEMORY_SCOPE_AGENT); } } }
    }
};
struct EpiC {
    static constexpr bool PERM = true, AFTER_DRAIN = false;
    bf16_t* U0; size_t ustride; const float* ssq; float* vsum; float* vsq;
    __device__ __forceinline__ void operator()(const f32x4 (&acc)[2][2][4][2], const Unit& u, int wr, int wc, int fr_, int fq_) const {
        int fr = fr_, fq = fq_; asm volatile("" : "+v"(fr), "+v"(fq));
        const int seg = u.pn >> 3; bf16_t* base = U0 + (size_t)seg * ustride;
        const int row0 = u.pm * BM + wr * 64 + fr, col0 = (u.pn & 7) * BM + wc * 32 + 8 * fq;
        float rsv[2][4];
        PG8_FOR_AI_M rsv[ai][m] = __builtin_amdgcn_rsqf(ssq[row0 + ai * HALF + m * 16] * (1.f / 2048.f) + 1e-6f);
        PG8_FOR_AI_M { const int row = row0 + ai * HALF + m * 16; const float rs = rsv[ai][m]; float s1 = 0.f, s2 = 0.f; bf16_t* rp = base + (size_t)row * 2048 + col0;
#pragma unroll
            for (int bj = 0; bj < 2; ++bj) { f32x4 v0 = acc[ai][bj][m][0] * rs, v1 = acc[ai][bj][m][1] * rs;
                if (seg < 2) { f32x2 a = gelu_pk((f32x2){v0[0], v0[1]}), b = gelu_pk((f32x2){v0[2], v0[3]}), c = gelu_pk((f32x2){v1[0], v1[1]}), d = gelu_pk((f32x2){v1[2], v1[3]});
                    v0 = (f32x4){a.x, a.y, b.x, b.y}; v1 = (f32x4){c.x, c.y, d.x, d.y}; }
                else {
#pragma unroll
                    for (int i = 0; i < 4; ++i) { v0[i] = v0[i] * sigm(v0[i]); v1[i] = v1[i] * sigm(v1[i]); } }
                *(u32x4*)(rp + bj * HALF) = pack8(v0, v1);
                if (seg == 1) { s1 += (v0[0] + v0[1]) + (v0[2] + v0[3]) + (v1[0] + v1[1]) + (v1[2] + v1[3]);
                    s2 += (v0[0] * v0[0] + v0[1] * v0[1]) + (v0[2] * v0[2] + v0[3] * v0[3]) + (v1[0] * v1[0] + v1[1] * v1[1]) + (v1[2] * v1[2] + v1[3] * v1[3]); } }
            if (seg == 1) { s1 += __shfl_xor(s1, 16); s1 += __shfl_xor(s1, 32); s2 += __shfl_xor(s2, 16); s2 += __shfl_xor(s2, 32);
                if (fq == 0) { __hip_atomic_fetch_add(vsum + row, s1, __ATOMIC_RELAXED, __HIP_MEMORY_SCOPE_AGENT); __hip_atomic_fetch_add(vsq + row, s2, __ATOMIC_RELAXED, __HIP_MEMORY_SCOPE_AGENT); } } }
    }
};
template <class Epi, class Sched, bool ALIGN_EPI = false, bool SP2 = false>
__device__ __forceinline__ void gemm_phase(PG8_LAS unsigned char* lds, const Gemm g, const Sched& S, const Epi& E, const int tid_in) {
    const int tid = tid_in, wid = __builtin_amdgcn_readfirstlane(tid >> 6), lane = tid & 63, wr = wid >> 2, wc = wid & 3, fr = lane & 15, fq = lane >> 4;
    const int K = g.K, nt = K / BK;
    unsigned voffA[2], voffB[2];
#pragma unroll
    for (int i = 0; i < 2; ++i) { int R, C; stage_rc(tid * 16 + i * 8192, R, C); const int Rb = Epi::PERM ? ((R & ~31) + perm32(R & 31)) : R;
        voffA[i] = (unsigned)(R * K + C) * 2u; voffB[i] = (unsigned)(Rb * K + C) * 2u; }
    const size_t kstep = (size_t)(BK * 2);
    const size_t hstep = (size_t)HALF * K * 2;
    const size_t tstep = 2 * hstep;
    const unsigned ldsw = (unsigned)wid * 1024u;
    const int aoff = lds_byte(wr * 64 + fr, fq * 8), boff = lds_byte(wc * 32 + fr, fq * 8);
#define PG8_SA(b, h) (((b) * 2 + (h)) * HTB)
#define PG8_SB(b, h) ((4 + (b) * 2 + (h)) * HTB)
#define PG8_STAGE(bufoff, gbase, voff) do { _Pragma("unroll") for (int _i = 0; _i < 2; ++_i) \
        __builtin_amdgcn_global_load_lds((const unsigned*)((const char*)(gbase) + (voff)[_i]), (PG8_LAS unsigned*)(lds + (bufoff) + ldsw + _i * 8192), 16, 0, 0); } while (0)
#define PG8_LDA(dst, b, h) do { _Pragma("unroll") for (int m = 0; m < 4; ++m) _Pragma("unroll") for (int k = 0; k < 2; ++k) dst[m][k] = *(const PG8_LAS bf16x8*)(lds + PG8_SA(b, h) + aoff + m * 2048 + k * 1024); } while (0)
#define PG8_LDB(dst, b, h) do { _Pragma("unroll") for (int n = 0; n < 2; ++n) _Pragma("unroll") for (int k = 0; k < 2; ++k) dst[n][k] = *(const PG8_LAS bf16x8*)(lds + PG8_SB(b, h) + boff + n * 2048 + k * 1024); } while (0)
#define PG8_MMA(ai, bj, At, Bt) do { __builtin_amdgcn_s_setprio(1); _Pragma("unroll") for (int m = 0; m < 4; ++m) _Pragma("unroll") for (int n = 0; n < 2; ++n) _Pragma("unroll") for (int k = 0; k < 2; ++k) \
        acc[ai][bj][m][n] = __builtin_amdgcn_mfma_f32_16x16x32_bf16(Bt[n][k], At[m][k], acc[ai][bj][m][n], 0, 0, 0); __builtin_amdgcn_s_setprio(0); } while (0)
#define PG8_WAIT_V(n) asm volatile("s_waitcnt vmcnt(" #n ")" ::: "memory")
#define PG8_WAIT_L(n) asm volatile("s_waitcnt lgkmcnt(" #n ")" ::: "memory")
#define PG8_BAR __builtin_amdgcn_s_barrier()
#define PG8_SCHED __builtin_amdgcn_sched_barrier(0)
    Unit cur, nxt; int ui = 0;
    if (!S.next(0, cur)) return;
    f32x4 acc[2][2][4][2];
#pragma unroll
    for (int a = 0; a < 2; ++a)
#pragma unroll
        for (int b = 0; b < 2; ++b)
#pragma unroll
            for (int m = 0; m < 4; ++m)
#pragma unroll
                for (int n = 0; n < 2; ++n) acc[a][b][m][n] = (f32x4){0.f, 0.f, 0.f, 0.f};
    bf16x8 At[4][2], B0[2][2], B1[2][2];
    const char* cA = (const char*)g.A + (size_t)cur.pm * tstep; const char* cB = (const char*)g.Bt + (size_t)cur.pn * tstep;
    S.a_ready(cur);
    if constexpr (SP2) {
        PG8_STAGE(PG8_SB(0, 0), cB, voffB); PG8_STAGE(PG8_SB(0, 1), cB + hstep, voffB); PG8_STAGE(PG8_SA(0, 0), cA, voffA); PG8_STAGE(PG8_SA(0, 1), cA + hstep, voffA);
        if (wr == 1) PG8_BAR;
        PG8_WAIT_V(2); PG8_BAR;
        PG8_STAGE(PG8_SB(1, 0), cB + kstep, voffB); PG8_STAGE(PG8_SA(1, 0), cA + kstep, voffA); PG8_STAGE(PG8_SB(1, 1), cB + hstep + kstep, voffB);
        PG8_WAIT_V(6); PG8_BAR;
    } else {
        PG8_STAGE(PG8_SB(0, 0), cB, voffB); PG8_STAGE(PG8_SA(0, 0), cA, voffA); PG8_STAGE(PG8_SB(0, 1), cB + hstep, voffB); PG8_STAGE(PG8_SA(0, 1), cA + hstep, voffA);
        if (wr == 1) PG8_BAR;
        PG8_WAIT_V(4); PG8_BAR;
        PG8_STAGE(PG8_SB(1, 0), cB + kstep, voffB); PG8_STAGE(PG8_SA(1, 0), cA + kstep, voffA); PG8_STAGE(PG8_SB(1, 1), cB + hstep + kstep, voffB);
        PG8_WAIT_V(6); PG8_BAR;
    }
    for (;;) {
        const bool has_next = S.next(ui + 1, nxt);
        const char* nA = has_next ? (const char*)g.A + (size_t)nxt.pm * tstep : cA; const char* nB = has_next ? (const char*)g.Bt + (size_t)nxt.pn * tstep : cB;
        for (int t = 0; t < nt; t += 2) {
            const bool last = (t == nt - 2);
            const char* a1 = cA + (size_t)(t + 1) * kstep;
            const char* a2 = last ? nA : cA + (size_t)(t + 2) * kstep; const char* b2 = last ? nB : cB + (size_t)(t + 2) * kstep;
            const char* a3 = a2 + kstep; const char* b3 = b2 + kstep;
            if (last && has_next) S.a_ready(nxt);
            if constexpr (SP2) {
            PG8_LDB(B0, 0, 0); PG8_LDB(B1, 0, 1); PG8_SCHED; PG8_LDA(At, 0, 0); PG8_STAGE(PG8_SA(1, 1), a1 + hstep, voffA);
            PG8_WAIT_V(8); PG8_WAIT_L(0); PG8_BAR; PG8_MMA(0, 0, At, B0); PG8_MMA(0, 1, At, B1); PG8_BAR; PG8_SCHED;
            PG8_LDA(At, 0, 1); PG8_STAGE(PG8_SB(0, 0), b2, voffB); PG8_STAGE(PG8_SB(0, 1), b2 + hstep, voffB); PG8_STAGE(PG8_SA(0, 0), a2, voffA);
            PG8_WAIT_V(8); PG8_WAIT_L(0); PG8_BAR; PG8_MMA(1, 0, At, B0); PG8_MMA(1, 1, At, B1); PG8_BAR; PG8_SCHED;
            PG8_LDB(B0, 1, 0); PG8_LDB(B1, 1, 1); PG8_SCHED; PG8_LDA(At, 1, 0); PG8_STAGE(PG8_SA(0, 1), a2 + hstep, voffA);
            PG8_WAIT_V(8); PG8_WAIT_L(0); PG8_BAR; PG8_MMA(0, 0, At, B0); PG8_MMA(0, 1, At, B1); PG8_BAR; PG8_SCHED;
            PG8_LDA(At, 1, 1); PG8_STAGE(PG8_SB(1, 0), b3, voffB); PG8_STAGE(PG8_SB(1, 1), b3 + hstep, voffB); PG8_STAGE(PG8_SA(1, 0), a3, voffA);
            PG8_WAIT_V(8); PG8_WAIT_L(0); PG8_BAR; PG8_MMA(1, 0, At, B0); PG8_MMA(1, 1, At, B1); PG8_BAR; PG8_SCHED;
            } else {
            PG8_LDB(B0, 0, 0); PG8_SCHED; PG8_LDA(At, 0, 0); PG8_STAGE(PG8_SA(1, 1), a1 + hstep, voffA);
            PG8_WAIT_L(8); PG8_BAR; PG8_WAIT_L(0); PG8_MMA(0, 0, At, B0); PG8_BAR; PG8_SCHED;
            PG8_LDB(B1, 0, 1); PG8_STAGE(PG8_SB(0, 0), b2, voffB);
            PG8_BAR; PG8_WAIT_L(0); PG8_MMA(0, 1, At, B1); PG8_BAR;
            PG8_LDA(At, 0, 1); PG8_STAGE(PG8_SA(0, 0), a2, voffA);
            PG8_BAR; PG8_WAIT_L(0); PG8_MMA(1, 0, At, B0); PG8_BAR; PG8_SCHED;
            PG8_STAGE(PG8_SB(0, 1), b2 + hstep, voffB);
            PG8_WAIT_V(6); PG8_BAR; PG8_MMA(1, 1, At, B1); PG8_BAR;
            PG8_LDB(B0, 1, 0); PG8_SCHED; PG8_LDA(At, 1, 0); PG8_STAGE(PG8_SA(0, 1), a2 + hstep, voffA);
            PG8_WAIT_L(8); PG8_BAR; PG8_WAIT_L(0); PG8_MMA(0, 0, At, B0); PG8_BAR; PG8_SCHED;
            PG8_LDB(B1, 1, 1); PG8_STAGE(PG8_SB(1, 0), b3, voffB);
            PG8_BAR; PG8_WAIT_L(0); PG8_MMA(0, 1, At, B1); PG8_BAR;
            PG8_LDA(At, 1, 1); PG8_STAGE(PG8_SA(1, 0), a3, voffA);
            PG8_BAR; PG8_WAIT_L(0); PG8_MMA(1, 0, At, B0); PG8_BAR; PG8_SCHED;
            PG8_STAGE(PG8_SB(1, 1), b3 + hstep, voffB);
            PG8_WAIT_V(6); PG8_BAR; PG8_MMA(1, 1, At, B1); PG8_BAR;
            }
        }
        if constexpr (ALIGN_EPI) { if (wr == 0) PG8_BAR; }
        if constexpr (!Epi::AFTER_DRAIN) { E(acc, cur, wr, wc, fr, fq); S.done(cur); }
        if (!has_next) break;
#pragma unroll
        for (int a = 0; a < 2; ++a)
#pragma unroll
            for (int b = 0; b < 2; ++b)
#pragma unroll
                for (int m = 0; m < 4; ++m)
#pragma unroll
                    for (int n = 0; n < 2; ++n) acc[a][b][m][n] = (f32x4){0.f, 0.f, 0.f, 0.f};
        cur = nxt; cA = nA; cB = nB; ++ui;
        if constexpr (ALIGN_EPI) { if (wr == 1) PG8_BAR; }
    }
    PG8_WAIT_V(0);
    if constexpr (!ALIGN_EPI) { if (wr == 0) PG8_BAR; }
    PG8_BAR;
    if constexpr (Epi::AFTER_DRAIN) { E.fused(acc, cur, wr, wc, fr, fq, lds, wid, lane); S.done(cur); }
#undef PG8_SA
#undef PG8_SB
#undef PG8_STAGE
#undef PG8_LDA
#undef PG8_LDB
#undef PG8_MMA
#undef PG8_WAIT_V
#undef PG8_WAIT_L
#undef PG8_BAR
#undef PG8_SCHED
}
}
constexpr int NB = 16, T = 2048, D = 2048, M = NB * T;
constexpr int N_IN0 = 8448;
constexpr size_t MiB = 1u << 20;
constexpr size_t WS_CTL = 0;
constexpr size_t WS_WIN0 = 2 * MiB, WS_WOUT0 = 35 * MiB, WS_WIN1 = 43 * MiB, WS_WOUT1 = 67 * MiB, WS_WG0 = 75 * MiB, WS_WG1 = 83 * MiB, WS_WP0 = 91 * MiB, WS_WP1 = 92 * MiB;
constexpr size_t WS_HBA = 96 * MiB, WS_PB = 224 * MiB, WS_G = 256 * MiB, WS_SMALL = 768 * MiB, WS_Z = 800 * MiB, WS_END = 928 * MiB;
constexpr int LDS_BYTES = 147456;
constexpr int NWAVES = 8;
typedef unsigned short bf16;
typedef short bf16x8 __attribute__((ext_vector_type(8)));
typedef float f32x4 __attribute__((ext_vector_type(4)));
typedef float f32x16 __attribute__((ext_vector_type(16)));
typedef unsigned u32x4 __attribute__((ext_vector_type(4)));
typedef unsigned u32x2 __attribute__((ext_vector_type(2)));
#define LAS __attribute__((address_space(3)))
#define LDS_WAIT() asm volatile("s_waitcnt lgkmcnt(0)" ::: "memory")
using pg8::cvt_pk_bf16; using pg8::bflo; using pg8::bfhi; using pg8::sigm;
constexpr float LOG2E = 1.4426950408889634f;

__device__ __forceinline__ int my_tid(int wave_s) { return wave_s * 64 + (int)__builtin_amdgcn_mbcnt_hi(~0u, __builtin_amdgcn_mbcnt_lo(~0u, 0u)); }
__device__ __forceinline__ float wave_sum(float v) {
#pragma unroll
    for (int o = 1; o < 64; o <<= 1) v += __shfl_xor(v, o);
    return v;
}
__device__ __forceinline__ float red16(float v) { v += __shfl_xor(v, 1); v += __shfl_xor(v, 2); v += __shfl_xor(v, 4); v += __shfl_xor(v, 8); return v; }

__device__ __forceinline__ void transpose_item(const float* W, int K, int Nsrc, int src_col0, int nvalid, const float* gk, bf16* WT, int dst_row0, float* scr, int kb, int lane) {
    const int k0 = 64 * kb, c = lane & 31;
#pragma unroll 8
    for (int i = 0; i < 32; ++i) { const int kk = 2 * i + (lane >> 5); float v = (c < nvalid) ? W[(size_t)(k0 + kk) * Nsrc + src_col0 + c] : 0.f; if (gk) v *= gk[k0 + kk]; scr[kk * 33 + c] = v; }
    LDS_WAIT();
    const int c8 = lane & 7;
#pragma unroll
    for (int j = 0; j < 4; ++j) { const int n = (lane >> 3) + 8 * j; const float* s = scr + (8 * c8) * 33 + n;
        u32x4 o; o.x = cvt_pk_bf16(s[0 * 33], s[1 * 33]); o.y = cvt_pk_bf16(s[2 * 33], s[3 * 33]); o.z = cvt_pk_bf16(s[4 * 33], s[5 * 33]); o.w = cvt_pk_bf16(s[6 * 33], s[7 * 33]);
        *(u32x4*)(WT + (size_t)(dst_row0 + n) * K + k0 + 8 * c8) = o; }
    LDS_WAIT();
}

struct Ptrs {
    const float *x, *p, *norm_pre, *norm_post, *ab_w_in, *fox_f_bias, *rwkv_mu, *rwkv_w0, *rwkv_w2, *rwkv_a0, *rwkv_a2, *rwkv_k_k, *rwkv_k_a, *rwkv_r_k, *rwkv_ln_g, *rwkv_ln_b,
        *ab_w_out, *c_w_in, *c_ln_g, *c_ln_b, *c_w_s, *c_b_s, *c_w_out, *ple_w_proj, *ple_w_gate;
    float* out; unsigned char* ws; int ph_lo, ph_hi;
};

__device__ __forceinline__ void p0_prologue(const Ptrs& P, unsigned char* lds, const int wave_s) {
    int tid_ = my_tid(wave_s); asm volatile("" : "+v"(tid_)); const int tid = tid_, lane = tid & 63, wave = tid >> 6;
    float* scr = (float*)(lds + wave * 16384);
    const int gw = blockIdx.x * NWAVES + wave, NGW = gridDim.x * NWAVES;
    unsigned char* ws = P.ws;
    if (blockIdx.x < 200) {
        const int c0 = blockIdx.x * 16, q = wave, cq = lane & 3, bb = lane >> 2;
        const float* xr = P.x + (size_t)bb * T * D + q * 256; const float* gq = P.norm_pre + q * 256; const float* Wq = P.ab_w_in + (size_t)(q * 256) * 8336 + 4112 + c0 + 4 * cq;
        f32x4 a0 = {0.f, 0.f, 0.f, 0.f}, a1 = a0, a2 = a0, a3 = a0;
#pragma unroll 2
        for (int k4 = 0; k4 < 64; ++k4) { const f32x4 gv = *(const f32x4*)(gq + 4 * k4);
            const f32x4 x0 = *(const f32x4*)(xr + 4 * k4) * gv, x1 = *(const f32x4*)(xr + D + 4 * k4) * gv, x2 = *(const f32x4*)(xr + 2 * D + 4 * k4) * gv, x3 = *(const f32x4*)(xr + 3 * D + 4 * k4) * gv;
#pragma unroll
            for (int e = 0; e < 4; ++e) { const f32x4 wv_ = *(const f32x4*)(Wq + (size_t)(4 * k4 + e) * 8336);
                a0 += x0[e] * wv_; a1 += x1[e] * wv_; a2 += x2[e] * wv_; a3 += x3[e] * wv_; } }
        { float* part = (float*)lds + (q * 64 + bb * 4) * 16 + 4 * cq;
          *(f32x4*)part = a0; *(f32x4*)(part + 16) = a1; *(f32x4*)(part + 32) = a2; *(f32x4*)(part + 48) = a3; }
        __syncthreads();
        float* EXG = (float*)(ws + WS_CTL + 0x100000);
#pragma unroll
        for (int o = tid * 2; o < tid * 2 + 2; ++o) { const int r2 = o >> 4, cc = o & 15; float v = 0.f;
#pragma unroll
            for (int w = 0; w < 8; ++w) v += ((const float*)lds)[(w * 64 + r2) * 16 + cc];
            EXG[(size_t)r2 * 3200 + c0 + cc] = v; }
        __syncthreads();
    }
    { float* z = (float*)(ws + WS_CTL) + M; for (int i = blockIdx.x * 512 + tid; i < 5 * M; i += gridDim.x * 512) z[i] = 0.f; }
    constexpr int I_IN0 = 32 * (N_IN0 / 32), I_SQ = 32 * 64, I_IN1 = 32 * 192, I_PJ = 4 * 64;
    constexpr int NITEMS = I_IN0 + I_SQ + I_IN1 + I_SQ + 2 * I_SQ + 2 * I_PJ;
    for (int it = gw; it < NITEMS; it += NGW) {
        int r = it;
        if (r < I_IN0) { const int nblk = N_IN0 / 32, kb = r / nblk, db = r % nblk; int src, nv = 32;
            if (db < 256) { const int grp = db >> 5; src = grp * 1024 + (grp >= 3 ? 16 : 0) + (grp == 7 ? 128 : 0) + (db & 31) * 32; }
            else if (db < 258) src = 7184 + (db - 256) * 32; else if (db < 260) src = 7248 + (db - 258) * 32; else if (db == 260) { src = 3072; nv = 16; } else { src = 0; nv = 0; }
            transpose_item(P.ab_w_in, 2048, 8336, src, nv, P.norm_pre, (bf16*)(ws + WS_WIN0), db * 32, scr, kb, lane); continue; } r -= I_IN0;
        if (r < I_SQ) { transpose_item(P.ab_w_out, 2048, 2048, (r % 64) * 32, 32, nullptr, (bf16*)(ws + WS_WOUT0), (r % 64) * 32, scr, r / 64, lane); continue; } r -= I_SQ;
        if (r < I_IN1) { transpose_item(P.c_w_in, 2048, 6144, (r % 192) * 32, 32, P.norm_pre + 2048, (bf16*)(ws + WS_WIN1), (r % 192) * 32, scr, r / 192, lane); continue; } r -= I_IN1;
        if (r < I_SQ) { transpose_item(P.c_w_out, 2048, 2048, (r % 64) * 32, 32, nullptr, (bf16*)(ws + WS_WOUT1), (r % 64) * 32, scr, r / 64, lane); continue; } r -= I_SQ;
        if (r < I_SQ) { transpose_item(P.ple_w_gate, 2048, 2048, (r % 64) * 32, 32, nullptr, (bf16*)(ws + WS_WG0), (r % 64) * 32, scr, r / 64, lane); continue; } r -= I_SQ;
        if (r < I_SQ) { transpose_item(P.ple_w_gate + (size_t)2048 * 2048, 2048, 2048, (r % 64) * 32, 32, nullptr, (bf16*)(ws + WS_WG1), (r % 64) * 32, scr, r / 64, lane); continue; } r -= I_SQ;
        if (r < I_PJ) { transpose_item(P.ple_w_proj, 256, 2048, (r % 64) * 32, 32, nullptr, (bf16*)(ws + WS_WP0), (r % 64) * 32, scr, r / 64, lane); continue; } r -= I_PJ;
        transpose_item(P.ple_w_proj + (size_t)256 * 2048, 256, 2048, (r % 64) * 32, 32, nullptr, (bf16*)(ws + WS_WP1), (r % 64) * 32, scr, r / 64, lane);
    }
    { float* ssq0 = (float*)(ws + WS_CTL); bf16* hb = (bf16*)(ws + WS_HBA);
      for (int row = gw; row < M; row += NGW) { const f32x4* xr = (const f32x4*)(P.x + (size_t)row * D) + lane; f32x4 v[8]; float s = 0.f;
#pragma unroll
          for (int j = 0; j < 8; ++j) { v[j] = xr[64 * j]; s += (v[j][0] * v[j][0] + v[j][1] * v[j][1]) + (v[j][2] * v[j][2] + v[j][3] * v[j][3]); }
          s = wave_sum(s); if (lane == 0) ssq0[row] = s;
          u32x2* o = (u32x2*)(hb + (size_t)row * D) + lane;
#pragma unroll
          for (int j = 0; j < 8; ++j) { u32x2 w; w.x = cvt_pk_bf16(v[j][0], v[j][1]); w.y = cvt_pk_bf16(v[j][2], v[j][3]); o[64 * j] = w; } } }
}

template <bool HIN_BF16> __device__ __forceinline__ void post_norm_phase(const float* hin, const bf16* hbin, const bf16* Y, const float* ssq, const float* g, float* hout, bf16* hb, const int wave_s) {
    int tid_ = my_tid(wave_s); asm volatile("" : "+v"(tid_)); const int tid = tid_, lane = tid & 63, wave = tid >> 6;
    const int gw = blockIdx.x * NWAVES + wave, NGW = gridDim.x * NWAVES;
    f32x4 gv[8];
#pragma unroll
    for (int j = 0; j < 8; ++j) gv[j] = *((const f32x4*)g + lane + 64 * j);
    for (int row = gw; row < M; row += NGW) {
        const float rs = __builtin_amdgcn_rsqf(ssq[row] * (1.f / 2048.f) + 1e-6f);
        const f32x4* hr = (const f32x4*)(hin + (size_t)row * D) + lane; const u32x2* yr = (const u32x2*)(Y + (size_t)row * D) + lane;
        u32x2* ob = (u32x2*)(hb + (size_t)row * D) + lane;
#pragma unroll
        for (int j = 0; j < 8; ++j) { f32x4 h; if (HIN_BF16) { const u32x2 hx = ((const u32x2*)(hbin + (size_t)row * D) + lane)[64 * j]; h = (f32x4){bflo(hx.x), bfhi(hx.x), bflo(hx.y), bfhi(hx.y)}; } else h = hr[64 * j];
            const u32x2 y = yr[64 * j]; f32x4 o;
            o[0] = h[0] + bflo(y.x) * rs * gv[j][0]; o[1] = h[1] + bfhi(y.x) * rs * gv[j][1]; o[2] = h[2] + bflo(y.y) * rs * gv[j][2]; o[3] = h[3] + bfhi(y.y) * rs * gv[j][3];
            u32x2 w; w.x = cvt_pk_bf16(o[0], o[1]); w.y = cvt_pk_bf16(o[2], o[3]); ob[64 * j] = w; }
    }
}

__device__ __forceinline__ int crow(int r, int hi) { return (r & 3) + 8 * (r >> 2) + 4 * hi; }
__device__ __forceinline__ void attn_phase(unsigned char* lds, const bf16* Qg, const bf16* Kg, const bf16* Vg, const bf16* GAg, const float* small, const float* fbias, bf16* Z, const int wave_s) {
    int tid_ = my_tid(wave_s); asm volatile("" : "+v"(tid_)); const int tid = tid_, lane = tid & 63, wid = __builtin_amdgcn_readfirstlane(tid >> 6), r32 = lane & 31, hi = lane >> 5;
    float* c2 = (float*)lds;
    float* wtot = (float*)(lds + 8192);
    bf16* Ks = (bf16*)(lds + 8192 + 64);
    bf16* Vt = Ks + 64 * 72;
    for (int bh = blockIdx.x; bh < 256; bh += gridDim.x) {
        const int b = bh >> 4, h = bh & 15; const size_t rowbase = (size_t)b * T;
        __syncthreads();
        { float lf[4]; const float fb = fbias[h]; float run = 0.f;
#pragma unroll
          for (int i = 0; i < 4; ++i) { const float xg = small[(rowbase + 4 * tid + i) * 256 + 128 + h] + fb; const float ls = fminf(xg, 0.f) - log1pf(__expf(-fabsf(xg))); run += ls; lf[i] = run; }
          float sc = run;
#pragma unroll
          for (int o = 1; o < 64; o <<= 1) { const float t = __shfl_up(sc, o); if (lane >= o) sc += t; }
          if (lane == 63) wtot[wid] = sc;
          __syncthreads();
          float off = sc - run;
#pragma unroll
          for (int w = 0; w < 8; ++w) if (w < wid) off += wtot[w];
#pragma unroll
          for (int i = 0; i < 4; ++i) c2[4 * tid + i] = (off + lf[i]) * LOG2E; }
        __syncthreads();
        for (int qb = 0; qb < 8; ++qb) {
            const int q0w = qb * 256 + wid * 32, q = q0w + r32;
            bf16x8 qr[4];
#pragma unroll
            for (int d0 = 0; d0 < 4; ++d0) qr[d0] = *(const bf16x8*)(Qg + (rowbase + q) * 1024 + h * 64 + d0 * 16 + hi * 8);
            const float cq = c2[q];
            f32x16 o0, o1;
#pragma unroll
            for (int r = 0; r < 16; ++r) { o0[r] = 0.f; o1[r] = 0.f; }
            float mrow = -1e30f, l = 0.f;
            const int NT = qb * 4 + 4;
            const int kr = tid >> 3, ch = tid & 7, vr = lane, vc = wid;
            const bf16* kgp = Kg + (rowbase + kr) * 1024 + h * 64 + ch * 8; const bf16* vgp = Vg + (rowbase + vr) * 1024 + h * 64 + vc * 8;
            u32x4 kreg = *(const u32x4*)kgp, vreg = *(const u32x4*)vgp;
            for (int t = 0; t < NT; ++t) {
                asm volatile("s_waitcnt lgkmcnt(0)\n\ts_barrier" ::: "memory");
                { *(u32x4*)(Ks + kr * 72 + ch * 8) = kreg; bf16* vt = Vt + (vc * 8) * 72 + vr;
                  vt[0 * 72] = (bf16)(vreg.x & 0xffffu); vt[1 * 72] = (bf16)(vreg.x >> 16); vt[2 * 72] = (bf16)(vreg.y & 0xffffu); vt[3 * 72] = (bf16)(vreg.y >> 16);
                  vt[4 * 72] = (bf16)(vreg.z & 0xffffu); vt[5 * 72] = (bf16)(vreg.z >> 16); vt[6 * 72] = (bf16)(vreg.w & 0xffffu); vt[7 * 72] = (bf16)(vreg.w >> 16);
                  if (t + 1 < NT) { kreg = *(const u32x4*)(kgp + (size_t)(t + 1) * 64 * 1024); vreg = *(const u32x4*)(vgp + (size_t)(t + 1) * 64 * 1024); } }
                asm volatile("s_waitcnt lgkmcnt(0)\n\ts_barrier" ::: "memory");
                if (t * 64 <= q0w + 31) {
                    f32x16 p0, p1;
#pragma unroll
                    for (int r = 0; r < 16; ++r) { p0[r] = 0.f; p1[r] = 0.f; }
#pragma unroll
                    for (int d0 = 0; d0 < 4; ++d0) { const bf16x8 k0 = *(const bf16x8*)(Ks + r32 * 72 + d0 * 16 + hi * 8), k1 = *(const bf16x8*)(Ks + (32 + r32) * 72 + d0 * 16 + hi * 8);
                        p0 = __builtin_amdgcn_mfma_f32_32x32x16_bf16(k0, qr[d0], p0, 0, 0, 0); p1 = __builtin_amdgcn_mfma_f32_32x32x16_bf16(k1, qr[d0], p1, 0, 0, 0); }
                    const int kvb = t * 64 + 4 * hi;
#pragma unroll
                    for (int g4 = 0; g4 < 4; ++g4) { const f32x4 ca = *(const f32x4*)(c2 + kvb + 8 * g4), cb = *(const f32x4*)(c2 + kvb + 32 + 8 * g4);
#pragma unroll
                        for (int i = 0; i < 4; ++i) { p0[4 * g4 + i] += cq - ca[i]; p1[4 * g4 + i] += cq - cb[i]; } }
                    if (t * 64 + 63 > q0w) {
#pragma unroll
                        for (int r = 0; r < 16; ++r) { const int kv = kvb + (r & 3) + 8 * (r >> 2); if (kv > q) p0[r] = -1e30f; if (kv + 32 > q) p1[r] = -1e30f; } }
                    float mx = fmaxf(p0[0], p1[0]);
#pragma unroll
                    for (int r = 1; r < 16; ++r) mx = fmaxf(mx, fmaxf(p0[r], p1[r]));
                    mx = fmaxf(mx, __shfl_xor(mx, 32));
                    const float mnew = fmaxf(mrow, mx), alpha = __builtin_amdgcn_exp2f(mrow - mnew); mrow = mnew;
                    l *= alpha; float ls = 0.f;
#pragma unroll
                    for (int r = 0; r < 16; ++r) { o0[r] *= alpha; o1[r] *= alpha; p0[r] = __builtin_amdgcn_exp2f(p0[r] - mnew); p1[r] = __builtin_amdgcn_exp2f(p1[r] - mnew); ls += p0[r] + p1[r]; }
                    l += ls;
                    u32x4 pw[4];
#pragma unroll
                    for (int s = 0; s < 2; ++s) { pw[s].x = cvt_pk_bf16(p0[8 * s + 0], p0[8 * s + 1]); pw[s].y = cvt_pk_bf16(p0[8 * s + 2], p0[8 * s + 3]); pw[s].z = cvt_pk_bf16(p0[8 * s + 4], p0[8 * s + 5]); pw[s].w = cvt_pk_bf16(p0[8 * s + 6], p0[8 * s + 7]);
                        pw[2 + s].x = cvt_pk_bf16(p1[8 * s + 0], p1[8 * s + 1]); pw[2 + s].y = cvt_pk_bf16(p1[8 * s + 2], p1[8 * s + 3]); pw[2 + s].z = cvt_pk_bf16(p1[8 * s + 4], p1[8 * s + 5]); pw[2 + s].w = cvt_pk_bf16(p1[8 * s + 6], p1[8 * s + 7]); }
#pragma unroll
                    for (int s = 0; s < 4; ++s) { const bf16x8 pf = __builtin_bit_cast(bf16x8, pw[s]);
                        { const bf16* vp = Vt + r32 * 72 + 16 * s + 4 * hi; const u32x2 lo = *(const u32x2*)vp, hi2 = *(const u32x2*)(vp + 8); u32x4 va; va.x = lo.x; va.y = lo.y; va.z = hi2.x; va.w = hi2.y;
                          o0 = __builtin_amdgcn_mfma_f32_32x32x16_bf16(__builtin_bit_cast(bf16x8, va), pf, o0, 0, 0, 0); }
                        { const bf16* vp = Vt + (32 + r32) * 72 + 16 * s + 4 * hi; const u32x2 lo = *(const u32x2*)vp, hi2 = *(const u32x2*)(vp + 8); u32x4 va; va.x = lo.x; va.y = lo.y; va.z = hi2.x; va.w = hi2.y;
                          o1 = __builtin_amdgcn_mfma_f32_32x32x16_bf16(__builtin_bit_cast(bf16x8, va), pf, o1, 0, 0, 0); } }
                }
            }
            l += __shfl_xor(l, 32); const float inv = 1.f / l;
#pragma unroll
            for (int g4 = 0; g4 < 4; ++g4) {
                { const int d = 8 * g4 + 4 * hi; const u32x2 gg = *(const u32x2*)(GAg + (rowbase + q) * 1024 + h * 64 + d);
                  const float g0 = bflo(gg.x), g1 = bfhi(gg.x), g2 = bflo(gg.y), g3 = bfhi(gg.y); u32x2 w;
                  w.x = cvt_pk_bf16(o0[4 * g4 + 0] * inv * g0 * sigm(g0), o0[4 * g4 + 1] * inv * g1 * sigm(g1)); w.y = cvt_pk_bf16(o0[4 * g4 + 2] * inv * g2 * sigm(g2), o0[4 * g4 + 3] * inv * g3 * sigm(g3));
                  *(u32x2*)(Z + (rowbase + q) * 2048 + h * 64 + d) = w; }
                { const int d = 32 + 8 * g4 + 4 * hi; const u32x2 gg = *(const u32x2*)(GAg + (rowbase + q) * 1024 + h * 64 + d);
                  const float g0 = bflo(gg.x), g1 = bfhi(gg.x), g2 = bflo(gg.y), g3 = bfhi(gg.y); u32x2 w;
                  w.x = cvt_pk_bf16(o1[4 * g4 + 0] * inv * g0 * sigm(g0), o1[4 * g4 + 1] * inv * g1 * sigm(g1)); w.y = cvt_pk_bf16(o1[4 * g4 + 2] * inv * g2 * sigm(g2), o1[4 * g4 + 3] * inv * g3 * sigm(g3));
                  *(u32x2*)(Z + (rowbase + q) * 2048 + h * 64 + d) = w; }
            }
        }
    }
}
__device__ __forceinline__ float exp_fast(float x) { return __builtin_amdgcn_exp2f(1.4426950408889634f * x); }
__device__ __forceinline__ float softplusf_(float z) { return fmaxf(z, 0.f) + 0.6931471805599453f * __builtin_amdgcn_logf(1.0f + exp_fast(-fabsf(z))); }
__device__ __forceinline__ float tanh_fast(float x) { return 1.0f - 2.0f * __builtin_amdgcn_rcpf(1.0f + __builtin_amdgcn_exp2f(2.885390081777927f * x)); }
__device__ __forceinline__ void rwkv_phase(unsigned char* lds, const Ptrs& P, const bf16* Rg, const bf16* Kg, const bf16* Vg, const bf16* GBg, const float* small, bf16* Z, const int wave_s) {
    int tid_ = my_tid(wave_s); asm volatile("" : "+v"(tid_)); const int tid = tid_, lane = tid & 63, wv = __builtin_amdgcn_readfirstlane(tid >> 6);
#define RW_BAR() asm volatile("s_waitcnt lgkmcnt(0)\n\ts_barrier" ::: "memory")
    bf16* W2t = (bf16*)lds;
    bf16* A2t = W2t + 64 * 72;
    float* DL = (float*)lds + 4608;
    float* TW = DL + 4096;
    float* AL = TW + 2176;
    float* Rr = AL + 2176;
    float* Vv = Rr + 10240;
    float* Yb = Vv + 2048;
    float* red = Yb + 2048;
    float* Uu = red + 2048;
    float* CC = Uu + 1024;
    float* Cc = CC + 64;
    const int tt = tid >> 4, c4 = (tid & 15) * 4;
    for (int bh = blockIdx.x; bh < 256; bh += gridDim.x) {
        const int b = bh >> 4, h = bh & 15, hc = h * 64 + c4; const size_t rowbase = (size_t)b * T;
        __syncthreads();
        for (int i = tid; i < 4096; i += 512) { const int k = i >> 6, c = i & 63; W2t[c * 72 + k] = (bf16)(cvt_pk_bf16(P.rwkv_w2[(size_t)k * 1024 + h * 64 + c], 0.f) & 0xffffu); A2t[c * 72 + k] = (bf16)(cvt_pk_bf16(P.rwkv_a2[(size_t)k * 1024 + h * 64 + c], 0.f) & 0xffffu); }
        if (tid < 16) { const int cc = tid * 4, hcc = h * 64 + cc;
            *(f32x4*)(Cc + 0 * 64 + cc) = *(const f32x4*)(P.rwkv_mu + hcc); *(f32x4*)(Cc + 1 * 64 + cc) = *(const f32x4*)(P.rwkv_mu + 1024 + hcc); *(f32x4*)(Cc + 2 * 64 + cc) = *(const f32x4*)(P.rwkv_mu + 2048 + hcc);
            *(f32x4*)(Cc + 3 * 64 + cc) = *(const f32x4*)(P.rwkv_mu + 3072 + cc); *(f32x4*)(Cc + 4 * 64 + cc) = *(const f32x4*)(P.rwkv_mu + 3136 + cc);
            *(f32x4*)(Cc + 5 * 64 + cc) = *(const f32x4*)(P.rwkv_w0 + hcc); *(f32x4*)(Cc + 6 * 64 + cc) = *(const f32x4*)(P.rwkv_a0 + hcc); *(f32x4*)(Cc + 7 * 64 + cc) = *(const f32x4*)(P.rwkv_k_k + hcc);
            *(f32x4*)(Cc + 8 * 64 + cc) = *(const f32x4*)(P.rwkv_k_a + hcc); *(f32x4*)(Cc + 9 * 64 + cc) = *(const f32x4*)(P.rwkv_r_k + hcc); *(f32x4*)(Cc + 10 * 64 + cc) = *(const f32x4*)(P.rwkv_ln_g + hcc);
            *(f32x4*)(Cc + 11 * 64 + cc) = *(const f32x4*)(P.rwkv_ln_b + hcc); }
#define CV(k) (*(const f32x4*)(Cc + (k) * 64 + c4))
        f32x4 Sv[4];
#pragma unroll
        for (int g = 0; g < 4; ++g) Sv[g] = (f32x4){0.f, 0.f, 0.f, 0.f};
        { float* const EX = red; const float* exg = (const float*)(P.ws + WS_CTL + 0x100000) + (size_t)(b * 4) * 3200;
          for (int i = tid; i < 1280; i += 512) { const int q = i / 320, cc = i - q * 320; const int col = (cc < 192) ? ((cc >> 6) * 1024 + h * 64 + (cc & 63)) : (3072 + (cc - 192));
              EX[i] = exg[q * 3200 + col] * __builtin_amdgcn_rsqf(((const float*)(P.ws + WS_CTL))[rowbase + q] * (1.f / 2048.f) + 1e-6f); }
          __syncthreads(); }
        u32x2 n_rc, n_kc, n_vc, n_gg, n_rp = {0u, 0u}, n_kp = {0u, 0u}, n_vp = {0u, 0u}; f32x4 n_wl, n_al, n_wlp = {0.f, 0.f, 0.f, 0.f}, n_alp = {0.f, 0.f, 0.f, 0.f};
#define RW_FETCH(ckk) do { const size_t row_ = rowbase + (ckk) * 32 + tt; \
            n_rc = *(const u32x2*)(Rg + row_ * 1024 + hc); n_kc = *(const u32x2*)(Kg + row_ * 1024 + hc); n_vc = *(const u32x2*)(Vg + row_ * 1024 + hc); \
            n_wl = *(const f32x4*)(small + row_ * 256 + c4); n_al = *(const f32x4*)(small + row_ * 256 + 64 + c4); } while (0)
        RW_FETCH(0); n_gg = *(const u32x2*)(GBg + (rowbase + tt) * 1024 + hc);
#define RW_FETCH_PREV(rowp) do { n_rp = *(const u32x2*)(Rg + (rowp) * 1024 + hc); n_kp = *(const u32x2*)(Kg + (rowp) * 1024 + hc); n_vp = *(const u32x2*)(Vg + (rowp) * 1024 + hc); \
            n_wlp = *(const f32x4*)(small + (rowp) * 256 + c4); n_alp = *(const f32x4*)(small + (rowp) * 256 + 64 + c4); } while (0)
        if (tt > 0) RW_FETCH_PREV(rowbase + tt - 1);
        for (int ck = 0; ck < T / 32; ++ck) {
            const int t = ck * 32 + tt; const size_t row = rowbase + t;
            f32x4 rs, ks, vs;
            { const f32x4 mu_r = CV(0), mu_k = CV(1), mu_v = CV(2), mu_w = CV(3), mu_a = CV(4);
              const u32x2 rc = n_rc, kc = n_kc, vc = n_vc, rp = n_rp, kp = n_kp, vp = n_vp; f32x4 wl = n_wl, al = n_al, wlp = n_wlp, alp = n_alp;
              f32x4 rcf = {bflo(rc.x), bfhi(rc.x), bflo(rc.y), bfhi(rc.y)}, rpf = {bflo(rp.x), bfhi(rp.x), bflo(rp.y), bfhi(rp.y)};
              f32x4 kcf = {bflo(kc.x), bfhi(kc.x), bflo(kc.y), bfhi(kc.y)}, kpf = {bflo(kp.x), bfhi(kp.x), bflo(kp.y), bfhi(kp.y)};
              f32x4 vcf = {bflo(vc.x), bfhi(vc.x), bflo(vc.y), bfhi(vc.y)}, vpf = {bflo(vp.x), bfhi(vp.x), bflo(vp.y), bfhi(vp.y)};
              if (t < 4) { const float* ex = red + t * 320; rcf = *(const f32x4*)(ex + c4); kcf = *(const f32x4*)(ex + 64 + c4); vcf = *(const f32x4*)(ex + 128 + c4); wl = *(const f32x4*)(ex + 192 + c4); al = *(const f32x4*)(ex + 256 + c4);
                  if (t > 0) { const float* ep = ex - 320; rpf = *(const f32x4*)(ep + c4); kpf = *(const f32x4*)(ep + 64 + c4); vpf = *(const f32x4*)(ep + 128 + c4); wlp = *(const f32x4*)(ep + 192 + c4); alp = *(const f32x4*)(ep + 256 + c4); } }
              rs = rcf + (rpf - rcf) * mu_r; ks = kcf + (kpf - kcf) * mu_k; vs = vcf + (vpf - vcf) * mu_v;
              wl = wl + (wlp - wl) * mu_w; al = al + (alp - al) * mu_a;
              f32x4 tw; tw[0] = tanh_fast(wl[0]); tw[1] = tanh_fast(wl[1]); tw[2] = tanh_fast(wl[2]); tw[3] = tanh_fast(wl[3]);
              *(f32x4*)(TW + tt * 68 + c4) = tw; *(f32x4*)(AL + tt * 68 + c4) = al; }
            RW_BAR();
            float bon;
            if (wv < 4) { const int mat = wv >> 1, nt = wv & 1, r32 = lane & 31, hi5 = lane >> 5; const float* X = (mat ? AL : TW) + r32 * 68 + 8 * hi5; const bf16* Wt = (mat ? A2t : W2t) + (nt * 32 + r32) * 72 + 8 * hi5;
                f32x16 acc;
#pragma unroll
                for (int r = 0; r < 16; ++r) acc[r] = 0.f;
#pragma unroll
                for (int ks = 0; ks < 4; ++ks) { const f32x4 xa = *(const f32x4*)(X + 16 * ks), xb = *(const f32x4*)(X + 16 * ks + 4);
                    u32x4 ap; ap.x = cvt_pk_bf16(xa[0], xa[1]); ap.y = cvt_pk_bf16(xa[2], xa[3]); ap.z = cvt_pk_bf16(xb[0], xb[1]); ap.w = cvt_pk_bf16(xb[2], xb[3]);
                    const bf16x8 bp = *(const bf16x8*)(Wt + 16 * ks);
                    acc = __builtin_amdgcn_mfma_f32_32x32x16_bf16(__builtin_bit_cast(bf16x8, ap), bp, acc, 0, 0, 0); }
#pragma unroll
                for (int r = 0; r < 16; ++r) DL[mat * 2048 + ((r & 3) + 8 * (r >> 2) + 4 * hi5) * 64 + nt * 32 + r32] = acc[r]; }
            RW_BAR();
            { const f32x4 w0v = CV(5), a0v = CV(6), kkg = CV(7), kag = CV(8), rkg = CV(9); f32x4 wpre = w0v + *(const f32x4*)(DL + tt * 64 + c4), apre = a0v + *(const f32x4*)(DL + 2048 + tt * 64 + c4);
              f32x4 dec, av, kk, kp, bb; float ss = 0.f, bs = 0.f;
#pragma unroll
              for (int i = 0; i < 4; ++i) { const float wraw = -softplusf_(-wpre[i]) - 0.5f; dec[i] = exp_fast(-exp_fast(wraw)); av[i] = __builtin_amdgcn_rcpf(1.f + exp_fast(-apre[i])); kk[i] = ks[i] * kkg[i]; ss += kk[i] * kk[i]; }
              ss = red16(ss); const float inrm = __builtin_amdgcn_rsqf(fmaxf(ss, 1e-24f));
#pragma unroll
              for (int i = 0; i < 4; ++i) { kk[i] *= inrm; kp[i] = ks[i] * (1.f + (av[i] - 1.f) * kag[i]); bb[i] = kk[i] * av[i]; bs += rs[i] * kp[i] * rkg[i]; }
              bon = red16(bs);
              { float* pp = Rr + (tt >> 1) * 640 + (tt & 1) * 64 + c4;
                *(f32x4*)pp = rs; *(f32x4*)(pp + 128) = dec; *(f32x4*)(pp + 256) = kp; *(f32x4*)(pp + 384) = kk; *(f32x4*)(pp + 512) = bb; *(f32x4*)(Vv + tt * 64 + c4) = vs; } }
            RW_BAR();
            { const int p = tid >> 5, j2 = (tid & 31) * 2; float* pb = Rr + p * 640 + j2; typedef float f32x2v __attribute__((ext_vector_type(2)));
              const f32x2v r0 = *(const f32x2v*)pb, r1 = *(const f32x2v*)(pb + 64), w0 = *(const f32x2v*)(pb + 128), w1 = *(const f32x2v*)(pb + 192), k0 = *(const f32x2v*)(pb + 256), k1 = *(const f32x2v*)(pb + 320),
                            q0 = *(const f32x2v*)(pb + 384), q1 = *(const f32x2v*)(pb + 448), b0 = *(const f32x2v*)(pb + 512), b1 = *(const f32x2v*)(pb + 576);
              const f32x2v w1r1 = w1 * r1, B0 = b0 * w1, K0 = k0 * w1;
              *(f32x2v*)pb = q0; *(f32x2v*)(pb + 64) = w0 * q1; *(f32x2v*)(pb + 128) = w0 * r0; *(f32x2v*)(pb + 192) = w0 * w1r1;
              *(f32x2v*)(pb + 256) = w0 * w1; *(f32x2v*)(pb + 320) = B0; *(f32x2v*)(pb + 384) = K0; *(f32x2v*)(pb + 448) = b1; *(f32x2v*)(pb + 512) = k1;
              float d[8] = { b0.x * q1.x + b0.y * q1.y, k0.x * q1.x + k0.y * q1.y, b0.x * r0.x + b0.y * r0.y, k0.x * r0.x + k0.y * r0.y,
                             B0.x * r1.x + B0.y * r1.y, K0.x * r1.x + K0.y * r1.y, b1.x * r1.x + b1.y * r1.y, k1.x * r1.x + k1.y * r1.y };
              { const bool h16 = (lane & 16) != 0, h8 = (lane & 8) != 0, h4 = (lane & 4) != 0;
#pragma unroll
                for (int e = 0; e < 4; ++e) { const float snd = h16 ? d[e] : d[e + 4], kp_ = h16 ? d[e + 4] : d[e]; d[e] = kp_ + __shfl_xor(snd, 16); }
#pragma unroll
                for (int e = 0; e < 2; ++e) { const float snd = h8 ? d[e] : d[e + 2], kp_ = h8 ? d[e + 2] : d[e]; d[e] = kp_ + __shfl_xor(snd, 8); }
                { const float snd = h4 ? d[0] : d[1], kp_ = h4 ? d[1] : d[0]; d[0] = kp_ + __shfl_xor(snd, 4); }
                d[0] += __shfl_xor(d[0], 2); d[0] += __shfl_xor(d[0], 1);
                if ((lane & 3) == 0) Uu[p * 8 + (h16 ? 4 : 0) + (h8 ? 2 : 0) + (h4 ? 1 : 0)] = d[0]; } }
            RW_BAR();
            if (ck + 1 < T / 32) RW_FETCH(ck + 1);
            const int j0 = 16 * (wv & 3);
#define RW_LD16(dst, base) do { _Pragma("unroll") for (int g_ = 0; g_ < 4; ++g_) dst[g_] = *(const f32x4*)((base) + j0 + 4 * g_); } while (0)
#define RW_DOT16(x) ({ f32x4 a_ = Sv[0] * x[0] + Sv[1] * x[1] + Sv[2] * x[2] + Sv[3] * x[3]; (a_[0] + a_[1]) + (a_[2] + a_[3]); })
#pragma unroll 1
            for (int p = 0; p < 16; ++p) {
                const int par = (p & 1) * 1024; const float* pb = Rr + p * 640; const float* sc = Uu + p * 8;
                if (wv < 4) {
                    { f32x4 d0[4], d1[4], d2[4], d3[4]; RW_LD16(d0, pb); RW_LD16(d1, pb + 64); RW_LD16(d2, pb + 128); RW_LD16(d3, pb + 192);
                      red[par + wv * 64 + lane] = RW_DOT16(d0); red[par + 256 + wv * 64 + lane] = RW_DOT16(d1); red[par + 512 + wv * 64 + lane] = RW_DOT16(d2); red[par + 768 + wv * 64 + lane] = RW_DOT16(d3); }
                    asm volatile("" ::: "memory");
                    f32x4 u0[4], u1[4], u2[4], u3[4], u4[4]; RW_LD16(u0, pb + 256); RW_LD16(u1, pb + 320); RW_LD16(u2, pb + 384); RW_LD16(u3, pb + 448); RW_LD16(u4, pb + 512);
                    const float v0 = Vv[(2 * p) * 64 + lane], v1 = Vv[(2 * p + 1) * 64 + lane], c1 = sc[0], c2 = sc[1];
                    RW_BAR();
                    const float sa0 = (red[par + lane] + red[par + 64 + lane]) + (red[par + 128 + lane] + red[par + 192 + lane]);
                    const float q = (red[par + 256 + lane] + red[par + 320 + lane]) + (red[par + 384 + lane] + red[par + 448 + lane]);
                    const float sa1 = q - sa0 * c1 + v0 * c2;
#pragma unroll
                    for (int g = 0; g < 4; ++g) Sv[g] = Sv[g] * u0[g] - sa0 * u1[g] + v0 * u2[g] - sa1 * u3[g] + v1 * u4[g];
                } else {
                    RW_BAR();
                    if (wv < 6) {
                        const float v0 = Vv[(2 * p) * 64 + lane];
                        const float sa0 = (red[par + lane] + red[par + 64 + lane]) + (red[par + 128 + lane] + red[par + 192 + lane]);
                        if (wv == 4) { const float y0 = (red[par + 512 + lane] + red[par + 576 + lane]) + (red[par + 640 + lane] + red[par + 704 + lane]);
                            Yb[(2 * p) * 64 + lane] = y0 - sa0 * sc[2] + v0 * sc[3]; }
                        else { const float v1 = Vv[(2 * p + 1) * 64 + lane];
                            const float q = (red[par + 256 + lane] + red[par + 320 + lane]) + (red[par + 384 + lane] + red[par + 448 + lane]);
                            const float sa1 = q - sa0 * sc[0] + v0 * sc[1];
                            const float y1 = (red[par + 768 + lane] + red[par + 832 + lane]) + (red[par + 896 + lane] + red[par + 960 + lane]);
                            Yb[(2 * p + 1) * 64 + lane] = y1 - sa0 * sc[4] + v0 * sc[5] - sa1 * sc[6] + v1 * sc[7]; } }
                    else if (p == 0) {
                        const size_t i8 = ((size_t)((blockIdx.x * 2 + (wv - 6)) * 64 + ck)) * 64 + lane;
                        const f32x4 pa = *(const f32x4*)(P.p + i8 * 8), pq = *(const f32x4*)(P.p + i8 * 8 + 4);
                        *(u32x4*)((bf16*)(P.ws + WS_PB) + i8 * 8) = pg8::pack8(pa, pq); } }
            }
            if (ck + 1 < T / 32) RW_FETCH_PREV(row + 31);
            RW_BAR();
#undef RW_LD16
#undef RW_BAR
#undef RW_DOT16
            { const f32x4 lng = CV(10), lnb = CV(11); const f32x4 y4 = *(const f32x4*)(Yb + tt * 64 + c4); const float mean = red16((y4[0] + y4[1]) + (y4[2] + y4[3])) * (1.f / 64.f);
              const f32x4 d = y4 - mean; const float var = red16((d[0] * d[0] + d[1] * d[1]) + (d[2] * d[2] + d[3] * d[3])) * (1.f / 64.f); const float rstd = __builtin_amdgcn_rsqf(var + 64e-5f);
              const u32x2 gg = n_gg; if (ck + 1 < T / 32) n_gg = *(const u32x2*)(GBg + (row + 32) * 1024 + hc);
              const float g0 = bflo(gg.x), g1 = bfhi(gg.x), g2 = bflo(gg.y), g3 = bfhi(gg.y);
              const float z0 = (d[0] * rstd * lng[0] + lnb[0] + bon * vs[0]) * g0 * sigm(g0), z1 = (d[1] * rstd * lng[1] + lnb[1] + bon * vs[1]) * g1 * sigm(g1);
              const float z2 = (d[2] * rstd * lng[2] + lnb[2] + bon * vs[2]) * g2 * sigm(g2), z3 = (d[3] * rstd * lng[3] + lnb[3] + bon * vs[3]) * g3 * sigm(g3);
              u32x2 w; w.x = cvt_pk_bf16(z0, z1); w.y = cvt_pk_bf16(z2, z3); *(u32x2*)(Z + row * 2048 + 1024 + hc) = w; }
        }
    }
}

#undef RW_FETCH
#undef RW_FETCH_PREV
#undef CV
__device__ __forceinline__ void gmlp_phase(unsigned char* lds, const Ptrs& P, const bf16* Ug, const bf16* Vg, const bf16* Gg, const float* vsum, const float* vsq, bf16* Z, const int wave_s) {
    int tid_ = my_tid(wave_s); asm volatile("" : "+v"(tid_)); const int tid = tid_, lane = tid & 63, wid = __builtin_amdgcn_readfirstlane(tid >> 6), r32 = lane & 31, hi = lane >> 5;
    bf16* As = (bf16*)lds;
    bf16* Bt = As + 128 * 136;
    float* Ds = (float*)(lds + 2 * 128 * 136 * 2 + 256);
    int gcur = -1;
    for (int u = blockIdx.x; u < 4096; u += gridDim.x) {
        const int g = u & 15, bn = u >> 4; const size_t row0 = (size_t)bn * 128; const int C0 = g * 128;
        __syncthreads();
        if (g != gcur) { gcur = g; const float* ws_ = P.c_w_s + (size_t)g * 128 * 128;
            for (int i = tid; i < 128 * 128 / 4; i += 512) { const int t = i >> 5, s4 = (i & 31) * 4; f32x4 w = *(const f32x4*)(ws_ + t * 128 + s4);
                u32x2 o; o.x = cvt_pk_bf16(s4 + 0 <= t ? w[0] : 0.f, s4 + 1 <= t ? w[1] : 0.f); o.y = cvt_pk_bf16(s4 + 2 <= t ? w[2] : 0.f, s4 + 3 <= t ? w[3] : 0.f); *(u32x2*)(As + t * 136 + s4) = o; } }
#pragma unroll
        for (int it = 0; it < 4; ++it) { const int i = tid + it * 512, s = i >> 4, c8 = (i & 15) * 8; const size_t row = row0 + s;
            const float mean = vsum[row] * (1.f / 2048.f), var = vsq[row] * (1.f / 2048.f) - mean * mean, rstd = __builtin_amdgcn_rsqf(fmaxf(var, 0.f) + 1e-5f);
            const u32x4 vv = *(const u32x4*)(Vg + row * 2048 + C0 + c8); const f32x4 lg0 = *(const f32x4*)(P.c_ln_g + C0 + c8), lg1 = *(const f32x4*)(P.c_ln_g + C0 + c8 + 4), lb0 = *(const f32x4*)(P.c_ln_b + C0 + c8), lb1 = *(const f32x4*)(P.c_ln_b + C0 + c8 + 4);
            float x[8] = {bflo(vv.x), bfhi(vv.x), bflo(vv.y), bfhi(vv.y), bflo(vv.z), bfhi(vv.z), bflo(vv.w), bfhi(vv.w)};
#pragma unroll
            for (int j = 0; j < 8; ++j) { const float gn = (x[j] - mean) * rstd * (j < 4 ? lg0[j & 3] : lg1[j & 3]) + (j < 4 ? lb0[j & 3] : lb1[j & 3]); const float nb = __shfl_xor(gn, 0); (void)nb;
                Bt[(c8 + j) * 136 + (c8 >> 3) * 8 + s] = (bf16)(cvt_pk_bf16(gn, 0.f) & 0xffffu); } }
        __syncthreads();
        { const int tb = wid >> 1, cb = (wid & 1) * 64; f32x16 d0, d1;
#pragma unroll
          for (int r = 0; r < 16; ++r) { d0[r] = 0.f; d1[r] = 0.f; }
          for (int k = 0; k <= 2 * tb + 1; ++k) {
              const bf16x8 a = *(const bf16x8*)(As + (32 * tb + r32) * 136 + 16 * k + 8 * hi);
              const bf16x8 b0 = *(const bf16x8*)(Bt + (cb + r32) * 136 + ((cb + r32) >> 3) * 8 + 16 * k + 8 * hi), b1 = *(const bf16x8*)(Bt + (cb + 32 + r32) * 136 + ((cb + 32 + r32) >> 3) * 8 + 16 * k + 8 * hi);
              d0 = __builtin_amdgcn_mfma_f32_32x32x16_bf16(a, b0, d0, 0, 0, 0); d1 = __builtin_amdgcn_mfma_f32_32x32x16_bf16(a, b1, d1, 0, 0, 0); }
#pragma unroll
          for (int r = 0; r < 16; ++r) { const int t = 32 * tb + crow(r, hi); Ds[t * 132 + cb + r32] = d0[r]; Ds[t * 132 + cb + 32 + r32] = d1[r]; } }
        __syncthreads();
#pragma unroll
        for (int it = 0; it < 4; ++it) { const int i = tid + it * 512, t = i >> 4, c8 = (i & 15) * 8; const size_t off = (row0 + t) * 2048 + C0 + c8;
            const float bs = P.c_b_s[g * 128 + t]; const u32x4 uu = *(const u32x4*)(Ug + off), gg = *(const u32x4*)(Gg + off);
            const f32x4 da = *(const f32x4*)(Ds + t * 132 + c8), db = *(const f32x4*)(Ds + t * 132 + c8 + 4); u32x4 o;
            o.x = cvt_pk_bf16(bflo(uu.x) * (da[0] + bs) * bflo(gg.x), bfhi(uu.x) * (da[1] + bs) * bfhi(gg.x)); o.y = cvt_pk_bf16(bflo(uu.y) * (da[2] + bs) * bflo(gg.y), bfhi(uu.y) * (da[3] + bs) * bfhi(gg.y));
            o.z = cvt_pk_bf16(bflo(uu.z) * (db[0] + bs) * bflo(gg.z), bfhi(uu.z) * (db[1] + bs) * bfhi(gg.z)); o.w = cvt_pk_bf16(bflo(uu.w) * (db[2] + bs) * bflo(gg.w), bfhi(uu.w) * (db[3] + bs) * bfhi(gg.w));
            *(u32x4*)(Z + off) = o; }
    }
}

__global__ void __launch_bounds__(512, 2) mega_fwd(Ptrs P) {
    extern __shared__ __attribute__((aligned(16))) unsigned char lds[];
    cg::grid_group grid = cg::this_grid();
    const int wave_s = __builtin_amdgcn_readfirstlane((int)threadIdx.x >> 6);
    unsigned char* ws = P.ws;
    float* ctl = (float*)(ws + WS_CTL);
    float *ssq0 = ctl, *ssqA = ctl + M, *ssqB = ctl + 2 * M, *ssqC = ctl + 3 * M, *vsum = ctl + 4 * M, *vsq = ctl + 5 * M;
    bf16* G = (bf16*)(ws + WS_G); const size_t GS = (size_t)M * 1024;
    bf16* HBA = (bf16*)(ws + WS_HBA); bf16* PB = (bf16*)(ws + WS_PB); float* SMALL = (float*)(ws + WS_SMALL); bf16* Zb = (bf16*)(ws + WS_Z);
    bf16* Y0 = G; bf16* PP0 = G + 2 * GS; bf16* HBB = G + 6 * GS;
    bf16* U_u = G; bf16* U_v = G + 2 * GS; bf16* U_g = G + 4 * GS;
    bf16* Y1 = G + 2 * GS; bf16* PP1 = G;
    const int lo = P.ph_lo, hi = P.ph_hi;
    PG8_LAS unsigned char* lds3 = (PG8_LAS unsigned char*)lds;
#define IN(k) (lo <= (k) && (k) < hi)
    unsigned* const gbar = (unsigned*)(ws + WS_CTL + 0x1F0000);
#define SEAM(k) do { if (IN(k) && IN((k) + 1)) { if ((k) == 0) grid.sync(); else { \
        asm volatile("s_waitcnt vmcnt(0) lgkmcnt(0)" ::: "memory"); __syncthreads(); \
        if (my_tid(wave_s) == 0) { __builtin_amdgcn_fence(__ATOMIC_RELEASE, "agent"); asm volatile("s_waitcnt vmcnt(0)" ::: "memory"); \
            __hip_atomic_fetch_add(gbar, 1u, __ATOMIC_RELAXED, __HIP_MEMORY_SCOPE_AGENT); \
            while (__hip_atomic_load(gbar, __ATOMIC_RELAXED, __HIP_MEMORY_SCOPE_AGENT) < 256u * (unsigned)(k)) __builtin_amdgcn_s_sleep(4); \
            __builtin_amdgcn_fence(__ATOMIC_ACQUIRE, "agent"); asm volatile("s_waitcnt vmcnt(0)" ::: "memory"); } \
        __syncthreads(); } } } while (0)
    if (IN(0)) { p0_prologue(P, lds, wave_s); } SEAM(0);
    if (IN(1)) { pg8::Gemm g{HBA, (const bf16*)(ws + WS_WIN0), M, N_IN0, 2048}; pg8::StaticOrder S; S.init(M, N_IN0, gridDim.x, blockIdx.x);
        pg8::EpiIn0 E{G, SMALL, ssq0, 0.125f * LOG2E}; pg8::gemm_phase<pg8::EpiIn0, pg8::StaticOrder, true, true>(lds3, g, S, E, my_tid(wave_s)); } SEAM(1);
    if (IN(2)) { attn_phase(lds, G, G + GS, G + 2 * GS, G + 3 * GS, SMALL, P.fox_f_bias, Zb, wave_s);
        rwkv_phase(lds, P, G + 4 * GS, G + 5 * GS, G + 6 * GS, G + 7 * GS, SMALL, Zb, wave_s); } SEAM(2);
    if (IN(3)) { { pg8::Gemm g{Zb, (const bf16*)(ws + WS_WOUT0), M, 2048, 2048}; pg8::StaticOrder S; S.init(M, 2048, gridDim.x, blockIdx.x);
          pg8::EpiY E{Y0, ssqA}; pg8::gemm_phase<pg8::EpiY, pg8::StaticOrder, true, true>(lds3, g, S, E, my_tid(wave_s)); }
        { pg8::Gemm g{PB, (const bf16*)(ws + WS_WP0), M, 2048, 256}; pg8::StaticOrder S; S.init(M, 2048, gridDim.x, blockIdx.x);
          pg8::EpiBf16<0> E{PP0, 2048, nullptr, 0, 0, 1.f}; pg8::gemm_phase<pg8::EpiBf16<0>, pg8::StaticOrder, true, true>(lds3, g, S, E, my_tid(wave_s)); } } SEAM(3);
    if (IN(4)) { post_norm_phase<true>(P.x, HBA, Y0, ssqA, P.norm_post, P.out, HBA, wave_s); } SEAM(4);
    if (IN(5)) { pg8::Gemm g{HBA, (const bf16*)(ws + WS_WG0), M, 2048, 2048}; pg8::StaticOrder S; S.init(M, 2048, gridDim.x, blockIdx.x);
        pg8::EpiGate E{P.x, P.out, Y0, ssqA, P.norm_post, PP0, HBB, ssqB}; pg8::gemm_phase<pg8::EpiGate, pg8::StaticOrder, true, true>(lds3, g, S, E, my_tid(wave_s)); } SEAM(5);
    if (IN(6)) { pg8::Gemm g{HBB, (const bf16*)(ws + WS_WIN1), M, 6144, 2048}; pg8::StaticOrder S; S.init(M, 6144, gridDim.x, blockIdx.x);
        pg8::EpiC E{U_u, 2 * GS, ssqB, vsum, vsq}; pg8::gemm_phase<pg8::EpiC, pg8::StaticOrder, true, true>(lds3, g, S, E, my_tid(wave_s)); } SEAM(6);
    if (IN(7)) { gmlp_phase(lds, P, U_u, U_v, U_g, vsum, vsq, Zb, wave_s); } SEAM(7);
    if (IN(8)) { { pg8::Gemm g{Zb, (const bf16*)(ws + WS_WOUT1), M, 2048, 2048}; pg8::StaticOrder S; S.init(M, 2048, gridDim.x, blockIdx.x);
          pg8::EpiY E{Y1, ssqC}; pg8::gemm_phase<pg8::EpiY, pg8::StaticOrder, true, true>(lds3, g, S, E, my_tid(wave_s)); }
        { pg8::Gemm g{PB + (size_t)M * 256, (const bf16*)(ws + WS_WP1), M, 2048, 256}; pg8::StaticOrder S; S.init(M, 2048, gridDim.x, blockIdx.x);
          pg8::EpiBf16<0> E{PP1, 2048, nullptr, 0, 0, 1.f}; pg8::gemm_phase<pg8::EpiBf16<0>, pg8::StaticOrder, true, true>(lds3, g, S, E, my_tid(wave_s)); } } SEAM(8);
    if (IN(9)) { post_norm_phase<true>(P.out, HBB, Y1, ssqC, P.norm_post + 2048, P.out, HBA, wave_s); } SEAM(9);
    if (IN(10)) { pg8::Gemm g{HBA, (const bf16*)(ws + WS_WG1), M, 2048, 2048}; pg8::StaticOrder S; S.init(M, 2048, gridDim.x, blockIdx.x);
        pg8::EpiGate E{P.out, P.out, Y1, ssqC, P.norm_post + 2048, PP1, nullptr, nullptr}; pg8::gemm_phase<pg8::EpiGate, pg8::StaticOrder, true, true>(lds3, g, S, E, my_tid(wave_s)); }
#undef IN
#undef SEAM
}

#ifndef MK_PER_PHASE
#define MK_PER_PHASE 0
#endif
constexpr int N_PHASES = 11;
extern "C" void kernel_launch(void* const* d_in, const int* in_sizes, int n_in, void* d_out, int out_size, void* d_ws, size_t ws_size, hipStream_t stream) {
    static int grid = 0;
    if (grid == 0) {
        if (n_in != 25 || ws_size < WS_END) { fprintf(stderr, "kernel_launch: need 25 inputs and %zu bytes of workspace (got %d, %zu)\n", (size_t)WS_END, n_in, ws_size); grid = -1; return; }
        int dev = 0, cus = 0, per_cu = 0;
        hipGetDevice(&dev); hipDeviceGetAttribute(&cus, hipDeviceAttributeMultiprocessorCount, dev);
        if (hipFuncSetAttribute((const void*)mega_fwd, hipFuncAttributeMaxDynamicSharedMemorySize, LDS_BYTES) != hipSuccess) { fprintf(stderr, "kernel_launch: hipFuncSetAttribute failed\n"); grid = -1; return; }
        hipOccupancyMaxActiveBlocksPerMultiprocessor(&per_cu, (const void*)mega_fwd, 512, LDS_BYTES);
        (void)hipGetLastError();
        if (per_cu < 1) { fprintf(stderr, "kernel_launch: occupancy query says %d blocks per CU\n", per_cu); per_cu = 1; }
        if (cus < 256) { fprintf(stderr, "kernel_launch: built for a 256-CU device (got %d CUs)\n", cus); grid = -1; return; }
        grid = 256;
    }
    if (grid < 0) return;
    (void)hipMemsetAsync((char*)d_ws + WS_CTL + 0x1F0000, 0, 256, stream);
    Ptrs p{};
    const float** pp = (const float**)&p;
    for (int i = 0; i < 25; ++i) pp[i] = (const float*)d_in[i];
    p.out = (float*)d_out; p.ws = (unsigned char*)d_ws;
#if MK_PER_PHASE
    for (int k = 0; k < N_PHASES; ++k) { p.ph_lo = k; p.ph_hi = k + 1; hipLaunchKernelGGL(mega_fwd, dim3(grid), dim3(512), LDS_BYTES, stream, p); }
#else
    p.ph_lo = 0; p.ph_hi = N_PHASES;
    void* args[] = {&p};
    hipError_t e = hipLaunchCooperativeKernel((const void*)mega_fwd, dim3(grid), dim3(512), args, LDS_BYTES, stream);
    if (e != hipSuccess) fprintf(stderr, "cooperative launch failed: %s (grid %d)\n", hipGetErrorString(e), grid);
#endif
}
```
